# Optimizing an MI355X kernel written in HIP

```python
import math
import jax, jax.numpy as jnp
from jax import lax
import numpy as np

D_MODEL = 1024
BATCH = 4
SEQ = 4096
DEPTH = 2
DEC_BATCH = 32
DEC_SEQ = 64
PAST_LEN = 2048

CHUNK = 64
D_MIX = D_MODEL
D_A = 3 * D_MIX // 8
D_B = D_MIX // 4
D_C = D_MIX - D_A - D_B
HGRN_HEAD = 64
HGRN_HEADS = D_A // HGRN_HEAD
HGRN_BLOCK = 16
S5_GROUP = 16
S5_GROUPS = D_B // S5_GROUP
S5_STATE = 64
LRU_BLOCK = 64
LRU_HEADS = D_C // LRU_BLOCK
CONV_W = 4
LRU_C = 8.0
D_FF = -(-8 * D_MODEL // (3 * 256)) * 256
D_IN = 4 * D_A + D_B + 2 * D_C
EPS = 1e-6

kernel_name = "hymba_hgrn2_s5_rglru_stream_step"

F32 = jnp.float32


def rmsnorm(x, w):
    x32 = x.astype(F32)
    y = x32 * lax.rsqrt(jnp.mean(x32 * x32, axis=-1, keepdims=True) + EPS)
    return (y * w.astype(F32)).astype(x.dtype)


def rms32(x, w):
    return x * lax.rsqrt(jnp.mean(x * x, axis=-1, keepdims=True) + EPS) * w.astype(F32)


def hgrn2_mixer(q, f_raw, inp, g, lb, norm_w, S0):
    Bsz, L, _ = q.shape
    q = q.astype(F32)
    f_raw = f_raw.astype(F32)
    inp = inp.astype(F32)
    f = lb + (1.0 - lb) * jax.nn.sigmoid(f_raw)
    log_f = jnp.log(f)
    k = (1.0 - lb) * jax.nn.sigmoid(-f_raw)
    nb = -(-L // HGRN_BLOCK)
    pad = nb * HGRN_BLOCK - L

    def blocks(t):
        t = jnp.pad(t, ((0, 0), (0, pad), (0, 0)))
        t = t.reshape(Bsz, nb, HGRN_BLOCK, HGRN_HEADS, HGRN_HEAD)
        return t.transpose(1, 0, 3, 2, 4)

    mask = jnp.tril(jnp.ones((HGRN_BLOCK, HGRN_BLOCK), dtype=bool))
    ref = HGRN_BLOCK // 2 - 1

    def step(S, blk):
        qb, kb, vb, gb = blk
        G = jnp.cumsum(gb, axis=2)
        Gr = G[:, :, ref:ref + 1]
        att = jnp.einsum('bhtd,bhsd->bhts', qb * jnp.exp(G - Gr), kb * jnp.exp(Gr - G))
        att = jnp.where(mask, att, 0.0)
        o = (jnp.einsum('bhts,bhsv->bhtv', att, vb)
             + jnp.einsum('bhtd,bhdv->bhtv', qb * jnp.exp(G), S))
        Gl = G[:, :, -1:]
        S = (jnp.exp(Gl)[:, :, 0, :, None] * S
             + jnp.einsum('bhsd,bhsv->bhdv', kb * jnp.exp(Gl - G), vb))
        return S, o

    S_fin, o = lax.scan(step, S0.astype(F32),
                        (blocks(q), blocks(k), blocks(inp), blocks(log_f)))
    o = o.transpose(1, 0, 3, 2, 4).reshape(Bsz, nb * HGRN_BLOCK, HGRN_HEADS, HGRN_HEAD)[:, :L]
    o = o * lax.rsqrt(jnp.mean(o * o, axis=-1, keepdims=True) + EPS)
    o = o.reshape(Bsz, L, D_A) * norm_w.astype(F32) * jax.nn.silu(g.astype(F32))
    return o, S_fin


def s5_mixer(u, lam_re, lam_im, log_dt, b_re, b_im, c_re, c_im, d, w_glu, b_glu, norm_w,
             h0_re, h0_im):
    Bsz, L, _ = u.shape
    u = u.astype(F32)
    ug = u.reshape(Bsz, L, S5_GROUPS, S5_GROUP)
    dt = jnp.exp(log_dt.astype(F32))[:, None]
    lr = jnp.minimum(lam_re.astype(F32), -1e-4)
    li = lam_im.astype(F32)
    mag = jnp.exp(lr * dt)
    a_re = mag * jnp.cos(li * dt)
    a_im = mag * jnp.sin(li * dt)
    den = lr * lr + li * li
    nr = a_re - 1.0
    gam_re = (nr * lr + a_im * li) / den
    gam_im = (a_im * lr - nr * li) / den
    b_re = b_re.astype(F32)
    b_im = b_im.astype(F32)
    bbar_re = gam_re[..., None] * b_re - gam_im[..., None] * b_im
    bbar_im = gam_re[..., None] * b_im + gam_im[..., None] * b_re
    bu_re = jnp.einsum('blgn,gpn->blgp', ug, bbar_re)
    bu_im = jnp.einsum('blgn,gpn->blgp', ug, bbar_im)
    h0_re = h0_re.astype(F32)
    h0_im = h0_im.astype(F32)
    bu_re = bu_re.at[:, 0].add(a_re * h0_re - a_im * h0_im)
    bu_im = bu_im.at[:, 0].add(a_re * h0_im + a_im * h0_re)
    ar = jnp.broadcast_to(a_re, bu_re.shape)
    ai = jnp.broadcast_to(a_im, bu_re.shape)

    def combine(e1, e2):
        a1r, a1i, b1r, b1i = e1
        a2r, a2i, b2r, b2i = e2
        return (a2r * a1r - a2i * a1i, a2r * a1i + a2i * a1r,
                a2r * b1r - a2i * b1i + b2r, a2r * b1i + a2i * b1r + b2i)

    _, _, h_re, h_im = lax.associative_scan(combine, (ar, ai, bu_re, bu_im), axis=1)
    y = (jnp.einsum('blgp,gnp->blgn', h_re, c_re.astype(F32))
         - jnp.einsum('blgp,gnp->blgn', h_im, c_im.astype(F32)))
    y = y.reshape(Bsz, L, D_B) + d.astype(F32) * u
    z = jax.nn.gelu(y)
    z = z * jax.nn.sigmoid(z @ w_glu.astype(F32) + b_glu.astype(F32))
    return rms32(z, norm_w), h_re[:, -1], h_im[:, -1]


def rglru_mixer(xb, gate, conv_w, conv_b, wa, ba, wx, bx, lam, norm_w, h0, buf):
    Bsz, L, _ = xb.shape
    xp = jnp.concatenate([buf.astype(F32), xb.astype(F32)], axis=1)
    conv_w = conv_w.astype(F32)
    xc = conv_b.astype(F32) + sum(xp[:, j:j + L] * conv_w[j] for j in range(CONV_W))
    new_buf = xp[:, L:]
    xh = xc.reshape(Bsz, L, LRU_HEADS, LRU_BLOCK)
    r = jax.nn.sigmoid(jnp.einsum('blhi,hij->blhj', xh, wa.astype(F32)).reshape(Bsz, L, D_C)
                       + ba.astype(F32))
    i = jax.nn.sigmoid(jnp.einsum('blhi,hij->blhj', xh, wx.astype(F32)).reshape(Bsz, L, D_C)
                       + bx.astype(F32))
    log_a = -LRU_C * r * jax.nn.softplus(-lam.astype(F32))
    a = jnp.exp(log_a)
    b = jnp.sqrt(-jnp.expm1(2.0 * log_a)) * (i * xc)
    b = b.at[:, 0].add(a[:, 0] * h0.astype(F32))

    def combine(e1, e2):
        return (e2[0] * e1[0], e2[0] * e1[1] + e2[1])

    _, h = lax.associative_scan(combine, (a, b), axis=1)
    y = h * jax.nn.gelu(gate.astype(F32))
    return rms32(y, norm_w), h[:, -1], new_buf


def trunk(x, s_hgrn, s_s5r, s_s5i, s_lru, s_conv, P):
    sm = jax.nn.softmax(P['hgrn_lb'].astype(F32), axis=0)
    cs = jnp.cumsum(sm, axis=0)
    lbs = cs - cs[0:1]
    splits = [D_A, 2 * D_A, 3 * D_A, 4 * D_A, 4 * D_A + D_B, 4 * D_A + D_B + D_C]
    out_h, out_sr, out_si, out_l, out_c = [], [], [], [], []
    for l in range(DEPTH):
        xn = rmsnorm(x, P['norm_mix'][l])
        proj = jnp.einsum('bld,de->ble', xn, P['w_in'][l])
        q, f_raw, inp, g, u, xr, gr = jnp.split(proj, splits, axis=-1)
        oA, hA = hgrn2_mixer(q, f_raw, inp, g, lbs[l], P['hgrn_norm'][l], s_hgrn[l])
        oB, hBr, hBi = s5_mixer(u, P['s5_lam_re'][l], P['s5_lam_im'][l], P['s5_log_dt'][l],
                                P['s5_b_re'][l], P['s5_b_im'][l], P['s5_c_re'][l],
                                P['s5_c_im'][l], P['s5_d'][l], P['s5_w_glu'][l],
                                P['s5_b_glu'][l], P['s5_norm'][l], s_s5r[l], s_s5i[l])
        oC, hC, bufC = rglru_mixer(xr, gr, P['lru_conv_w'][l], P['lru_conv_b'][l],
                                   P['lru_wa'][l], P['lru_ba'][l], P['lru_wx'][l],
                                   P['lru_bx'][l], P['lru_lam'][l], P['lru_norm'][l],
                                   s_lru[l], s_conv[l])
        mix = jnp.concatenate([oA, oB, oC], axis=-1).astype(x.dtype)
        x = x + jnp.einsum('ble,ed->bld', mix, P['w_out'][l])
        xn2 = rmsnorm(x, P['norm_ffn'][l])
        hid = (jax.nn.silu(jnp.einsum('bld,df->blf', xn2, P['w_ffn_gate'][l]))
               * jnp.einsum('bld,df->blf', xn2, P['w_ffn_up'][l]))
        x = x + jnp.einsum('blf,fd->bld', hid, P['w_ffn_down'][l])
        out_h.append(hA); out_sr.append(hBr); out_si.append(hBi)
        out_l.append(hC); out_c.append(bufC)
    y = rmsnorm(x, P['norm_final'])
    return (y, jnp.stack(out_h), jnp.stack(out_sr), jnp.stack(out_si),
            jnp.stack(out_l), jnp.stack(out_c))


def setup_inputs(seed: int = 0) -> dict:
    key = jax.random.key(seed)
    ks = iter(jax.random.split(key, 48))

    def nrm(shape, scale):
        return scale * jax.random.normal(next(ks), shape, F32)

    n = jnp.arange(S5_STATE, dtype=F32)
    u_lam = jax.random.uniform(next(ks), (DEPTH, D_C), F32, 0.9, 0.999)
    s_lam = u_lam ** (1.0 / LRU_C)
    return {
        "x_prompt": nrm((BATCH, SEQ, D_MODEL), 1.0),
        "x_sample": nrm((DEC_BATCH, DEC_SEQ, D_MODEL), 1.0),
        "state_hgrn": nrm((DEPTH, DEC_BATCH, HGRN_HEADS, HGRN_HEAD, HGRN_HEAD), 0.5),
        "state_s5_re": nrm((DEPTH, DEC_BATCH, S5_GROUPS, S5_STATE), 0.5),
        "state_s5_im": nrm((DEPTH, DEC_BATCH, S5_GROUPS, S5_STATE), 0.5),
        "state_rglru": nrm((DEPTH, DEC_BATCH, D_C), 1.0),
        "cache_conv": nrm((DEPTH, DEC_BATCH, CONV_W - 1, D_C), 1.0),
        "norm_mix": 1.0 + nrm((DEPTH, D_MODEL), 0.02),
        "w_in": nrm((DEPTH, D_MODEL, D_IN), D_MODEL ** -0.5),
        "hgrn_lb": nrm((DEPTH, D_A), 1.0),
        "hgrn_norm": 1.0 + nrm((DEPTH, D_A), 0.02),
        "s5_lam_re": -0.5 + nrm((DEPTH, S5_GROUPS, S5_STATE), 0.01),
        "s5_lam_im": jnp.pi * n + nrm((DEPTH, S5_GROUPS, S5_STATE), 0.01),
        "s5_log_dt": jax.random.uniform(next(ks), (DEPTH, S5_GROUPS), F32,
                                        math.log(1e-3), math.log(1e-1)),
        "s5_b_re": nrm((DEPTH, S5_GROUPS, S5_STATE, S5_GROUP), (2 * S5_GROUP) ** -0.5),
        "s5_b_im": nrm((DEPTH, S5_GROUPS, S5_STATE, S5_GROUP), (2 * S5_GROUP) ** -0.5),
        "s5_c_re": nrm((DEPTH, S5_GROUPS, S5_GROUP, S5_STATE), (2 * S5_STATE) ** -0.5),
        "s5_c_im": nrm((DEPTH, S5_GROUPS, S5_GROUP, S5_STATE), (2 * S5_STATE) ** -0.5),
        "s5_d": nrm((DEPTH, D_B), 1.0),
        "s5_w_glu": nrm((DEPTH, D_B, D_B), D_B ** -0.5),
        "s5_b_glu": nrm((DEPTH, D_B), 0.01),
        "s5_norm": 1.0 + nrm((DEPTH, D_B), 0.02),
        "lru_conv_w": nrm((DEPTH, CONV_W, D_C), CONV_W ** -0.5),
        "lru_conv_b": nrm((DEPTH, D_C), 0.01),
        "lru_wa": nrm((DEPTH, LRU_HEADS, LRU_BLOCK, LRU_BLOCK), LRU_BLOCK ** -0.5),
        "lru_ba": nrm((DEPTH, D_C), 0.01),
        "lru_wx": nrm((DEPTH, LRU_HEADS, LRU_BLOCK, LRU_BLOCK), LRU_BLOCK ** -0.5),
        "lru_bx": nrm((DEPTH, D_C), 0.01),
        "lru_lam": jnp.log(s_lam) - jnp.log1p(-s_lam),
        "lru_norm": 1.0 + nrm((DEPTH, D_C), 0.02),
        "w_out": nrm((DEPTH, D_MIX, D_MODEL), D_MIX ** -0.5),
        "norm_ffn": 1.0 + nrm((DEPTH, D_MODEL), 0.02),
        "w_ffn_gate": nrm((DEPTH, D_MODEL, D_FF), D_MODEL ** -0.5),
        "w_ffn_up": nrm((DEPTH, D_MODEL, D_FF), D_MODEL ** -0.5),
        "w_ffn_down": nrm((DEPTH, D_FF, D_MODEL), D_FF ** -0.5),
        "norm_final": 1.0 + nrm((D_MODEL,), 0.02),
    }


def reference(x_prompt, x_sample, state_hgrn, state_s5_re, state_s5_im, state_rglru, cache_conv,
              norm_mix, w_in, hgrn_lb, hgrn_norm, s5_lam_re, s5_lam_im, s5_log_dt, s5_b_re,
              s5_b_im, s5_c_re, s5_c_im, s5_d, s5_w_glu, s5_b_glu, s5_norm, lru_conv_w,
              lru_conv_b, lru_wa, lru_ba, lru_wx, lru_bx, lru_lam, lru_norm, w_out, norm_ffn,
              w_ffn_gate, w_ffn_up, w_ffn_down, norm_final):
    P = {
        'norm_mix': norm_mix, 'w_in': w_in, 'hgrn_lb': hgrn_lb, 'hgrn_norm': hgrn_norm,
        's5_lam_re': s5_lam_re, 's5_lam_im': s5_lam_im, 's5_log_dt': s5_log_dt,
        's5_b_re': s5_b_re, 's5_b_im': s5_b_im, 's5_c_re': s5_c_re, 's5_c_im': s5_c_im,
        's5_d': s5_d, 's5_w_glu': s5_w_glu, 's5_b_glu': s5_b_glu, 's5_norm': s5_norm,
        'lru_conv_w': lru_conv_w, 'lru_conv_b': lru_conv_b, 'lru_wa': lru_wa, 'lru_ba': lru_ba,
        'lru_wx': lru_wx, 'lru_bx': lru_bx, 'lru_lam': lru_lam, 'lru_norm': lru_norm,
        'w_out': w_out, 'norm_ffn': norm_ffn, 'w_ffn_gate': w_ffn_gate, 'w_ffn_up': w_ffn_up,
        'w_ffn_down': w_ffn_down, 'norm_final': norm_final,
    }
    bp = x_prompt.shape[0]
    z_hgrn = jnp.zeros((DEPTH, bp, HGRN_HEADS, HGRN_HEAD, HGRN_HEAD), F32)
    z_s5 = jnp.zeros((DEPTH, bp, S5_GROUPS, S5_STATE), F32)
    z_lru = jnp.zeros((DEPTH, bp, D_C), F32)
    z_conv = jnp.zeros((DEPTH, bp, CONV_W - 1, D_C), F32)
    y_prompt, hgrn_p, s5re_p, s5im_p, lru_p, conv_p = trunk(
        x_prompt, z_hgrn, z_s5, z_s5, z_lru, z_conv, P)
    y_sample, hgrn_s, s5re_s, s5im_s, lru_s, conv_s = trunk(
        x_sample, state_hgrn, state_s5_re, state_s5_im, state_rglru, cache_conv, P)
    return (y_prompt, y_sample, hgrn_p, s5re_p, s5im_p, lru_p, conv_p,
            hgrn_s, s5re_s, s5im_s, lru_s, conv_s)
```

```cpp
#include <hip/hip_runtime.h>
#include <hip/hip_cooperative_groups.h>
#include <cstdio>
#include <cstdint>
namespace pg8 {
#define PG8_LAS __attribute__((address_space(3)))
typedef unsigned short bf16_t;
typedef short bf16x8 __attribute__((ext_vector_type(8)));
typedef float f32x4 __attribute__((ext_vector_type(4)));
typedef unsigned u32x4 __attribute__((ext_vector_type(4)));
constexpr int BM = 256, BK = 64, HALF = 128, HTB = HALF * BK * 2  , STAGE_BYTES = 8 * HTB, NXCD = 8, WGM = 8;

__host__ __device__ __forceinline__ int lds_byte(int r, int c) { const int st = (r >> 4) * 2 + (c >> 5), rr = r & 15, cc = c & 31, ob = rr * 64 + cc * 2; return st * 1024 + (ob ^ (((ob >> 9) & 1) << 5)); }
__host__ __device__ __forceinline__ void stage_rc(int b, int& R, int& C) { const int st = b / 1024, sb = b % 1024, swz = sb ^ (((sb >> 9) & 1) << 5); R = (st >> 1) * 16 + swz / 64; C = (st & 1) * 32 + (swz % 64) / 2; }
__host__ __device__ __forceinline__ int perm32(int rho) { const int n = rho >> 4, i = rho & 15; return 8 * (i >> 2) + 4 * n + (i & 3); }

struct Unit { int pm, pn; };
struct Gemm { const bf16_t* A; const bf16_t* Bt; int M, N, K; };

struct StaticOrder {
    int nM, nN, nwg, G, c;
    __host__ __device__ void init(int M, int N, int G_, int c_) { nM = M / BM; nN = N / BM; nwg = nM * nN; G = G_; c = c_; }
    __host__ __device__ bool next(int i, Unit& u) const {
        const long L = (long)i * G + c; if (L >= nwg) return false;
        int wgid = (int)L; { const int q = nwg / NXCD, r = nwg % NXCD, xcd = wgid % NXCD, off = wgid / NXCD; wgid = (xcd < r ? xcd * (q + 1) : r * (q + 1) + (xcd - r) * q) + off; }
        const int nig = WGM * nN, gid = wgid / nig, fm = gid * WGM, gsz = (nM - fm) < WGM ? (nM - fm) : WGM;
        u.pm = fm + ((wgid % nig) % gsz); u.pn = (wgid % nig) / gsz; return true;
    }
    __device__ __forceinline__ void a_ready(const Unit&) const {}
    __device__ __forceinline__ void done(const Unit&) const {}
};

__device__ __forceinline__ unsigned cvt_pk_bf16(float lo, float hi) { unsigned r; asm volatile("v_cvt_pk_bf16_f32 %0, %1, %2" : "=v"(r) : "v"(lo), "v"(hi)); return r; }
typedef float f32x2 __attribute__((ext_vector_type(2)));
constexpr float RMS_EPS = 1e-6f;
__device__ __forceinline__ float row_rstd(const float* ssp, size_t row) {
    const f32x4* p = (const f32x4*)(ssp + row * 16); const f32x4 a = p[0], b = p[1], c = p[2], d = p[3];
    const float s = (((a[0] + a[1]) + (a[2] + a[3])) + ((b[0] + b[1]) + (b[2] + b[3]))) + (((c[0] + c[1]) + (c[2] + c[3])) + ((d[0] + d[1]) + (d[2] + d[3])));
    return __builtin_amdgcn_rsqf(s * (1.0f / 1024.0f) + RMS_EPS);
}
__device__ __forceinline__ float fast_sigmoid(float x) { return __builtin_amdgcn_rcpf(1.0f + __builtin_amdgcn_exp2f(-1.4426950408889634f * x)); }
struct EpiProj {
    static constexpr bool PERM = true, AFTER_DRAIN = false;
    bf16_t* O; int ldc; const float* ss;
    __device__ __forceinline__ void operator()(const f32x4 (&acc)[2][2][4][2], const Unit& u, int wr, int wc, int fr, int fq) const {
        const int row0 = u.pm * BM + wr * 64 + fr, col0 = u.pn * BM + wc * 32 + 8 * fq;
#pragma unroll
        for (int ai = 0; ai < 2; ++ai)
#pragma unroll
            for (int m = 0; m < 4; ++m) {
                const int row = row0 + ai * HALF + m * 16;
                const float rs = row_rstd(ss, (size_t)row);
                bf16_t* rowp = O + (size_t)row * ldc + col0;
#pragma unroll
                for (int bj = 0; bj < 2; ++bj) { const f32x4 v0 = acc[ai][bj][m][0] * rs, v1 = acc[ai][bj][m][1] * rs;
                    u32x4 w; w.x = cvt_pk_bf16(v0[0], v0[1]); w.y = cvt_pk_bf16(v0[2], v0[3]); w.z = cvt_pk_bf16(v1[0], v1[1]); w.w = cvt_pk_bf16(v1[2], v1[3]);
                    *(u32x4*)(rowp + bj * HALF) = w; }
            }
    }
};
struct EpiGateUp {
    static constexpr bool PERM = true, AFTER_DRAIN = false;
    bf16_t* O; int ldc; const float* ss;
    __device__ __forceinline__ void operator()(const f32x4 (&acc)[2][2][4][2], const Unit& u, int wr, int wc, int fr, int fq) const {
        const int row0 = u.pm * BM + wr * 64 + fr, col0 = u.pn * HALF + wc * 32 + 8 * fq;
#pragma unroll
        for (int ai = 0; ai < 2; ++ai)
#pragma unroll
            for (int m = 0; m < 4; ++m) {
                const int row = row0 + ai * HALF + m * 16;
                const float rs = row_rstd(ss, (size_t)row);
                float hv[8];
#pragma unroll
                for (int n = 0; n < 2; ++n)
#pragma unroll
                    for (int e = 0; e < 4; ++e) { const float g = acc[ai][0][m][n][e] * rs, up = acc[ai][1][m][n][e] * rs; hv[n * 4 + e] = g * fast_sigmoid(g) * up; }
                u32x4 w; w.x = cvt_pk_bf16(hv[0], hv[1]); w.y = cvt_pk_bf16(hv[2], hv[3]); w.z = cvt_pk_bf16(hv[4], hv[5]); w.w = cvt_pk_bf16(hv[6], hv[7]);
                *(u32x4*)(O + (size_t)row * ldc + col0) = w;
            }
    }
};
struct EpiRes {
    static constexpr bool PERM = false, AFTER_DRAIN = false;
    const float* base0; const float* base1; float* out; bf16_t* xb; float* ssn;
    __device__ __forceinline__ void operator()(const f32x4 (&acc)[2][2][4][2], const Unit& u, int wr, int wc, int fr, int fq) const {
        typedef unsigned u32x2v __attribute__((ext_vector_type(2)));
        const int col0 = u.pn * BM + wc * 32 + 4 * fq;
        const float* bp = (u.pm < 64) ? base0 + (size_t)u.pm * BM * 1024 : base1 + (size_t)(u.pm - 64) * BM * 1024;
#pragma unroll
        for (int ai = 0; ai < 2; ++ai)
#pragma unroll
            for (int m = 0; m < 4; ++m) {
                const int rl = ai * HALF + wr * 64 + m * 16 + fr; const size_t row = (size_t)u.pm * BM + rl;
                float ssq = 0.f;
#pragma unroll
                for (int bj = 0; bj < 2; ++bj)
#pragma unroll
                    for (int n = 0; n < 2; ++n) { const int c = col0 + bj * HALF + n * 16;
                        const f32x4 b = *(const f32x4*)(bp + (size_t)rl * 1024 + c); const f32x4 o = b + acc[ai][bj][m][n];
                        *(f32x4*)(out + row * 1024 + c) = o; ssq += (o[0] * o[0] + o[1] * o[1]) + (o[2] * o[2] + o[3] * o[3]);
                        u32x2v w; w.x = cvt_pk_bf16(o[0], o[1]); w.y = cvt_pk_bf16(o[2], o[3]); *(u32x2v*)(xb + row * 1024 + c) = w; }
                ssq += __shfl_xor(ssq, 16); ssq += __shfl_xor(ssq, 32);
                if (fq == 0) ssn[row * 16 + u.pn * 4 + wc] = ssq;
                asm volatile("" ::: "memory");
            }
    }
};
template <class Epi, class Sched, bool ALIGN_EPI = false, bool SP2 = false>
__device__ __forceinline__ void gemm_phase(PG8_LAS unsigned char* lds, const Gemm g, const Sched& S, const Epi& E) {
    int tid_ = threadIdx.x; asm volatile("" : "+v"(tid_));
    const int tid = tid_, wid = __builtin_amdgcn_readfirstlane(tid >> 6), lane = tid & 63, wr = wid >> 2, wc = wid & 3, fr = lane & 15, fq = lane >> 4;
    const int K = g.K, nt = K / BK;
    unsigned voffA[2], voffB[2];
#pragma unroll
    for (int i = 0; i < 2; ++i) { int R, C; stage_rc(tid * 16 + i * 8192, R, C); const int Rb = Epi::PERM ? ((R & ~31) + perm32(R & 31)) : R;
        voffA[i] = (unsigned)(R * K + C) * 2u; voffB[i] = (unsigned)(Rb * K + C) * 2u; }
    const size_t kstep = (size_t)(BK * 2);
    const size_t hstep = (size_t)HALF * K * 2;
    const size_t tstep = 2 * hstep;
    const unsigned ldsw = (unsigned)wid * 1024u;
    const int aoff = lds_byte(wr * 64 + fr, fq * 8), boff = lds_byte(wc * 32 + fr, fq * 8);
#define PG8_SA(b, h) (((b) * 2 + (h)) * HTB)
#define PG8_SB(b, h) ((4 + (b) * 2 + (h)) * HTB)
#define PG8_STAGE(bufoff, gbase, voff) do { _Pragma("unroll") for (int _i = 0; _i < 2; ++_i) \
        __builtin_amdgcn_global_load_lds((const unsigned*)((const char*)(gbase) + (voff)[_i]), (PG8_LAS unsigned*)(lds + (bufoff) + ldsw + _i * 8192), 16, 0, 0); } while (0)
#define PG8_LDA(dst, b, h) do { _Pragma("unroll") for (int m = 0; m < 4; ++m) _Pragma("unroll") for (int k = 0; k < 2; ++k) dst[m][k] = *(const PG8_LAS bf16x8*)(lds + PG8_SA(b, h) + aoff + m * 2048 + k * 1024); } while (0)
#define PG8_LDB(dst, b, h) do { _Pragma("unroll") for (int n = 0; n < 2; ++n) _Pragma("unroll") for (int k = 0; k < 2; ++k) dst[n][k] = *(const PG8_LAS bf16x8*)(lds + PG8_SB(b, h) + boff + n * 2048 + k * 1024); } while (0)
#define PG8_MMA(ai, bj, At, Bt) do { __builtin_amdgcn_s_setprio(1); _Pragma("unroll") for (int m = 0; m < 4; ++m) _Pragma("unroll") for (int n = 0; n < 2; ++n) _Pragma("unroll") for (int k = 0; k < 2; ++k) \
        acc[ai][bj][m][n] = __builtin_amdgcn_mfma_f32_16x16x32_bf16(Bt[n][k], At[m][k], acc[ai][bj][m][n], 0, 0, 0); __builtin_amdgcn_s_setprio(0); } while (0)
#define PG8_WAIT_V(n) asm volatile("s_waitcnt vmcnt(" #n ")" ::: "memory")
#define PG8_WAIT_L(n) asm volatile("s_waitcnt lgkmcnt(" #n ")" ::: "memory")
#define PG8_BAR __builtin_amdgcn_s_barrier()
#define PG8_SCHED __builtin_amdgcn_sched_barrier(0)
    Unit cur, nxt; int ui = 0;
    if (!S.next(0, cur)) return;
    f32x4 acc[2][2][4][2];
#pragma unroll
    for (int a = 0; a < 2; ++a)
#pragma unroll
        for (int b = 0; b < 2; ++b)
#pragma unroll
            for (int m = 0; m < 4; ++m)
#pragma unroll
                for (int n = 0; n < 2; ++n) acc[a][b][m][n] = (f32x4){0.f, 0.f, 0.f, 0.f};
    bf16x8 At[4][2], B0[2][2], B1[2][2];
    const char* cA = (const char*)g.A + (size_t)cur.pm * tstep; const char* cB = (const char*)g.Bt + (size_t)cur.pn * tstep;
    S.a_ready(cur);
    if constexpr (SP2) {
        PG8_STAGE(PG8_SB(0, 0), cB, voffB); PG8_STAGE(PG8_SB(0, 1), cB + hstep, voffB); PG8_STAGE(PG8_SA(0, 0), cA, voffA); PG8_STAGE(PG8_SA(0, 1), cA + hstep, voffA);
        if (wr == 1) PG8_BAR;
        PG8_WAIT_V(2); PG8_BAR;
        PG8_STAGE(PG8_SB(1, 0), cB + kstep, voffB); PG8_STAGE(PG8_SA(1, 0), cA + kstep, voffA); PG8_STAGE(PG8_SB(1, 1), cB + hstep + kstep, voffB);
        PG8_WAIT_V(6); PG8_BAR;
    } else {
        PG8_STAGE(PG8_SB(0, 0), cB, voffB); PG8_STAGE(PG8_SA(0, 0), cA, voffA); PG8_STAGE(PG8_SB(0, 1), cB + hstep, voffB); PG8_STAGE(PG8_SA(0, 1), cA + hstep, voffA);
        if (wr == 1) PG8_BAR;
        PG8_WAIT_V(4); PG8_BAR;
        PG8_STAGE(PG8_SB(1, 0), cB + kstep, voffB); PG8_STAGE(PG8_SA(1, 0), cA + kstep, voffA); PG8_STAGE(PG8_SB(1, 1), cB + hstep + kstep, voffB);
        PG8_WAIT_V(6); PG8_BAR;
    }
    for (;;) {
        const bool has_next = S.next(ui + 1, nxt);
        const char* nA = has_next ? (const char*)g.A + (size_t)nxt.pm * tstep : cA; const char* nB = has_next ? (const char*)g.Bt + (size_t)nxt.pn * tstep : cB;
        for (int t = 0; t < nt; t += 2) {
            const bool last = (t == nt - 2);
            const char* a1 = cA + (size_t)(t + 1) * kstep;
            const char* a2 = last ? nA : cA + (size_t)(t + 2) * kstep; const char* b2 = last ? nB : cB + (size_t)(t + 2) * kstep;
            const char* a3 = a2 + kstep; const char* b3 = b2 + kstep;
            if (last && has_next) S.a_ready(nxt);
            if constexpr (SP2) {
            PG8_LDB(B0, 0, 0); PG8_LDB(B1, 0, 1); PG8_SCHED; PG8_LDA(At, 0, 0); PG8_STAGE(PG8_SA(1, 1), a1 + hstep, voffA);
            PG8_WAIT_V(8); PG8_WAIT_L(0); PG8_BAR; PG8_MMA(0, 0, At, B0); PG8_MMA(0, 1, At, B1); PG8_BAR; PG8_SCHED;
            PG8_LDA(At, 0, 1); PG8_STAGE(PG8_SB(0, 0), b2, voffB); PG8_STAGE(PG8_SB(0, 1), b2 + hstep, voffB); PG8_STAGE(PG8_SA(0, 0), a2, voffA);
            PG8_WAIT_V(8); PG8_WAIT_L(0); PG8_BAR; PG8_MMA(1, 0, At, B0); PG8_MMA(1, 1, At, B1); PG8_BAR; PG8_SCHED;
            PG8_LDB(B0, 1, 0); PG8_LDB(B1, 1, 1); PG8_SCHED; PG8_LDA(At, 1, 0); PG8_STAGE(PG8_SA(0, 1), a2 + hstep, voffA);
            PG8_WAIT_V(8); PG8_WAIT_L(0); PG8_BAR; PG8_MMA(0, 0, At, B0); PG8_MMA(0, 1, At, B1); PG8_BAR; PG8_SCHED;
            PG8_LDA(At, 1, 1); PG8_STAGE(PG8_SB(1, 0), b3, voffB); PG8_STAGE(PG8_SB(1, 1), b3 + hstep, voffB); PG8_STAGE(PG8_SA(1, 0), a3, voffA);
            PG8_WAIT_V(8); PG8_WAIT_L(0); PG8_BAR; PG8_MMA(1, 0, At, B0); PG8_MMA(1, 1, At, B1); PG8_BAR; PG8_SCHED;
            } else {
            PG8_LDB(B0, 0, 0); PG8_SCHED; PG8_LDA(At, 0, 0); PG8_STAGE(PG8_SA(1, 1), a1 + hstep, voffA);
            PG8_WAIT_L(8); PG8_BAR; PG8_WAIT_L(0); PG8_MMA(0, 0, At, B0); PG8_BAR; PG8_SCHED;
            PG8_LDB(B1, 0, 1); PG8_STAGE(PG8_SB(0, 0), b2, voffB);
            PG8_BAR; PG8_WAIT_L(0); PG8_MMA(0, 1, At, B1); PG8_BAR;
            PG8_LDA(At, 0, 1); PG8_STAGE(PG8_SA(0, 0), a2, voffA);
            PG8_BAR; PG8_WAIT_L(0); PG8_MMA(1, 0, At, B0); PG8_BAR; PG8_SCHED;
            PG8_STAGE(PG8_SB(0, 1), b2 + hstep, voffB);
            PG8_WAIT_V(6); PG8_BAR; PG8_MMA(1, 1, At, B1); PG8_BAR;
            PG8_LDB(B0, 1, 0); PG8_SCHED; PG8_LDA(At, 1, 0); PG8_STAGE(PG8_SA(0, 1), a2 + hstep, voffA);
            PG8_WAIT_L(8); PG8_BAR; PG8_WAIT_L(0); PG8_MMA(0, 0, At, B0); PG8_BAR; PG8_SCHED;
            PG8_LDB(B1, 1, 1); PG8_STAGE(PG8_SB(1, 0), b3, voffB);
            PG8_BAR; PG8_WAIT_L(0); PG8_MMA(0, 1, At, B1); PG8_BAR;
            PG8_LDA(At, 1, 1); PG8_STAGE(PG8_SA(1, 0), a3, voffA);
            PG8_BAR; PG8_WAIT_L(0); PG8_MMA(1, 0, At, B0); PG8_BAR; PG8_SCHED;
            PG8_STAGE(PG8_SB(1, 1), b3 + hstep, voffB);
            PG8_WAIT_V(6); PG8_BAR; PG8_MMA(1, 1, At, B1); PG8_BAR;
            }
        }
        if constexpr (ALIGN_EPI) { if (wr == 0) PG8_BAR; }
        if constexpr (!Epi::AFTER_DRAIN) { E(acc, cur, wr, wc, fr, fq); S.done(cur); }
        if (!has_next) break;
#pragma unroll
        for (int a = 0; a < 2; ++a)
#pragma unroll
            for (int b = 0; b < 2; ++b)
#pragma unroll
                for (int m = 0; m < 4; ++m)
#pragma unroll
                    for (int n = 0; n < 2; ++n) acc[a][b][m][n] = (f32x4){0.f, 0.f, 0.f, 0.f};
        cur = nxt; cA = nA; cB = nB; ++ui;
        if constexpr (ALIGN_EPI) { if (wr == 1) PG8_BAR; }
    }
    PG8_WAIT_V(0);
    if constexpr (!ALIGN_EPI) { if (wr == 0) PG8_BAR; }
    PG8_BAR;
    if constexpr (Epi::AFTER_DRAIN) { E.fused(acc, cur, wr, wc, fr, fq, lds, wid, lane); S.done(cur); }
#undef PG8_SA
#undef PG8_SB
#undef PG8_STAGE
#undef PG8_LDA
#undef PG8_LDB
#undef PG8_MMA
#undef PG8_WAIT_V
#undef PG8_WAIT_L
#undef PG8_BAR
#undef PG8_SCHED
}
}
namespace cg = cooperative_groups;
#define LAS __attribute__((address_space(3)))
typedef unsigned short bf16;
typedef unsigned v4u __attribute__((ext_vector_type(4)));
typedef unsigned v2u __attribute__((ext_vector_type(2)));
typedef float f32x4 __attribute__((ext_vector_type(4)));
typedef float f32x2v __attribute__((ext_vector_type(2)));
typedef short bf16x8 __attribute__((ext_vector_type(8)));
typedef short bf16x4 __attribute__((ext_vector_type(4)));

constexpr int NWAVES = 8, NTHREADS = 512;
constexpr int DM = 1024, M_TOK = 18432, M_PROMPT = 16384, NCHUNK = 288, NPCH = 256;
constexpr int D_IN = 2560, D_FF = 2816, DA = 384, DB = 256, DC = 384;
constexpr int CQ = 0, CF = 384, CI = 768, CG = 1152, CU = 1536, CXR = 1792, CGR = 2176;
constexpr float EPS = 1e-6f;
constexpr size_t O_Y = 0, O_HP = 18874368, O_SRP = O_HP + 196608, O_SIP = O_SRP + 8192, O_LP = O_SIP + 8192, O_CP = O_LP + 3072,
                 O_HS = O_CP + 9216, O_SRS = O_HS + 1572864, O_SIS = O_SRS + 65536, O_LS = O_SIS + 65536, O_CS = O_LS + 24576, O_END = O_CS + 73728;
constexpr size_t MiB = 1u << 20;
constexpr size_t WS_CTL = 0, CTL_ZERO_BYTES = 1 * MiB, WS_SS = 64 * 1024, WS_TAB = 1 * MiB;
constexpr size_t WS_WIN = 2 * MiB, WS_WOUT = 12 * MiB, WS_WGU = 16 * MiB, WS_WDN = 38 * MiB, WS_SMALL = 49 * MiB;
constexpr size_t SM_LBS = 0, SM_S5A = 4096, SM_S5A64 = SM_S5A + 16384, SM_BB = SM_S5A64 + 16384, SM_CC = SM_BB + 131072, SM_WGT = SM_CC + 131072,
                 SM_WAT = SM_WGT + 262144, SM_WXT = SM_WAT + 98304, SM_SP = SM_WXT + 98304, SM_END = SM_SP + 4096;
static_assert(SM_END <= 3 * MiB, "small tables");
constexpr size_t WS_XB = 52 * MiB, WS_PROJ = 88 * MiB, WS_MIX = 178 * MiB, WS_HID = 88 * MiB;
constexpr size_t WS_HST = 214 * MiB, WS_HD = 238 * MiB, WS_S5ST = 239 * MiB, WS_LRUST = 241 * MiB, WS_SSP = 243 * MiB, WS_END = 249 * MiB;
constexpr int LDS_BYTES = 147456;

struct Args { const float* in[36]; float* out; unsigned char* ws; };
enum { I_XP = 0, I_XS, I_SH, I_SSR, I_SSI, I_SL, I_SC, I_NMIX, I_WIN, I_HLB, I_HNORM, I_S5LR, I_S5LI, I_S5DT, I_S5BR, I_S5BI, I_S5CR, I_S5CI, I_S5D, I_S5WG, I_S5BG, I_S5N,
       I_LCW, I_LCB, I_LWA, I_LBA, I_LWX, I_LBX, I_LLAM, I_LNORM, I_WOUT, I_NFFN, I_WG, I_WU, I_WD, I_NFIN };


__device__ __forceinline__ unsigned long long rfl64(unsigned long long v) { return ((unsigned long long)(unsigned)__builtin_amdgcn_readfirstlane((int)(unsigned)(v >> 32)) << 32) | (unsigned long long)(unsigned)__builtin_amdgcn_readfirstlane((int)(unsigned)v); }
__device__ __forceinline__ const float* gp(const Args& a, int k) { return (const float*)rfl64((unsigned long long)a.in[k]); }
__device__ __forceinline__ unsigned char* gws(const Args& a) { return (unsigned char*)rfl64((unsigned long long)a.ws); }
__device__ __forceinline__ float* gout(const Args& a) { return (float*)rfl64((unsigned long long)a.out); }
__device__ __forceinline__ float bf2f(bf16 b) { return __uint_as_float((unsigned)b << 16); }
__device__ __forceinline__ unsigned pk2(float lo, float hi) { return pg8::cvt_pk_bf16(lo, hi); }
__device__ __forceinline__ bf16 f2bf(float f) { return (bf16)(pk2(f, 0.f) & 0xffffu); }
__device__ __forceinline__ float sigm(float x) { return 1.0f / (1.0f + __expf(-x)); }
__device__ __forceinline__ float gelu_tanh(float x) { const float u = 0.7978845608028654f * (x + 0.044715f * x * x * x); return x * sigm(2.0f * u); }
#define LAUNDER_V(x) asm volatile("" : "+v"(x))
#define LDS_WAIT() asm volatile("s_waitcnt lgkmcnt(0)" ::: "memory")
#define WAVE_SYNC() do { asm volatile("s_waitcnt lgkmcnt(0)" ::: "memory"); __builtin_amdgcn_wave_barrier(); } while (0)
#define MFMA16(a, b, c) __builtin_amdgcn_mfma_f32_16x16x32_bf16((a), (b), (c), 0, 0, 0)
__device__ __forceinline__ float wave_sum(float v) {
#pragma unroll
    for (int o = 1; o < 64; o <<= 1) v += __shfl_xor(v, o);
    return v;
}

__device__ __forceinline__ void p0_transpose_item(const float* W, int K, int N, bf16* WT, int k0, int n0, int drow0, const float* kscale, LAS float* scr, int lane) {
#pragma unroll 8
    for (int i = 0; i < 32; ++i) { const int kk = 2 * i + (lane >> 5); float v = W[(size_t)(k0 + kk) * N + n0 + (lane & 31)]; if (kscale) v *= kscale[k0 + kk]; scr[kk * 33 + (lane & 31)] = v; }
    LDS_WAIT(); asm volatile("" ::: "memory");
    const int c = lane & 7;
#pragma unroll
    for (int j = 0; j < 4; ++j) { const int n = (lane >> 3) + 8 * j; const LAS float* s = scr + (8 * c) * 33 + n;
        v4u o; o.x = pk2(s[0 * 33], s[1 * 33]); o.y = pk2(s[2 * 33], s[3 * 33]); o.z = pk2(s[4 * 33], s[5 * 33]); o.w = pk2(s[6 * 33], s[7 * 33]);
        *(v4u*)(WT + (size_t)(drow0 + n) * K + k0 + 8 * c) = o; }
    LDS_WAIT(); asm volatile("" ::: "memory");
}

__device__ __forceinline__ void p0_prologue(const Args& a, LAS unsigned char* lds, int tid, int lane, int wave) {
    unsigned char* ws = gws(a);
    LAS float* scr = (LAS float*)(lds + wave * 16384);
    const int gw = blockIdx.x * NWAVES + wave, NGW = gridDim.x * NWAVES;
    constexpr int IT_IN = 16 * 80, IT_OUT = 16 * 32, IT_G = 16 * 88, IT_D = 44 * 32;
    constexpr int NITEMS = 2 * (IT_IN + IT_OUT + 2 * IT_G + IT_D);
    for (int it = gw; it < NITEMS; it += NGW) {
        int r = it; const int l = r / (NITEMS / 2); r -= l * (NITEMS / 2);
        if (r < IT_IN) { const int kb = r / 80, nb = r % 80;
            p0_transpose_item(gp(a, I_WIN) + (size_t)l * DM * D_IN, DM, D_IN, (bf16*)(ws + WS_WIN) + (size_t)l * D_IN * DM, 64 * kb, 32 * nb, 32 * nb, gp(a, I_NMIX) + l * DM, scr, lane); continue; }
        r -= IT_IN;
        if (r < IT_OUT) { const int kb = r / 32, nb = r % 32;
            p0_transpose_item(gp(a, I_WOUT) + (size_t)l * DM * DM, DM, DM, (bf16*)(ws + WS_WOUT) + (size_t)l * DM * DM, 64 * kb, 32 * nb, 32 * nb, nullptr, scr, lane); continue; }
        r -= IT_OUT;
        if (r < 2 * IT_G) { const int sel = r / IT_G; r -= sel * IT_G; const int kb = r / 88, nb = r % 88; const int n0 = 32 * nb;
            const int drow0 = 256 * (n0 >> 7) + 128 * sel + (n0 & 127);
            p0_transpose_item(gp(a, sel ? I_WU : I_WG) + (size_t)l * DM * D_FF, DM, D_FF, (bf16*)(ws + WS_WGU) + (size_t)l * 2 * D_FF * DM, 64 * kb, n0, drow0, gp(a, I_NFFN) + l * DM, scr, lane); continue; }
        r -= 2 * IT_G;
        { const int kb = r / 32, nb = r % 32;
            p0_transpose_item(gp(a, I_WD) + (size_t)l * D_FF * DM, D_FF, DM, (bf16*)(ws + WS_WDN) + (size_t)l * DM * D_FF, 64 * kb, 32 * nb, 32 * nb, nullptr, scr, lane); }
    }
    {
        bf16* XB = (bf16*)(ws + WS_XB); float* SS0 = (float*)(ws + WS_SSP);
        for (int m = gw; m < M_TOK; m += NGW) {
            const float* xrow = (m < M_PROMPT) ? gp(a, I_XP) + (size_t)m * DM : gp(a, I_XS) + (size_t)(m - M_PROMPT) * DM;
            const f32x4* xr = (const f32x4*)xrow + lane; float s = 0.f;
            unsigned long long* o8 = (unsigned long long*)(XB + (size_t)m * DM) + lane;
#pragma unroll
            for (int j = 0; j < 4; ++j) { const f32x4 v = xr[64 * j]; s += (v.x * v.x + v.y * v.y) + (v.z * v.z + v.w * v.w);
                o8[64 * j] = (unsigned long long)pk2(v.x, v.y) | ((unsigned long long)pk2(v.z, v.w) << 32); }
            s = wave_sum(s); if (lane < 16) SS0[(size_t)m * 16 + lane] = (lane == 0) ? s : 0.f;
        }
    }
    unsigned char* sm = ws + WS_SMALL;
    const int gt = blockIdx.x * NTHREADS + tid, NGT = gridDim.x * NTHREADS;
    for (int i = gt; i < 2 * DA; i += NGT) {
        const int l = i / DA, j = i % DA; float v = 0.f;
        if (l == 1) { const float l0 = gp(a, I_HLB)[j], l1 = gp(a, I_HLB)[DA + j]; v = 1.0f / (1.0f + expf(l0 - l1)); }
        ((float*)(sm + SM_LBS))[i] = v;
    }
    for (int i = gt; i < 2 * DC; i += NGT) { const float lam = gp(a, I_LLAM)[i]; ((float*)(sm + SM_SP))[i] = -8.0f * log1pf(expf(-lam)); }
    for (int i = gt; i < 2 * 16 * 64; i += NGT) {
        const int lg = i >> 6, p = i & 63;
        const float dt = expf(gp(a, I_S5DT)[lg]); const float lr = fminf(gp(a, I_S5LR)[i], -1e-4f), li = gp(a, I_S5LI)[i];
        const float mag = expf(lr * dt); const float are = mag * cosf(li * dt), aim = mag * sinf(li * dt);
        ((f32x2v*)(sm + SM_S5A))[i] = (f32x2v){are, aim};
        float pr = are, pi = aim;
#pragma unroll
        for (int s = 0; s < 6; ++s) { const float nr_ = pr * pr - pi * pi, ni_ = 2.0f * pr * pi; pr = nr_; pi = ni_; }
        ((f32x2v*)(sm + SM_S5A64))[i] = (f32x2v){pr, pi};
        const float den = lr * lr + li * li, nr = are - 1.0f;
        const float gre = (nr * lr + aim * li) / den, gim = (aim * lr - nr * li) / den;
        bf16* BB = (bf16*)(sm + SM_BB) + ((size_t)lg * 128 + 2 * p) * 16;
#pragma unroll
        for (int n = 0; n < 16; ++n) { const float br = gp(a, I_S5BR)[(size_t)i * 16 + n], bi = gp(a, I_S5BI)[(size_t)i * 16 + n];
            BB[n] = f2bf(gre * br - gim * bi); BB[16 + n] = f2bf(gre * bi + gim * br); }
        bf16* CC = (bf16*)(sm + SM_CC) + (size_t)lg * 16 * 128;
#pragma unroll
        for (int n = 0; n < 16; ++n) { const float cr = gp(a, I_S5CR)[((size_t)lg * 16 + n) * 64 + p], ci = gp(a, I_S5CI)[((size_t)lg * 16 + n) * 64 + p];
            CC[n * 128 + 2 * p] = f2bf(cr); CC[n * 128 + 2 * p + 1] = f2bf(-ci); }
    }
    for (int i = gt; i < 2 * 256 * 256; i += NGT) { const int l = i >> 16, n = (i >> 8) & 255, k = i & 255; ((bf16*)(sm + SM_WGT))[i] = f2bf(gp(a, I_S5WG)[((size_t)l * 256 + k) * 256 + n]); }
    for (int i = gt; i < 2 * 6 * 64 * 64; i += NGT) { const int lh = i >> 12, j = (i >> 6) & 63, ii = i & 63;
        ((bf16*)(sm + SM_WAT))[i] = f2bf(gp(a, I_LWA)[((size_t)lh * 64 + ii) * 64 + j]); ((bf16*)(sm + SM_WXT))[i] = f2bf(gp(a, I_LWX)[((size_t)lh * 64 + ii) * 64 + j]); }
}

constexpr int HG_QG = 0, HG_KG = 2048, HG_QE = 4096, HG_KET = 6144, HG_VT = 8192, HG_EGL = 10240, HG_WAVE_BYTES = 10496;
template <bool OUT>
__device__ __forceinline__ void hgrn_unit(const Args& a, int layer, int cid, int h, LAS unsigned char* wl, int lane) {
    const int fr = lane & 15, fq = lane >> 4;
    unsigned char* ws = gws(a);
    const bf16* proj = (const bf16*)(ws + WS_PROJ) + (size_t)cid * 64 * D_IN;
    const float lb = ((const float*)(ws + WS_SMALL + SM_LBS))[layer * DA + h * 64 + lane];
    const float oml = 1.0f - lb;
    float* HST = (float*)(ws + WS_HST);
    f32x4 S[4][4];
    {
        const float* s0 = nullptr;
        if (cid >= NPCH) s0 = gp(a, I_SH) + (((size_t)layer * 32 + (cid - NPCH)) * 6 + h) * 4096;
        else if (OUT && (cid & 63) != 0) s0 = HST + ((size_t)(cid - 1) * 6 + h) * 4096;
        if (s0) {
            const float* sp = s0 + (4 * fq) * 64 + fr;
#pragma unroll
            for (int dt = 0; dt < 4; ++dt)
#pragma unroll
                for (int vt = 0; vt < 4; ++vt)
#pragma unroll
                    for (int j = 0; j < 4; ++j) S[dt][vt][j] = sp[(16 * dt + j) * 64 + 16 * vt];
        } else {
#pragma unroll
            for (int dt = 0; dt < 4; ++dt)
#pragma unroll
                for (int vt = 0; vt < 4; ++vt) S[dt][vt] = (f32x4){0.f, 0.f, 0.f, 0.f};
        }
    }
    float gtot = 0.f;
    LAS bf16* QG = (LAS bf16*)(wl + HG_QG); LAS bf16* KG = (LAS bf16*)(wl + HG_KG); LAS bf16* QE = (LAS bf16*)(wl + HG_QE);
    LAS bf16* KET = (LAS bf16*)(wl + HG_KET); LAS bf16* VT = (LAS bf16*)(wl + HG_VT); LAS float* EGL = (LAS float*)(wl + HG_EGL);
    const bf16x8 zero8 = {0, 0, 0, 0, 0, 0, 0, 0};
#pragma unroll 1
    for (int sb = 0; sb < 4; ++sb) {
        const bf16* pr = proj + (size_t)sb * 16 * D_IN;
        {
            float gv[16], kv[16]; float G = 0.f;
#pragma unroll
            for (int t = 0; t < 16; ++t) { const float x = bf2f(pr[(size_t)t * D_IN + CF + h * 64 + lane]); const float sg = sigm(x);
                const float f = lb + oml * sg; kv[t] = oml * (1.0f - sg); G += __logf(f); gv[t] = G; }
            const float Gr = gv[7], Gl = gv[15];
            const float eGr = __expf(Gr), eGlr = __expf(Gl - Gr);
            EGL[lane] = __expf(Gl); gtot += Gl;
            unsigned kp[8];
#pragma unroll
            for (int t = 0; t < 16; t += 2) {
                const float e2a = __expf(Gr - gv[t]), e2b = __expf(Gr - gv[t + 1]);
                if (OUT) { const float e1a = __expf(gv[t] - Gr), e1b = __expf(gv[t + 1] - Gr);
                           const float qa = bf2f(pr[(size_t)t * D_IN + CQ + h * 64 + lane]), qb = bf2f(pr[(size_t)(t + 1) * D_IN + CQ + h * 64 + lane]);
                           QG[t * 64 + lane] = f2bf(qa * e1a); KG[t * 64 + lane] = f2bf(kv[t] * e2a); QE[t * 64 + lane] = f2bf(qa * e1a * eGr);
                           QG[(t + 1) * 64 + lane] = f2bf(qb * e1b); KG[(t + 1) * 64 + lane] = f2bf(kv[t + 1] * e2b); QE[(t + 1) * 64 + lane] = f2bf(qb * e1b * eGr); }
                kp[t >> 1] = pk2(kv[t] * e2a * eGlr, kv[t + 1] * e2b * eGlr);
            }
            *(LAS v4u*)(KET + lane * 16) = (v4u){kp[0], kp[1], kp[2], kp[3]}; *(LAS v4u*)(KET + lane * 16 + 8) = (v4u){kp[4], kp[5], kp[6], kp[7]};
            unsigned vp[8];
#pragma unroll
            for (int t = 0; t < 16; t += 2) vp[t >> 1] = (unsigned)pr[(size_t)t * D_IN + CI + h * 64 + lane] | ((unsigned)pr[(size_t)(t + 1) * D_IN + CI + h * 64 + lane] << 16);
            *(LAS v4u*)(VT + lane * 16) = (v4u){vp[0], vp[1], vp[2], vp[3]}; *(LAS v4u*)(VT + lane * 16 + 8) = (v4u){vp[4], vp[5], vp[6], vp[7]};
        }
        WAVE_SYNC();
        if (OUT) {
            f32x4 at = {0.f, 0.f, 0.f, 0.f};
#pragma unroll
            for (int kk = 0; kk < 2; ++kk) { const bf16x8 A = *(const LAS bf16x8*)(KG + fr * 64 + kk * 32 + fq * 8), B = *(const LAS bf16x8*)(QG + fr * 64 + kk * 32 + fq * 8); at = MFMA16(A, B, at); }
#pragma unroll
            for (int j = 0; j < 4; ++j) if (4 * fq + j > fr) at[j] = 0.f;
            union { bf16x8 v; unsigned u[4]; } Aatt; Aatt.u[0] = pk2(at[0], at[1]); Aatt.u[1] = pk2(at[2], at[3]); Aatt.u[2] = 0u; Aatt.u[3] = 0u;
            union { bf16x8 v; v2u h[2]; } Aq[2];
#pragma unroll
            for (int kk = 0; kk < 2; ++kk) { Aq[kk].h[0] = *(const LAS v2u*)(QE + fr * 64 + kk * 32 + 4 * fq); Aq[kk].h[1] = *(const LAS v2u*)(QE + fr * 64 + kk * 32 + 16 + 4 * fq); }
            f32x4 ov[4]; float ssq[4] = {0.f, 0.f, 0.f, 0.f};
#pragma unroll
            for (int vt = 0; vt < 4; ++vt) {
                union { bf16x8 v; v2u h[2]; } Bv; Bv.h[0] = *(const LAS v2u*)(VT + (16 * vt + fr) * 16 + 4 * fq); Bv.h[1] = (v2u){0u, 0u};
                f32x4 o = {0.f, 0.f, 0.f, 0.f};
                o = MFMA16(Aatt.v, Bv.v, o);
#pragma unroll
                for (int kk = 0; kk < 2; ++kk) { union { bf16x8 v; unsigned u[4]; } Bs;
                    Bs.u[0] = pk2(S[2 * kk][vt][0], S[2 * kk][vt][1]); Bs.u[1] = pk2(S[2 * kk][vt][2], S[2 * kk][vt][3]);
                    Bs.u[2] = pk2(S[2 * kk + 1][vt][0], S[2 * kk + 1][vt][1]); Bs.u[3] = pk2(S[2 * kk + 1][vt][2], S[2 * kk + 1][vt][3]);
                    o = MFMA16(Aq[kk].v, Bs.v, o); }
                ov[vt] = o;
#pragma unroll
                for (int j = 0; j < 4; ++j) ssq[j] += o[j] * o[j];
            }
#pragma unroll
            for (int j = 0; j < 4; ++j) { float s = ssq[j]; s += __shfl_xor(s, 1); s += __shfl_xor(s, 2); s += __shfl_xor(s, 4); s += __shfl_xor(s, 8); ssq[j] = rsqrtf(s * (1.0f / 64.0f) + EPS); }
            bf16* MIX = (bf16*)(ws + WS_MIX) + ((size_t)cid * 64 + sb * 16) * DM + h * 64;
#pragma unroll
            for (int vt = 0; vt < 4; ++vt) { const float nw = gp(a, I_HNORM)[layer * DA + h * 64 + 16 * vt + fr];
#pragma unroll
                for (int j = 0; j < 4; ++j) { const int t = 4 * fq + j; const float g = bf2f(pr[(size_t)t * D_IN + CG + h * 64 + 16 * vt + fr]);
                    MIX[(size_t)t * DM + 16 * vt + fr] = f2bf(ov[vt][j] * ssq[j] * nw * g * sigm(g)); } }
        }
        {
            bf16x8 Bv[4];
#pragma unroll
            for (int vt = 0; vt < 4; ++vt) Bv[vt] = (fq < 2) ? *(const LAS bf16x8*)(VT + (16 * vt + fr) * 16 + fq * 8) : zero8;
#pragma unroll
            for (int dt = 0; dt < 4; ++dt) { const f32x4 eg = *(const LAS f32x4*)(EGL + 16 * dt + 4 * fq);
                const bf16x8 A = (fq < 2) ? *(const LAS bf16x8*)(KET + (16 * dt + fr) * 16 + fq * 8) : zero8;
#pragma unroll
                for (int vt = 0; vt < 4; ++vt) S[dt][vt] = MFMA16(A, Bv[vt], S[dt][vt] * eg); }
        }
        WAVE_SYNC();
    }
    {
        float* dst = nullptr;
        if (OUT) { if (cid >= NPCH) dst = gout(a) + O_HS + (((size_t)layer * 32 + (cid - NPCH)) * 6 + h) * 4096;
                   else if ((cid & 63) == 63) dst = gout(a) + O_HP + (((size_t)layer * 4 + (cid >> 6)) * 6 + h) * 4096; }
        else { dst = HST + ((size_t)cid * 6 + h) * 4096; ((float*)(ws + WS_HD))[((size_t)cid * 6 + h) * 64 + lane] = __expf(gtot); }
        if (dst) {
#pragma unroll
            for (int dt = 0; dt < 4; ++dt)
#pragma unroll
                for (int vt = 0; vt < 4; ++vt)
#pragma unroll
                    for (int j = 0; j < 4; ++j) dst[(4 * fq) * 64 + fr + (16 * dt + j) * 64 + 16 * vt] = S[dt][vt][j];
        }
    }
}

constexpr int S5_UT = 0, S5_BUT = 8192, S5_HT = 73728, S5_ZT = 106496, S5_ZF = 114688;
template <bool OUT>
__device__ __forceinline__ void s5_unit(const Args& a, int layer, int cid, LAS unsigned char* lds, int tid, int lane, int wave) {
    const int fr = lane & 15, fq = lane >> 4;
    unsigned char* ws = gws(a); const unsigned char* sm = ws + WS_SMALL;
    const bf16* proj = (const bf16*)(ws + WS_PROJ) + (size_t)cid * 64 * D_IN;
    f32x2v* ST = (f32x2v*)(ws + WS_S5ST);
    LAS bf16* UT = (LAS bf16*)(lds + S5_UT); LAS float* BUT = (LAS float*)(lds + S5_BUT) + wave * 2048; LAS bf16* HT = (LAS bf16*)(lds + S5_HT) + wave * 2048;
    LAS bf16* ZT = (LAS bf16*)(lds + S5_ZT); LAS float* ZF = (LAS float*)(lds + S5_ZF);
    const bf16x8 zero8 = {0, 0, 0, 0, 0, 0, 0, 0};
    float are[2], aim[2], hre[2], him[2];
#pragma unroll
    for (int hf = 0; hf < 2; ++hf) { const int g = hf * 8 + wave; const f32x2v av = ((const f32x2v*)(sm + SM_S5A))[(layer * 16 + g) * 64 + lane]; are[hf] = av.x; aim[hf] = av.y;
        if (cid >= NPCH) { const size_t o = (((size_t)layer * 32 + (cid - NPCH)) * 16 + g) * 64 + lane; hre[hf] = gp(a, I_SSR)[o]; him[hf] = gp(a, I_SSI)[o]; }
        else if (OUT && (cid & 63) != 0) { const f32x2v hv = ST[((size_t)(cid - 1) * 16 + g) * 64 + lane]; hre[hf] = hv.x; him[hf] = hv.y; }
        else { hre[hf] = 0.f; him[hf] = 0.f; } }
#pragma unroll 1
    for (int tt = 0; tt < 4; ++tt) {
        const bf16* pr = proj + (size_t)tt * 16 * D_IN;
        { const int r = tid >> 5, c8 = (tid & 31) * 8; *(LAS v4u*)(UT + r * 256 + c8) = *(const v4u*)(pr + (size_t)r * D_IN + CU + c8); }
        LDS_WAIT(); __syncthreads();
#pragma unroll
        for (int hf = 0; hf < 2; ++hf) {
            const int g = hf * 8 + wave;
            {
                const bf16x8 A = (fq < 2) ? *(const LAS bf16x8*)(UT + fr * 256 + g * 16 + fq * 8) : zero8;
                const bf16* BB = (const bf16*)(sm + SM_BB) + ((size_t)(layer * 16 + g) * 128) * 16;
#pragma unroll
                for (int nt = 0; nt < 8; ++nt) { const bf16x8 B = (fq < 2) ? *(const bf16x8*)(BB + (16 * nt + fr) * 16 + fq * 8) : zero8;
                    f32x4 c = {0.f, 0.f, 0.f, 0.f}; c = MFMA16(A, B, c);
#pragma unroll
                    for (int j = 0; j < 4; ++j) BUT[(4 * fq + j) * 128 + 16 * nt + fr] = c[j]; }
            }
            LDS_WAIT(); __syncthreads();
            {
                float hr = hre[hf], hi = him[hf]; const float ar = are[hf], ai = aim[hf];
#pragma unroll
                for (int t = 0; t < 16; ++t) { const f32x2v b = *(const LAS f32x2v*)(BUT + t * 128 + 2 * lane);
                    const float nr = ar * hr - ai * hi + b.x, ni = ar * hi + ai * hr + b.y; hr = nr; hi = ni;
                    if (OUT) *(LAS unsigned*)(HT + t * 128 + 2 * lane) = pk2(hr, hi); }
                hre[hf] = hr; him[hf] = hi;
            }
            LDS_WAIT(); __syncthreads();
            if (OUT) {
                const bf16* CC = (const bf16*)(sm + SM_CC) + (size_t)(layer * 16 + g) * 16 * 128;
                f32x4 y = {0.f, 0.f, 0.f, 0.f};
#pragma unroll
                for (int kk = 0; kk < 4; ++kk) { const bf16x8 A = *(const LAS bf16x8*)(HT + fr * 128 + 32 * kk + 8 * fq), B = *(const bf16x8*)(CC + fr * 128 + 32 * kk + 8 * fq); y = MFMA16(A, B, y); }
                const int ch = g * 16 + fr; const float dd = gp(a, I_S5D)[layer * DB + ch];
#pragma unroll
                for (int j = 0; j < 4; ++j) { const int tok = 4 * fq + j; const float u = bf2f(UT[tok * 256 + ch]); const float z = gelu_tanh(y[j] + dd * u);
                    ZT[tok * 256 + ch] = f2bf(z); ZF[tok * 256 + ch] = z; }
            }
        }
        if (OUT) {
            LDS_WAIT(); __syncthreads();
            const bf16* WG = (const bf16*)(sm + SM_WGT) + (size_t)layer * 65536;
#pragma unroll
            for (int i = 0; i < 2; ++i) { const int nt = 2 * wave + i; f32x4 p = {0.f, 0.f, 0.f, 0.f};
#pragma unroll
                for (int kk = 0; kk < 8; ++kk) { const bf16x8 A = *(const LAS bf16x8*)(ZT + fr * 256 + 32 * kk + 8 * fq), B = *(const bf16x8*)(WG + (size_t)(16 * nt + fr) * 256 + 32 * kk + 8 * fq); p = MFMA16(A, B, p); }
                const int n = 16 * nt + fr; const float bg = gp(a, I_S5BG)[layer * DB + n];
#pragma unroll
                for (int j = 0; j < 4; ++j) { const int tok = 4 * fq + j; ZF[tok * 256 + n] = ZF[tok * 256 + n] * sigm(p[j] + bg); } }
            LDS_WAIT(); __syncthreads();
            { const int tok = tid >> 5, c8 = (tid & 31) * 8; const f32x4 v0 = *(const LAS f32x4*)(ZF + tok * 256 + c8), v1 = *(const LAS f32x4*)(ZF + tok * 256 + c8 + 4);
              float s = (v0.x * v0.x + v0.y * v0.y) + (v0.z * v0.z + v0.w * v0.w) + (v1.x * v1.x + v1.y * v1.y) + (v1.z * v1.z + v1.w * v1.w);
              s += __shfl_xor(s, 1); s += __shfl_xor(s, 2); s += __shfl_xor(s, 4); s += __shfl_xor(s, 8); s += __shfl_xor(s, 16);
              const float rs = rsqrtf(s * (1.0f / 256.0f) + EPS); const f32x4 w0 = *(const f32x4*)(gp(a, I_S5N) + layer * DB + c8), w1 = *(const f32x4*)(gp(a, I_S5N) + layer * DB + c8 + 4);
              v4u o; o.x = pk2(v0.x * rs * w0.x, v0.y * rs * w0.y); o.y = pk2(v0.z * rs * w0.z, v0.w * rs * w0.w); o.z = pk2(v1.x * rs * w1.x, v1.y * rs * w1.y); o.w = pk2(v1.z * rs * w1.z, v1.w * rs * w1.w);
              *(v4u*)((bf16*)(ws + WS_MIX) + ((size_t)cid * 64 + tt * 16 + tok) * DM + DA + c8) = o; }
        }
        __syncthreads();
    }
#pragma unroll
    for (int hf = 0; hf < 2; ++hf) { const int g = hf * 8 + wave;
        if (OUT) { if (cid >= NPCH) { const size_t o = (((size_t)layer * 32 + (cid - NPCH)) * 16 + g) * 64 + lane; gout(a)[O_SRS + o] = hre[hf]; gout(a)[O_SIS + o] = him[hf]; }
                   else if ((cid & 63) == 63) { const size_t o = (((size_t)layer * 4 + (cid >> 6)) * 16 + g) * 64 + lane; gout(a)[O_SRP + o] = hre[hf]; gout(a)[O_SIP + o] = him[hf]; } }
        else ST[((size_t)cid * 16 + g) * 64 + lane] = (f32x2v){hre[hf], him[hf]}; }
    __syncthreads();
}

constexpr int LR_XC = 0, LR_AL = 24576, LR_BL = 73728;
template <bool OUT>
__device__ __forceinline__ void lru_unit(const Args& a, int layer, int cid, LAS unsigned char* lds, int tid, int lane, int wave) {
    const int fr = lane & 15, fq = lane >> 4;
    unsigned char* ws = gws(a); const unsigned char* sm = ws + WS_SMALL;
    const bf16* proj = (const bf16*)(ws + WS_PROJ) + (size_t)cid * 64 * D_IN;
    f32x2v* ST = (f32x2v*)(ws + WS_LRUST);
    LAS bf16* XC = (LAS bf16*)(lds + LR_XC); LAS float* AL = (LAS float*)(lds + LR_AL); LAS float* BL = (LAS float*)(lds + LR_BL);
    const bool act = tid < DC; const int c = act ? tid : 0;
    float cw0 = gp(a, I_LCW)[(layer * 4 + 0) * DC + c], cw1 = gp(a, I_LCW)[(layer * 4 + 1) * DC + c], cw2 = gp(a, I_LCW)[(layer * 4 + 2) * DC + c], cw3 = gp(a, I_LCW)[(layer * 4 + 3) * DC + c];
    const float cb = gp(a, I_LCB)[layer * DC + c];
    float xm3 = 0.f, xm2 = 0.f, xm1 = 0.f, h = 0.f, P = 1.f;
    if (cid >= NPCH) { const size_t sb = (size_t)layer * 32 + (cid - NPCH); xm3 = gp(a, I_SC)[(sb * 3 + 0) * DC + c]; xm2 = gp(a, I_SC)[(sb * 3 + 1) * DC + c]; xm1 = gp(a, I_SC)[(sb * 3 + 2) * DC + c]; h = gp(a, I_SL)[sb * DC + c]; }
    else if ((cid & 63) != 0) { xm3 = bf2f(proj[-3 * D_IN + CXR + c]); xm2 = bf2f(proj[-2 * D_IN + CXR + c]); xm1 = bf2f(proj[-1 * D_IN + CXR + c]); if (OUT) h = ST[(size_t)(cid - 1) * DC + c].y; }
#pragma unroll 1
    for (int tile = 0; tile < 2; ++tile) {
        const bf16* pr = proj + (size_t)tile * 32 * D_IN;
        if (act) {
#pragma unroll 8
            for (int t = 0; t < 32; ++t) { const float x = bf2f(pr[(size_t)t * D_IN + CXR + c]); const float xc = cb + cw0 * xm3 + cw1 * xm2 + cw2 * xm1 + cw3 * x; XC[t * DC + c] = f2bf(xc); xm3 = xm2; xm2 = xm1; xm1 = x; }
        }
        LDS_WAIT(); __syncthreads();
#pragma unroll
        for (int i = 0; i < 3; ++i) { const int ntg = 3 * wave + i, hd = ntg >> 2, jn = (ntg & 3) * 16; const int ch = 16 * ntg + fr;
            const bf16* WA = (const bf16*)(sm + SM_WAT) + ((size_t)(layer * 6 + hd) * 64 + jn + fr) * 64; const bf16* WX = (const bf16*)(sm + SM_WXT) + ((size_t)(layer * 6 + hd) * 64 + jn + fr) * 64;
            const bf16x8 BA0 = *(const bf16x8*)(WA + 8 * fq), BA1 = *(const bf16x8*)(WA + 32 + 8 * fq), BX0 = *(const bf16x8*)(WX + 8 * fq), BX1 = *(const bf16x8*)(WX + 32 + 8 * fq);
            const float ba = gp(a, I_LBA)[layer * DC + ch], bx = gp(a, I_LBX)[layer * DC + ch], sp = ((const float*)(sm + SM_SP))[layer * DC + ch];
#pragma unroll
            for (int mt = 0; mt < 2; ++mt) { const bf16x8 A0 = *(const LAS bf16x8*)(XC + (16 * mt + fr) * DC + hd * 64 + 8 * fq), A1 = *(const LAS bf16x8*)(XC + (16 * mt + fr) * DC + hd * 64 + 32 + 8 * fq);
                f32x4 r = {0.f, 0.f, 0.f, 0.f}, ii = {0.f, 0.f, 0.f, 0.f};
                r = MFMA16(A0, BA0, r); r = MFMA16(A1, BA1, r); ii = MFMA16(A0, BX0, ii); ii = MFMA16(A1, BX1, ii);
#pragma unroll
                for (int j = 0; j < 4; ++j) { const int tok = 16 * mt + 4 * fq + j; const float rg = sigm(r[j] + ba), ig = sigm(ii[j] + bx); const float la = sp * rg; const float av = __expf(la);
                    const float xcv = bf2f(XC[tok * DC + ch]); AL[tok * DC + ch] = av; BL[tok * DC + ch] = sqrtf(fmaxf(-expm1f(2.0f * la), 0.f)) * ig * xcv; } } }
        LDS_WAIT(); __syncthreads();
        if (act) {
#pragma unroll 8
            for (int t = 0; t < 32; ++t) { const float av = AL[t * DC + c]; h = av * h + BL[t * DC + c]; P *= av;
                if (OUT) { const float g = bf2f(pr[(size_t)t * D_IN + CGR + c]); BL[t * DC + c] = h * gelu_tanh(g); } }
        }
        if (OUT) {
            LDS_WAIT(); __syncthreads();
            const int tok = tid >> 4, c0 = (tid & 15) * 24; float v[24]; float s = 0.f;
#pragma unroll
            for (int q = 0; q < 6; ++q) { const f32x4 x = *(const LAS f32x4*)(BL + tok * DC + c0 + 4 * q); v[4 * q] = x.x; v[4 * q + 1] = x.y; v[4 * q + 2] = x.z; v[4 * q + 3] = x.w; s += (x.x * x.x + x.y * x.y) + (x.z * x.z + x.w * x.w); }
            s += __shfl_xor(s, 1); s += __shfl_xor(s, 2); s += __shfl_xor(s, 4); s += __shfl_xor(s, 8);
            const float rs = rsqrtf(s * (1.0f / 384.0f) + EPS); const float* nw = gp(a, I_LNORM) + layer * DC + c0;
            bf16* dst = (bf16*)(ws + WS_MIX) + ((size_t)cid * 64 + tile * 32 + tok) * DM + DA + DB + c0;
#pragma unroll
            for (int q = 0; q < 3; ++q) { v4u o; o.x = pk2(v[8 * q] * rs * nw[8 * q], v[8 * q + 1] * rs * nw[8 * q + 1]); o.y = pk2(v[8 * q + 2] * rs * nw[8 * q + 2], v[8 * q + 3] * rs * nw[8 * q + 3]);
                o.z = pk2(v[8 * q + 4] * rs * nw[8 * q + 4], v[8 * q + 5] * rs * nw[8 * q + 5]); o.w = pk2(v[8 * q + 6] * rs * nw[8 * q + 6], v[8 * q + 7] * rs * nw[8 * q + 7]); *(v4u*)(dst + 8 * q) = o; }
        }
    }
    if (act) {
        if (OUT) {
            float* ho = nullptr; float* co = nullptr;
            if (cid >= NPCH) { const size_t sb = (size_t)layer * 32 + (cid - NPCH); ho = gout(a) + O_LS + sb * DC; co = gout(a) + O_CS + sb * 3 * DC; }
            else if ((cid & 63) == 63) { const size_t sb = (size_t)layer * 4 + (cid >> 6); ho = gout(a) + O_LP + sb * DC; co = gout(a) + O_CP + sb * 3 * DC; }
            if (ho) { ho[c] = h; co[c] = xm3; co[DC + c] = xm2; co[2 * DC + c] = xm1; }
        } else ST[(size_t)cid * DC + c] = (f32x2v){P, h};
    }
    __syncthreads();
}

__device__ __forceinline__ void carry_phase(const Args& a, int layer, int tid) {
    unsigned char* ws = gws(a);
    const int gt = blockIdx.x * NTHREADS + tid, NGT = gridDim.x * NTHREADS;
    for (int i = gt; i < 4 * 6 * 4096; i += NGT) {
        const int b = i / 24576, rem = i % 24576, hh = rem >> 12, e = rem & 4095, d = e >> 6;
        float* HST = (float*)(ws + WS_HST) + ((size_t)(b * 64) * 6 + hh) * 4096 + e; const float* HD = (const float*)(ws + WS_HD) + ((size_t)(b * 64) * 6 + hh) * 64 + d;
        float S = 0.f;
#pragma unroll 7
        for (int cc = 0; cc < 63; ++cc) { S = HD[(size_t)cc * 6 * 64] * S + HST[(size_t)cc * 6 * 4096]; HST[(size_t)cc * 6 * 4096] = S; }
    }
    for (int i = gt; i < 4 * 1024; i += NGT) {
        const int b = i >> 10, gp = i & 1023; const f32x2v A = ((const f32x2v*)(ws + WS_SMALL + SM_S5A64))[layer * 1024 + gp];
        f32x2v* ST = (f32x2v*)(ws + WS_S5ST) + (size_t)(b * 64) * 1024 + gp; float hr = 0.f, hi = 0.f;
#pragma unroll 7
        for (int cc = 0; cc < 63; ++cc) { const f32x2v l = ST[(size_t)cc * 1024]; const float nr = A.x * hr - A.y * hi + l.x, ni = A.x * hi + A.y * hr + l.y; hr = nr; hi = ni; ST[(size_t)cc * 1024] = (f32x2v){hr, hi}; }
    }
    for (int i = gt; i < 4 * DC; i += NGT) {
        const int b = i / DC, c = i % DC; f32x2v* ST = (f32x2v*)(ws + WS_LRUST) + (size_t)(b * 64) * DC + c; float h = 0.f;
#pragma unroll 7
        for (int cc = 0; cc < 63; ++cc) { const f32x2v l = ST[(size_t)cc * DC]; h = l.x * h + l.y; ST[(size_t)cc * DC] = (f32x2v){l.x, h}; }
    }
}

template <bool OUT>
__device__ __forceinline__ void mixer_phase(const Args& a, int layer, LAS unsigned char* lds, int tid0) {
#ifndef MIXSEL
#define MIXSEL 7
#endif
    if (MIXSEL & 1) {
        int tid = tid0; LAUNDER_V(tid); const int lane = tid & 63, wave = __builtin_amdgcn_readfirstlane(tid >> 6);
        const int gw = blockIdx.x * NWAVES + wave, NGW = gridDim.x * NWAVES;
        LAS unsigned char* wl = lds + wave * HG_WAVE_BYTES;
        if (OUT) { for (int u = gw; u < NCHUNK * 6; u += NGW) hgrn_unit<true>(a, layer, u / 6, u % 6, wl, lane); }
        else     { for (int u = gw; u < 4 * 63 * 6; u += NGW) { const int b = u / 378, rem = u % 378; hgrn_unit<false>(a, layer, b * 64 + rem / 6, rem % 6, wl, lane); } }
    }
    __syncthreads();
    const int NU = OUT ? NCHUNK : 4 * 63;
    if (MIXSEL & 2) {
        int tid = tid0; LAUNDER_V(tid); const int lane = tid & 63, wave = __builtin_amdgcn_readfirstlane(tid >> 6);
        for (int u = blockIdx.x; u < NU; u += gridDim.x) { const int cid = OUT ? u : (u / 63) * 64 + (u % 63); s5_unit<OUT>(a, layer, cid, lds, tid, lane, wave); }
    }
    if (MIXSEL & 4) {
        int tid = tid0; LAUNDER_V(tid); const int lane = tid & 63, wave = __builtin_amdgcn_readfirstlane(tid >> 6);
        for (int u = gridDim.x - 1 - blockIdx.x; u < NU; u += gridDim.x) { const int cid = OUT ? u : (u / 63) * 64 + (u % 63); lru_unit<OUT>(a, layer, cid, lds, tid, lane, wave); }
    }
}

__device__ __forceinline__ void final_norm(const Args& a, int lane, int wave) {
    const int gw = blockIdx.x * NWAVES + wave, NGW = gridDim.x * NWAVES;
    const float* SS = (const float*)(gws(a) + WS_SSP) + (size_t)4 * M_TOK * 16; const f32x4* nw = (const f32x4*)gp(a, I_NFIN) + lane;
    f32x4 w[4];
#pragma unroll
    for (int j = 0; j < 4; ++j) w[j] = nw[64 * j];
    for (int m = gw; m < M_TOK; m += NGW) { const float rs = pg8::row_rstd(SS, (size_t)m); f32x4* xr = (f32x4*)(gout(a) + (size_t)m * DM) + lane;
#pragma unroll
        for (int j = 0; j < 4; ++j) { f32x4 v = xr[64 * j]; v = v * rs * w[j]; xr[64 * j] = v; } }
}

#ifndef PHSEL
#define PHSEL 0xFF
#endif
#ifndef MK_MULTI
#define MK_MULTI 0
#endif
struct KArgs { Args a; int ph_lo, ph_hi; };
__global__ void __launch_bounds__(NTHREADS, 2) fwd_megakernel(KArgs ka) {
    extern __shared__ __attribute__((aligned(16))) unsigned char lds_raw[];
    LAS unsigned char* lds = (LAS unsigned char*)lds_raw;
    const int tid = threadIdx.x, lane = tid & 63, wave = __builtin_amdgcn_readfirstlane(tid >> 6);
    unsigned char* ws = ka.a.ws; float* const out = ka.a.out;
    const Args& a = *(const Args*)(ws + WS_TAB);
    float* SS = (float*)(ws + WS_SSP);
    bf16* XB = (bf16*)(ws + WS_XB); bf16* PROJ = (bf16*)(ws + WS_PROJ); bf16* MIX = (bf16*)(ws + WS_MIX); bf16* HID = (bf16*)(ws + WS_HID);
    int ph = 0;
#if MK_MULTI
#define SEAM() do { ++ph; } while (0)
#define RUN(b) (((PHSEL) >> (b)) & 1) && (ph >= ka.ph_lo && ph < ka.ph_hi)
#else
    cg::grid_group grid = cg::this_grid();
#define SEAM() do { asm volatile("s_waitcnt vmcnt(0) lgkmcnt(0)" ::: "memory"); grid.sync(); __builtin_amdgcn_fence(__ATOMIC_ACQUIRE, "agent"); asm volatile("s_waitcnt vmcnt(0)" ::: "memory"); ++ph; } while (0)
#define RUN(b) ((((PHSEL) >> (b)) & 1) != 0)
#endif
#ifndef STOP_AFTER
#define STOP_AFTER 999
#endif
#ifndef DUMP_OFF
#define DUMP_OFF WS_MIX
#endif
#ifndef DUMP_F32
#define DUMP_F32 0
#endif
#define PROBE() do { if (ph == STOP_AFTER) { if (DUMP_F32 == 2) { const bf16* src = (const bf16*)(ws + WS_PROJ); for (size_t i = (size_t)blockIdx.x * NTHREADS + tid; i < (size_t)M_TOK * 256; i += (size_t)gridDim.x * NTHREADS) out[i] = bf2f(src[(i >> 8) * D_IN + CU + (i & 255)]); } else if (DUMP_F32) { const float* src = (const float*)(ws + DUMP_OFF); for (size_t i = (size_t)blockIdx.x * NTHREADS + tid; i < (size_t)7602176; i += (size_t)gridDim.x * NTHREADS) out[i] = src[i]; } \
    else { const bf16* src = (const bf16*)(ws + DUMP_OFF); for (size_t i = (size_t)blockIdx.x * NTHREADS + tid; i < (size_t)M_TOK * DM; i += (size_t)gridDim.x * NTHREADS) out[i] = bf2f(src[i]); } return; } } while (0)
    if (RUN(0)) { p0_prologue(ka.a, lds, tid, lane, wave); if (blockIdx.x == 0 && tid < 38) ((unsigned long long*)(ws + WS_TAB))[tid] = (tid < 36) ? (unsigned long long)ka.a.in[tid] : (tid == 36 ? (unsigned long long)ka.a.out : (unsigned long long)ka.a.ws); }
    SEAM(); PROBE();
#pragma unroll 1
    for (int l = 0; l < 2; ++l) {
        if (RUN(1)) { pg8::Gemm g{XB, (const bf16*)(ws + WS_WIN) + (size_t)l * D_IN * DM, M_TOK, D_IN, DM}; pg8::StaticOrder S; S.init(M_TOK, D_IN, gridDim.x, blockIdx.x);
            pg8::EpiProj E{PROJ, D_IN, SS + (size_t)(2 * l) * M_TOK * 16};
            pg8::gemm_phase<pg8::EpiProj, pg8::StaticOrder, true, true>(lds, g, S, E); }
        SEAM(); PROBE();
        if (RUN(2)) mixer_phase<false>(a, l, lds, tid);
        SEAM(); PROBE();
        if (RUN(3)) carry_phase(a, l, tid);
        SEAM(); PROBE();
        if (RUN(4)) mixer_phase<true>(a, l, lds, tid);
        SEAM(); PROBE();
        if (RUN(5)) { pg8::Gemm g{MIX, (const bf16*)(ws + WS_WOUT) + (size_t)l * DM * DM, M_TOK, DM, DM}; pg8::StaticOrder S; S.init(M_TOK, DM, gridDim.x, blockIdx.x);
            pg8::EpiRes E{l == 0 ? gp(a, I_XP) : out, l == 0 ? gp(a, I_XS) : out + (size_t)M_PROMPT * DM, out, XB, SS + (size_t)(2 * l + 1) * M_TOK * 16};
            pg8::gemm_phase<pg8::EpiRes, pg8::StaticOrder, true, true>(lds, g, S, E); }
        SEAM(); PROBE();
        if (RUN(6)) { pg8::Gemm g{XB, (const bf16*)(ws + WS_WGU) + (size_t)l * 2 * D_FF * DM, M_TOK, 2 * D_FF, DM}; pg8::StaticOrder S; S.init(M_TOK, 2 * D_FF, gridDim.x, blockIdx.x);
            pg8::EpiGateUp E{HID, D_FF, SS + (size_t)(2 * l + 1) * M_TOK * 16};
            pg8::gemm_phase<pg8::EpiGateUp, pg8::StaticOrder, true, true>(lds, g, S, E); }
        SEAM(); PROBE();
        if (RUN(7)) { pg8::Gemm g{HID, (const bf16*)(ws + WS_WDN) + (size_t)l * DM * D_FF, M_TOK, DM, D_FF}; pg8::StaticOrder S; S.init(M_TOK, DM, gridDim.x, blockIdx.x);
            pg8::EpiRes E{out, out + (size_t)M_PROMPT * DM, out, XB, SS + (size_t)(2 * l + 2) * M_TOK * 16};
            pg8::gemm_phase<pg8::EpiRes, pg8::StaticOrder, true, true>(lds, g, S, E); }
        SEAM(); PROBE();
    }
    if (RUN(3)) final_norm(a, lane, wave);
}
constexpr int N_PHASES = 1 + 2 * 7 + 1;

extern "C" void kernel_launch(void* const* d_in, const int* in_sizes, int n_in, void* d_out, int out_size, void* d_ws, size_t ws_size, hipStream_t stream) {
    static int grid = 0;
    if (grid == 0) {
        if (n_in != 36 || in_sizes[0] != M_PROMPT * DM || (size_t)out_size != O_END || ws_size < WS_END) {
            fprintf(stderr, "kernel_launch: unexpected shapes: n_in %d in0 %d out %d ws %zu\n", n_in, n_in > 0 ? in_sizes[0] : -1, out_size, ws_size); }
        int dev = 0, cus = 0, per_cu = 0;
        hipGetDevice(&dev); hipDeviceGetAttribute(&cus, hipDeviceAttributeMultiprocessorCount, dev);
        if (hipFuncSetAttribute((const void*)fwd_megakernel, hipFuncAttributeMaxDynamicSharedMemorySize, LDS_BYTES) != hipSuccess) { fprintf(stderr, "kernel_launch: hipFuncSetAttribute failed\n"); grid = -1; return; }
        if (hipOccupancyMaxActiveBlocksPerMultiprocessor(&per_cu, (const void*)fwd_megakernel, NTHREADS, LDS_BYTES) != hipSuccess || per_cu < 1) { fprintf(stderr, "kernel_launch: occupancy query failed (%d)\n", per_cu); (void)hipGetLastError(); per_cu = 1; }
        grid = cus * (per_cu > 1 ? 1 : per_cu);
        fprintf(stderr, "kernel_launch: grid %d (cus %d, per_cu %d)\n", grid, cus, per_cu);
    }
    if (grid < 0) return;
    KArgs ka{};
    for (int i = 0; i < 36; ++i) ka.a.in[i] = (const float*)d_in[i];
    ka.a.out = (float*)d_out; ka.a.ws = (unsigned char*)d_ws;
#if MK_MULTI
    for (int p = 0; p < N_PHASES; ++p) { ka.ph_lo = p; ka.ph_hi = p + 1; hipLaunchKernelGGL(fwd_megakernel, dim3(grid), dim3(NTHREADS), LDS_BYTES, stream, ka); }
#else
    ka.ph_lo = 0; ka.ph_hi = N_PHASES;
    void* args[] = {&ka};
    hipError_t e = hipLaunchCooperativeKernel((const void*)fwd_megakernel, dim3(grid), dim3(NTHREADS), args, LDS_BYTES, stream);
    if (e != hipSuccess) fprintf(stderr, "cooperative launch failed: %s (grid %d)\n", hipGetErrorString(e), grid);
#endif
}
```

```cpp
#include <hip/hip_runtime.h>
#include <hip/hip_cooperative_groups.h>
#include <cstdio>
#include <cstdint>
namespace pg8 {
#define PG8_LAS __attribute__((address_space(3)))
typedef unsigned short bf16_t;
typedef short bf16x8 __attribute__((ext_vector_type(8)));
typedef float f32x4 __attribute__((ext_vector_type(4)));
typedef unsigned u32x4 __attribute__((ext_vector_type(4)));
constexpr int BM = 256, BK = 64, HALF = 128, HTB = HALF * BK * 2  , STAGE_BYTES = 8 * HTB, NXCD = 8, WGM = 8;

__host__ __device__ __forceinline__ int lds_byte(int r, int c) { const int st = (r >> 4) * 2 + (c >> 5), rr = r & 15, cc = c & 31, ob = rr * 64 + cc * 2; return st * 1024 + (ob ^ (((ob >> 9) & 1) << 5)); }
__host__ __device__ __forceinline__ void stage_rc(int b, int& R, int& C) { const int st = b / 1024, sb = b % 1024, swz = sb ^ (((sb >> 9) & 1) << 5); R = (st >> 1) * 16 + swz / 64; C = (st & 1) * 32 + (swz % 64) / 2; }
__host__ __device__ __forceinline__ int perm32(int rho) { const int n = rho >> 4, i = rho & 15; return 8 * (i >> 2) + 4 * n + (i & 3); }

struct Unit { int pm, pn; };
struct Gemm { const bf16_t* A; const bf16_t* Bt; int M, N, K; };

struct StaticOrder {
    int nM, nN, nwg, G, c;
    __host__ __device__ void init(int M, int N, int G_, int c_) { nM = M / BM; nN = N / BM; nwg = nM * nN; G = G_; c = c_; }
    __host__ __device__ bool next(int i, Unit& u) const {
        const long L = (long)i * G + c; if (L >= nwg) return false;
        int wgid = (int)L; { const int q = nwg / NXCD, r = nwg % NXCD, xcd = wgid % NXCD, off = wgid / NXCD; wgid = (xcd < r ? xcd * (q + 1) : r * (q + 1) + (xcd - r) * q) + off; }
        const int nig = WGM * nN, gid = wgid / nig, fm = gid * WGM, gsz = (nM - fm) < WGM ? (nM - fm) : WGM;
        u.pm = fm + ((wgid % nig) % gsz); u.pn = (wgid % nig) / gsz; return true;
    }
    __device__ __forceinline__ void a_ready(const Unit&) const {}
    __device__ __forceinline__ void done(const Unit&) const {}
};

__device__ __forceinline__ unsigned cvt_pk_bf16(float lo, float hi) { unsigned r; asm volatile("v_cvt_pk_bf16_f32 %0, %1, %2" : "=v"(r) : "v"(lo), "v"(hi)); return r; }
typedef float f32x2 __attribute__((ext_vector_type(2)));
constexpr float RMS_EPS = 1e-6f;
__device__ __forceinline__ float row_rstd(const float* ssp, size_t row) {
    const f32x4* p = (const f32x4*)(ssp + row * 16); const f32x4 a = p[0], b = p[1], c = p[2], d = p[3];
    const float s = (((a[0] + a[1]) + (a[2] + a[3])) + ((b[0] + b[1]) + (b[2] + b[3]))) + (((c[0] + c[1]) + (c[2] + c[3])) + ((d[0] + d[1]) + (d[2] + d[3])));
    return __builtin_amdgcn_rsqf(s * (1.0f / 1024.0f) + RMS_EPS);
}
__device__ __forceinline__ float row_rstd_q(const float* ssp, size_t row, int fq) {
    const f32x4 a = *(const f32x4*)(ssp + row * 16 + 4 * fq);
    float s = (a[0] + a[1]) + (a[2] + a[3]);
    s += __shfl_xor(s, 16); s += __shfl_xor(s, 32);
    return __builtin_amdgcn_rsqf(s * (1.0f / 1024.0f) + RMS_EPS);
}
__device__ __forceinline__ float fast_sigmoid(float x) { return __builtin_amdgcn_rcpf(1.0f + __builtin_amdgcn_exp2f(-1.4426950408889634f * x)); }
struct EpiProj {
    static constexpr bool PERM = true, AFTER_DRAIN = false;
    bf16_t* O; int ldc; const float* ss;
    __device__ __forceinline__ void operator()(const f32x4 (&acc)[2][2][4][2], const Unit& u, int wr, int wc, int fr, int fq) const {
        const int row0 = u.pm * BM + wr * 64 + fr, col0 = u.pn * BM + wc * 32 + 8 * fq;
#pragma unroll
        for (int ai = 0; ai < 2; ++ai)
#pragma unroll
            for (int m = 0; m < 4; ++m) {
                const int row = row0 + ai * HALF + m * 16;
                const float rs = row_rstd_q(ss, (size_t)row, fq);
                bf16_t* rowp = O + (size_t)row * ldc + col0;
#pragma unroll
                for (int bj = 0; bj < 2; ++bj) { const f32x4 v0 = acc[ai][bj][m][0] * rs, v1 = acc[ai][bj][m][1] * rs;
                    u32x4 w; w.x = cvt_pk_bf16(v0[0], v0[1]); w.y = cvt_pk_bf16(v0[2], v0[3]); w.z = cvt_pk_bf16(v1[0], v1[1]); w.w = cvt_pk_bf16(v1[2], v1[3]);
                    *(u32x4*)(rowp + bj * HALF) = w; }
            }
    }
};
struct EpiGateUp {
    static constexpr bool PERM = true, AFTER_DRAIN = false;
    bf16_t* O; int ldc; const float* ss;
    __device__ __forceinline__ void operator()(const f32x4 (&acc)[2][2][4][2], const Unit& u, int wr, int wc, int fr, int fq) const {
        const int row0 = u.pm * BM + wr * 64 + fr, col0 = u.pn * HALF + wc * 32 + 8 * fq;
#pragma unroll
        for (int ai = 0; ai < 2; ++ai)
#pragma unroll
            for (int m = 0; m < 4; ++m) {
                const int row = row0 + ai * HALF + m * 16;
                const float rs = row_rstd_q(ss, (size_t)row, fq);
                float hv[8];
#pragma unroll
                for (int n = 0; n < 2; ++n)
#pragma unroll
                    for (int e = 0; e < 4; ++e) { const float g = acc[ai][0][m][n][e] * rs, up = acc[ai][1][m][n][e] * rs; hv[n * 4 + e] = g * fast_sigmoid(g) * up; }
                u32x4 w; w.x = cvt_pk_bf16(hv[0], hv[1]); w.y = cvt_pk_bf16(hv[2], hv[3]); w.z = cvt_pk_bf16(hv[4], hv[5]); w.w = cvt_pk_bf16(hv[6], hv[7]);
                *(u32x4*)(O + (size_t)row * ldc + col0) = w;
            }
    }
};
struct EpiRes {
    static constexpr bool PERM = true, AFTER_DRAIN = false;
    bf16_t* xb; float* ssn;
    __device__ __forceinline__ void operator()(const f32x4 (&acc)[2][2][4][2], const Unit& u, int wr, int wc, int fr, int fq) const {
        const int col0 = u.pn * BM + wc * 32 + 8 * fq;
#pragma unroll
        for (int ai = 0; ai < 2; ++ai)
#pragma unroll
            for (int m = 0; m < 4; ++m) {
                const size_t row = (size_t)u.pm * BM + ai * HALF + wr * 64 + m * 16 + fr;
                float ssq = 0.f;
#pragma unroll
                for (int bj = 0; bj < 2; ++bj) { bf16_t* p = xb + row * 1024 + col0 + bj * HALF;
                    const u32x4 b = *(const u32x4*)p; const f32x4 a0 = acc[ai][bj][m][0], a1 = acc[ai][bj][m][1];
                    float o[8];
                    o[0] = __uint_as_float(b.x << 16) + a0[0]; o[1] = __uint_as_float(b.x & 0xffff0000u) + a0[1]; o[2] = __uint_as_float(b.y << 16) + a0[2]; o[3] = __uint_as_float(b.y & 0xffff0000u) + a0[3];
                    o[4] = __uint_as_float(b.z << 16) + a1[0]; o[5] = __uint_as_float(b.z & 0xffff0000u) + a1[1]; o[6] = __uint_as_float(b.w << 16) + a1[2]; o[7] = __uint_as_float(b.w & 0xffff0000u) + a1[3];
                    ssq += ((o[0] * o[0] + o[1] * o[1]) + (o[2] * o[2] + o[3] * o[3])) + ((o[4] * o[4] + o[5] * o[5]) + (o[6] * o[6] + o[7] * o[7]));
                    u32x4 w; w.x = cvt_pk_bf16(o[0], o[1]); w.y = cvt_pk_bf16(o[2], o[3]); w.z = cvt_pk_bf16(o[4], o[5]); w.w = cvt_pk_bf16(o[6], o[7]); *(u32x4*)p = w; }
                ssq += __shfl_xor(ssq, 16); ssq += __shfl_xor(ssq, 32);
                if (fq == 0) ssn[row * 16 + u.pn * 4 + wc] = ssq;
            }
    }
};

struct GuOrder : StaticOrder {
    int npre, lo, hi;
    __device__ __forceinline__ bool next(int i, Unit& u) const {
        const long L = (long)lo + (long)i * G + c; if (L >= hi) return false;
        if (L < npre) { u.pm = 64 + (int)L / nN; u.pn = (int)L % nN; return true; }
        int wgid = (int)(L - npre); { const int q = nwg / NXCD, r = nwg % NXCD, xcd = wgid % NXCD, off = wgid / NXCD; wgid = (xcd < r ? xcd * (q + 1) : r * (q + 1) + (xcd - r) * q) + off; }
        const int nig = WGM * nN, gid = wgid / nig, fm = gid * WGM, gsz = (nM - fm) < WGM ? (nM - fm) : WGM;
        u.pm = fm + ((wgid % nig) % gsz); u.pn = (wgid % nig) / gsz; return true;
    }
    __device__ __forceinline__ void a_ready(const Unit&) const {}
    __device__ __forceinline__ void done(const Unit&) const {}
};
struct SampleOrder {
    int c0, c;
    __device__ __forceinline__ bool next(int i, Unit& u) const { if (i != 0 || c < c0 || c >= c0 + 32) return false; u.pm = 64 + (c - c0) / 4; u.pn = (c - c0) % 4; return true; }
    __device__ __forceinline__ void a_ready(const Unit&) const {}
    __device__ __forceinline__ void done(const Unit&) const {}
};
template <class Epi, class Sched, bool ALIGN_EPI = false, bool SP2 = false>
__device__ __forceinline__ void gemm_phase(PG8_LAS unsigned char* lds, const Gemm g, const Sched& S, const Epi& E) {
    int tid_ = threadIdx.x; asm volatile("" : "+v"(tid_));
    const int tid = tid_, wid = __builtin_amdgcn_readfirstlane(tid >> 6), lane = tid & 63, wr = wid >> 2, wc = wid & 3, fr = lane & 15, fq = lane >> 4;
    const int K = g.K, nt = K / BK;
    unsigned voffA[2], voffB[2];
#pragma unroll
    for (int i = 0; i < 2; ++i) { int R, C; stage_rc(tid * 16 + i * 8192, R, C); const int Rb = Epi::PERM ? ((R & ~31) + perm32(R & 31)) : R;
        voffA[i] = (unsigned)(R * K + C) * 2u; voffB[i] = (unsigned)(Rb * K + C) * 2u; }
    const size_t kstep = (size_t)(BK * 2);
    const size_t hstep = (size_t)HALF * K * 2;
    const size_t tstep = 2 * hstep;
    const unsigned ldsw = (unsigned)wid * 1024u;
    const int aoff = lds_byte(wr * 64 + fr, fq * 8), boff = lds_byte(wc * 32 + fr, fq * 8);
#define PG8_SA(b, h) (((b) * 2 + (h)) * HTB)
#define PG8_SB(b, h) ((4 + (b) * 2 + (h)) * HTB)
#define PG8_STAGE(bufoff, gbase, voff) do { _Pragma("unroll") for (int _i = 0; _i < 2; ++_i) \
        __builtin_amdgcn_global_load_lds((const unsigned*)((const char*)(gbase) + (voff)[_i]), (PG8_LAS unsigned*)(lds + (bufoff) + ldsw + _i * 8192), 16, 0, 0); } while (0)
#define PG8_LDA(dst, b, h) do { _Pragma("unroll") for (int m = 0; m < 4; ++m) _Pragma("unroll") for (int k = 0; k < 2; ++k) dst[m][k] = *(const PG8_LAS bf16x8*)(lds + PG8_SA(b, h) + aoff + m * 2048 + k * 1024); } while (0)
#define PG8_LDB(dst, b, h) do { _Pragma("unroll") for (int n = 0; n < 2; ++n) _Pragma("unroll") for (int k = 0; k < 2; ++k) dst[n][k] = *(const PG8_LAS bf16x8*)(lds + PG8_SB(b, h) + boff + n * 2048 + k * 1024); } while (0)
#define PG8_MMA(ai, bj, At, Bt) do { __builtin_amdgcn_s_setprio(1); _Pragma("unroll") for (int m = 0; m < 4; ++m) _Pragma("unroll") for (int n = 0; n < 2; ++n) _Pragma("unroll") for (int k = 0; k < 2; ++k) \
        acc[ai][bj][m][n] = __builtin_amdgcn_mfma_f32_16x16x32_bf16(Bt[n][k], At[m][k], acc[ai][bj][m][n], 0, 0, 0); __builtin_amdgcn_s_setprio(0); } while (0)
#define PG8_WAIT_V(n) asm volatile("s_waitcnt vmcnt(" #n ")" ::: "memory")
#define PG8_WAIT_L(n) asm volatile("s_waitcnt lgkmcnt(" #n ")" ::: "memory")
#define PG8_BAR __builtin_amdgcn_s_barrier()
#define PG8_SCHED __builtin_amdgcn_sched_barrier(0)
    Unit cur, nxt; int ui = 0;
    if (!S.next(0, cur)) return;
    f32x4 acc[2][2][4][2];
#pragma unroll
    for (int a = 0; a < 2; ++a)
#pragma unroll
        for (int b = 0; b < 2; ++b)
#pragma unroll
            for (int m = 0; m < 4; ++m)
#pragma unroll
                for (int n = 0; n < 2; ++n) acc[a][b][m][n] = (f32x4){0.f, 0.f, 0.f, 0.f};
    bf16x8 At[4][2], B0[2][2], B1[2][2];
    const char* cA = (const char*)g.A + (size_t)cur.pm * tstep; const char* cB = (const char*)g.Bt + (size_t)cur.pn * tstep;
    S.a_ready(cur);
    if constexpr (SP2) {
        PG8_STAGE(PG8_SB(0, 0), cB, voffB); PG8_STAGE(PG8_SB(0, 1), cB + hstep, voffB); PG8_STAGE(PG8_SA(0, 0), cA, voffA); PG8_STAGE(PG8_SA(0, 1), cA + hstep, voffA);
        if (wr == 1) PG8_BAR;
        PG8_WAIT_V(2); PG8_BAR;
        PG8_STAGE(PG8_SB(1, 0), cB + kstep, voffB); PG8_STAGE(PG8_SA(1, 0), cA + kstep, voffA); PG8_STAGE(PG8_SB(1, 1), cB + hstep + kstep, voffB);
        PG8_WAIT_V(6); PG8_BAR;
    } else {
        PG8_STAGE(PG8_SB(0, 0), cB, voffB); PG8_STAGE(PG8_SA(0, 0), cA, voffA); PG8_STAGE(PG8_SB(0, 1), cB + hstep, voffB); PG8_STAGE(PG8_SA(0, 1), cA + hstep, voffA);
        if (wr == 1) PG8_BAR;
        PG8_WAIT_V(4); PG8_BAR;
        PG8_STAGE(PG8_SB(1, 0), cB + kstep, voffB); PG8_STAGE(PG8_SA(1, 0), cA + kstep, voffA); PG8_STAGE(PG8_SB(1, 1), cB + hstep + kstep, voffB);
        PG8_WAIT_V(6); PG8_BAR;
    }
    for (;;) {
        const bool has_next = S.next(ui + 1, nxt);
        const char* nA = has_next ? (const char*)g.A + (size_t)nxt.pm * tstep : cA; const char* nB = has_next ? (const char*)g.Bt + (size_t)nxt.pn * tstep : cB;
        for (int t = 0; t < nt; t += 2) {
            const bool last = (t == nt - 2);
            const char* a1 = cA + (size_t)(t + 1) * kstep;
            const char* a2 = last ? nA : cA + (size_t)(t + 2) * kstep; const char* b2 = last ? nB : cB + (size_t)(t + 2) * kstep;
            const char* a3 = a2 + kstep; const char* b3 = b2 + kstep;
            if (last && has_next) S.a_ready(nxt);
            if constexpr (SP2) {
            PG8_LDB(B0, 0, 0); PG8_LDB(B1, 0, 1); PG8_SCHED; PG8_LDA(At, 0, 0); PG8_STAGE(PG8_SA(1, 1), a1 + hstep, voffA);
            PG8_WAIT_V(8); PG8_WAIT_L(0); PG8_BAR; PG8_MMA(0, 0, At, B0); PG8_MMA(0, 1, At, B1); PG8_BAR; PG8_SCHED;
            PG8_LDA(At, 0, 1); PG8_STAGE(PG8_SB(0, 0), b2, voffB); PG8_STAGE(PG8_SB(0, 1), b2 + hstep, voffB); PG8_STAGE(PG8_SA(0, 0), a2, voffA);
            PG8_WAIT_V(8); PG8_WAIT_L(0); PG8_BAR; PG8_MMA(1, 0, At, B0); PG8_MMA(1, 1, At, B1); PG8_BAR; PG8_SCHED;
            PG8_LDB(B0, 1, 0); PG8_LDB(B1, 1, 1); PG8_SCHED; PG8_LDA(At, 1, 0); PG8_STAGE(PG8_SA(0, 1), a2 + hstep, voffA);
            PG8_WAIT_V(8); PG8_WAIT_L(0); PG8_BAR; PG8_MMA(0, 0, At, B0); PG8_MMA(0, 1, At, B1); PG8_BAR; PG8_SCHED;
            PG8_LDA(At, 1, 1); PG8_STAGE(PG8_SB(1, 0), b3, voffB); PG8_STAGE(PG8_SB(1, 1), b3 + hstep, voffB); PG8_STAGE(PG8_SA(1, 0), a3, voffA);
            PG8_WAIT_V(8); PG8_WAIT_L(0); PG8_BAR; PG8_MMA(1, 0, At, B0); PG8_MMA(1, 1, At, B1); PG8_BAR; PG8_SCHED;
            } else {
            PG8_LDB(B0, 0, 0); PG8_SCHED; PG8_LDA(At, 0, 0); PG8_STAGE(PG8_SA(1, 1), a1 + hstep, voffA);
            PG8_WAIT_L(8); PG8_BAR; PG8_WAIT_L(0); PG8_MMA(0, 0, At, B0); PG8_BAR; PG8_SCHED;
            PG8_LDB(B1, 0, 1); PG8_STAGE(PG8_SB(0, 0), b2, voffB);
            PG8_BAR; PG8_WAIT_L(0); PG8_MMA(0, 1, At, B1); PG8_BAR;
            PG8_LDA(At, 0, 1); PG8_STAGE(PG8_SA(0, 0), a2, voffA);
            PG8_BAR; PG8_WAIT_L(0); PG8_MMA(1, 0, At, B0); PG8_BAR; PG8_SCHED;
            PG8_STAGE(PG8_SB(0, 1), b2 + hstep, voffB);
            PG8_WAIT_V(6); PG8_BAR; PG8_MMA(1, 1, At, B1); PG8_BAR;
            PG8_LDB(B0, 1, 0); PG8_SCHED; PG8_LDA(At, 1, 0); PG8_STAGE(PG8_SA(0, 1), a2 + hstep, voffA);
            PG8_WAIT_L(8); PG8_BAR; PG8_WAIT_L(0); PG8_MMA(0, 0, At, B0); PG8_BAR; PG8_SCHED;
            PG8_LDB(B1, 1, 1); PG8_STAGE(PG8_SB(1, 0), b3, voffB);
            PG8_BAR; PG8_WAIT_L(0); PG8_MMA(0, 1, At, B1); PG8_BAR;
            PG8_LDA(At, 1, 1); PG8_STAGE(PG8_SA(1, 0), a3, voffA);
            PG8_BAR; PG8_WAIT_L(0); PG8_MMA(1, 0, At, B0); PG8_BAR; PG8_SCHED;
            PG8_STAGE(PG8_SB(1, 1), b3 + hstep, voffB);
            PG8_WAIT_V(6); PG8_BAR; PG8_MMA(1, 1, At, B1); PG8_BAR;
            }
        }
        if constexpr (ALIGN_EPI) { if (wr == 0) PG8_BAR; }
        if constexpr (!Epi::AFTER_DRAIN) { E(acc, cur, wr, wc, fr, fq); S.done(cur); }
        if (!has_next) break;
#pragma unroll
        for (int a = 0; a < 2; ++a)
#pragma unroll
            for (int b = 0; b < 2; ++b)
#pragma unroll
                for (int m = 0; m < 4; ++m)
#pragma unroll
                    for (int n = 0; n < 2; ++n) acc[a][b][m][n] = (f32x4){0.f, 0.f, 0.f, 0.f};
        cur = nxt; cA = nA; cB = nB; ++ui;
        if constexpr (ALIGN_EPI) { if (wr == 1) PG8_BAR; }
    }
    PG8_WAIT_V(0);
    if constexpr (!ALIGN_EPI) { if (wr == 0) PG8_BAR; }
    PG8_BAR;
    if constexpr (Epi::AFTER_DRAIN) { E.fused(acc, cur, wr, wc, fr, fq, lds, wid, lane); S.done(cur); }
#undef PG8_SA
#undef PG8_SB
#undef PG8_STAGE
#undef PG8_LDA
#undef PG8_LDB
#undef PG8_MMA
#undef PG8_WAIT_V
#undef PG8_WAIT_L
#undef PG8_BAR
#undef PG8_SCHED
}
}
namespace cg = cooperative_groups;
#define LAS __attribute__((address_space(3)))
typedef unsigned short bf16;
typedef unsigned v4u __attribute__((ext_vector_type(4)));
typedef unsigned v2u __attribute__((ext_vector_type(2)));
typedef float f32x4 __attribute__((ext_vector_type(4)));
typedef float f32x2v __attribute__((ext_vector_type(2)));
typedef short bf16x8 __attribute__((ext_vector_type(8)));
typedef short bf16x4 __attribute__((ext_vector_type(4)));

constexpr int NWAVES = 8, NTHREADS = 512;
constexpr int DM = 1024, M_TOK = 18432, M_PROMPT = 16384, NCHUNK = 288, NPCH = 256;
constexpr int D_IN = 2560, D_FF = 2816, DA = 384, DB = 256, DC = 384;
constexpr int CQ = 0, CF = 384, CI = 768, CG = 1152, CU = 1536, CXR = 1792, CGR = 2176;
constexpr float EPS = 1e-6f;
constexpr size_t O_Y = 0, O_HP = 18874368, O_SRP = O_HP + 196608, O_SIP = O_SRP + 8192, O_LP = O_SIP + 8192, O_CP = O_LP + 3072,
                 O_HS = O_CP + 9216, O_SRS = O_HS + 1572864, O_SIS = O_SRS + 65536, O_LS = O_SIS + 65536, O_CS = O_LS + 24576, O_END = O_CS + 73728;
constexpr size_t MiB = 1u << 20;
constexpr size_t WS_CTL = 0, CTL_ZERO_BYTES = 1 * MiB, WS_SS = 64 * 1024, WS_TAB = 1 * MiB;
constexpr size_t WS_WIN = 2 * MiB, WS_WOUT = 12 * MiB, WS_WGU = 16 * MiB, WS_WDN = 38 * MiB, WS_SMALL = 49 * MiB;
constexpr size_t SM_LBS = 0, SM_S5A = 4096, SM_S5A64 = SM_S5A + 16384, SM_BB = SM_S5A64 + 16384, SM_CC = SM_BB + 131072, SM_WGT = SM_CC + 131072,
                 SM_WAT = SM_WGT + 262144, SM_WXT = SM_WAT + 98304, SM_SP = SM_WXT + 98304, SM_END = SM_SP + 4096;
static_assert(SM_END <= 3 * MiB, "small tables");
constexpr size_t WS_XB = 52 * MiB, WS_PROJ = 88 * MiB, WS_MIX = 178 * MiB, WS_HID = 88 * MiB;
constexpr size_t WS_HST = 214 * MiB, WS_HD = 238 * MiB, WS_S5ST = 239 * MiB, WS_LRUST = 241 * MiB, WS_SSP = 243 * MiB, WS_END = 249 * MiB;
constexpr int LDS_BYTES = 147456, XB_LDS_OFF = 147456 - 256;

struct Args { const float* in[36]; float* out; unsigned char* ws; };
enum { I_XP = 0, I_XS, I_SH, I_SSR, I_SSI, I_SL, I_SC, I_NMIX, I_WIN, I_HLB, I_HNORM, I_S5LR, I_S5LI, I_S5DT, I_S5BR, I_S5BI, I_S5CR, I_S5CI, I_S5D, I_S5WG, I_S5BG, I_S5N,
       I_LCW, I_LCB, I_LWA, I_LBA, I_LWX, I_LBX, I_LLAM, I_LNORM, I_WOUT, I_NFFN, I_WG, I_WU, I_WD, I_NFIN };


__device__ __forceinline__ unsigned long long rfl64(unsigned long long v) { return ((unsigned long long)(unsigned)__builtin_amdgcn_readfirstlane((int)(unsigned)(v >> 32)) << 32) | (unsigned long long)(unsigned)__builtin_amdgcn_readfirstlane((int)(unsigned)v); }
#define GAS __attribute__((address_space(1)))
typedef __attribute__((address_space(4))) const unsigned char KSEG;
__device__ __forceinline__ const Args& kargs() { KSEG* p = (KSEG*)__builtin_amdgcn_kernarg_segment_ptr(); asm volatile("" : "+s"(p)); return *(const Args*)(const void*)p; }
__device__ __forceinline__ const float* gp(const Args& a, int k) { return (const float*)(const GAS float*)a.in[k]; }
__device__ __forceinline__ unsigned char* gws(const Args& a) { return (unsigned char*)(GAS unsigned char*)a.ws; }
__device__ __forceinline__ float* gout(const Args& a) { return (float*)(GAS float*)a.out; }
__device__ __forceinline__ float bf2f(bf16 b) { return __uint_as_float((unsigned)b << 16); }
__device__ __forceinline__ unsigned pk2(float lo, float hi) { return pg8::cvt_pk_bf16(lo, hi); }
__device__ __forceinline__ bf16 f2bf(float f) { return (bf16)(pk2(f, 0.f) & 0xffffu); }
__device__ __forceinline__ float sigm(float x) { return __builtin_amdgcn_rcpf(1.0f + __builtin_amdgcn_exp2f(-1.4426950408889634f * x)); }
__device__ __forceinline__ float gelu_tanh(float x) { const float u = 0.7978845608028654f * (x + 0.044715f * x * x * x); return x * sigm(2.0f * u); }
#define LAUNDER_V(x) asm volatile("" : "+v"(x))
#define BSYNC() asm volatile("s_waitcnt lgkmcnt(0)\n\ts_barrier" ::: "memory")
#define LDS_WAIT() asm volatile("s_waitcnt lgkmcnt(0)" ::: "memory")
#define WAVE_SYNC() do { asm volatile("s_waitcnt lgkmcnt(0)" ::: "memory"); __builtin_amdgcn_wave_barrier(); } while (0)
#define MFMA16(a, b, c) __builtin_amdgcn_mfma_f32_16x16x32_bf16((a), (b), (c), 0, 0, 0)
__device__ __forceinline__ float wave_sum(float v) {
#pragma unroll
    for (int o = 1; o < 64; o <<= 1) v += __shfl_xor(v, o);
    return v;
}

#define XB_TMO      128
#define XB_XCNT(j)  (256  + 64 * (j))
#define XB_XSUB(j)  (1280 + 64 * (j))
#define XB_XGEN(j)  (2304 + 64 * (j))
#define XB_TOP      3328
#define XB_TOPGEN   3392
#define XCD_BAR_WORDS 3456
#define XB_SPIN_CAP (1u << 18)

__device__ __forceinline__ unsigned xb_ld(unsigned* p)              { return __hip_atomic_load(p, __ATOMIC_RELAXED, __HIP_MEMORY_SCOPE_AGENT); }
__device__ __forceinline__ unsigned xb_add(unsigned* p, unsigned v) { return __hip_atomic_fetch_add(p, v, __ATOMIC_RELAXED, __HIP_MEMORY_SCOPE_AGENT); }
__device__ __forceinline__ unsigned xb_xcc_id() { return (unsigned)__builtin_amdgcn_s_getreg((3 << 11) | 20) & 0xFu; }
#define XB_SPIN(cond, bar) do { unsigned _sp = 0; while (cond) { __builtin_amdgcn_s_sleep(1); \
    if ((++_sp & 255u) == 0u) { if (xb_ld(&(bar)[XB_TMO])) break; if (_sp > XB_SPIN_CAP) { atomicAdd(&(bar)[XB_TMO], 1u); break; } } } } while (0)

struct XcdBarrier {
    unsigned* bar; unsigned x;
    volatile LAS unsigned* st;
};

__device__ __forceinline__ XcdBarrier xcd_barrier_post(unsigned* bar, volatile LAS unsigned* st) {
    XcdBarrier b; b.bar = bar; b.x = xb_xcc_id(); b.st = st;
    if (threadIdx.x == 0) (void)xb_add(&bar[XB_XCNT(b.x)], 1u);
    return b;
}
__device__ __forceinline__ void xcd_barrier_complete(unsigned* bar, unsigned x, unsigned& nloc, unsigned& nx) {
    const unsigned G = gridDim.x * gridDim.y * gridDim.z;
    unsigned sum, cnt, mine, sp = 0u;
    for (;;) {
        sum = 0u; cnt = 0u; mine = 0u;
#pragma unroll
        for (unsigned j = 0; j < 16; ++j) { const unsigned c = xb_ld(&bar[XB_XCNT(j)]); sum += c; cnt += (c > 0u) ? 1u : 0u; mine = (j == x) ? c : mine; }
        if (sum == G) break;
        __builtin_amdgcn_s_sleep(1);
        if ((++sp & 255u) == 0u) { if (xb_ld(&bar[XB_TMO])) break; if (sp > XB_SPIN_CAP) { atomicAdd(&bar[XB_TMO], 1u); break; } }
    }
    nloc = mine > 0u ? mine : 1u; nx = cnt > 0u ? cnt : 1u;
}

__device__ __forceinline__ void xcd_barrier(const XcdBarrier& b) {
    asm volatile("s_waitcnt vmcnt(0)" ::: "memory");
    __syncthreads();
    if (threadIdx.x == 0) {
        unsigned* bar = b.bar;
        __builtin_amdgcn_s_waitcnt(0);
        unsigned nloc = b.st[0], nx = b.st[1];
        if (nloc == 0u) { xcd_barrier_complete(bar, b.x, nloc, nx); b.st[0] = nloc; b.st[1] = nx; }
        const unsigned old = xb_add(&bar[XB_XSUB(b.x)], 1u);
        const unsigned gen = old / nloc;
        if (old + 1u == (gen + 1u) * nloc) {
            __builtin_amdgcn_fence(__ATOMIC_RELEASE, "agent");
            asm volatile("s_waitcnt vmcnt(0)" ::: "memory");
            const unsigned og = xb_add(&bar[XB_TOP], 1u);
            const unsigned tg = og / nx;
            if (og + 1u == (tg + 1u) * nx) xb_add(&bar[XB_TOPGEN], 1u);
            else XB_SPIN(xb_ld(&bar[XB_TOPGEN]) == tg, bar);
            __builtin_amdgcn_fence(__ATOMIC_ACQUIRE, "agent");
            xb_add(&bar[XB_XGEN(b.x)], 1u);
            asm volatile("s_waitcnt vmcnt(0)" ::: "memory");
        } else {
            XB_SPIN(xb_ld(&bar[XB_XGEN(b.x)]) == gen, bar);
            __builtin_amdgcn_fence(__ATOMIC_ACQUIRE, "agent");
            asm volatile("s_waitcnt vmcnt(0)" ::: "memory");
        }
    }
    __syncthreads();
}

__device__ __forceinline__ void p0_transpose_item(const float* W, int K, int N, bf16* WT, int k0, int n0, int drow0, const float* kscale, LAS float* scr, int lane) {
    const int c = lane & 7;
    f32x4 ks0 = {1.f, 1.f, 1.f, 1.f}, ks1 = {1.f, 1.f, 1.f, 1.f};
    if (kscale) { ks0 = *(const f32x4*)(kscale + k0 + 8 * c); ks1 = *(const f32x4*)(kscale + k0 + 8 * c + 4); }
    const float* wp = W + (size_t)(k0 + (lane >> 5)) * N + n0 + (lane & 31);
#pragma unroll
    for (int i = 0; i < 32; ++i) scr[(2 * i + (lane >> 5)) * 33 + (lane & 31)] = wp[(size_t)(2 * i) * N];
    LDS_WAIT(); asm volatile("" ::: "memory");
#pragma unroll
    for (int j = 0; j < 4; ++j) { const int n = (lane >> 3) + 8 * j; const LAS float* s = scr + (8 * c) * 33 + n;
        v4u o; o.x = pk2(s[0 * 33] * ks0.x, s[1 * 33] * ks0.y); o.y = pk2(s[2 * 33] * ks0.z, s[3 * 33] * ks0.w); o.z = pk2(s[4 * 33] * ks1.x, s[5 * 33] * ks1.y); o.w = pk2(s[6 * 33] * ks1.z, s[7 * 33] * ks1.w);
        *(v4u*)(WT + (size_t)(drow0 + n) * K + k0 + 8 * c) = o; }
    LDS_WAIT(); asm volatile("" ::: "memory");
}

__device__ __forceinline__ void convert_weights(const Args& a, int l, LAS unsigned char* lds, int lane, int wave, int w, int nw, int part = 4  ) {
    unsigned char* ws = gws(a);
    LAS float* scr = (LAS float*)(lds + wave * 16384);
    constexpr int IT_IN = 16 * 80, IT_OUT = 16 * 32, IT_G = 16 * 88, IT_D = 44 * 32;
    constexpr int NITEMS = IT_IN + IT_OUT + 2 * IT_G + IT_D;
    const int it_lo = part == 4 ? 0 : (part == 0 ? 0 : part == 1 ? IT_IN : part == 2 ? IT_IN + IT_OUT : IT_IN + IT_OUT + 2 * IT_G);
    const int it_hi = part == 4 ? NITEMS : (part == 0 ? IT_IN : part == 1 ? IT_IN + IT_OUT : part == 2 ? IT_IN + IT_OUT + 2 * IT_G : NITEMS);
    for (int it = it_lo + w; it < it_hi; it += nw) {
        int r = it;
        if (r < IT_IN) { const int kb = r / 80, nb = r % 80;
            p0_transpose_item(gp(a, I_WIN) + (size_t)l * DM * D_IN, DM, D_IN, (bf16*)(ws + WS_WIN) + (size_t)l * D_IN * DM, 64 * kb, 32 * nb, 32 * nb, gp(a, I_NMIX) + l * DM, scr, lane); continue; }
        r -= IT_IN;
        if (r < IT_OUT) { const int kb = r / 32, nb = r % 32;
            p0_transpose_item(gp(a, I_WOUT) + (size_t)l * DM * DM, DM, DM, (bf16*)(ws + WS_WOUT) + (size_t)l * DM * DM, 64 * kb, 32 * nb, 32 * nb, nullptr, scr, lane); continue; }
        r -= IT_OUT;
        if (r < 2 * IT_G) { const int sel = r / IT_G; r -= sel * IT_G; const int kb = r / 88, nb = r % 88; const int n0 = 32 * nb;
            const int drow0 = 256 * (n0 >> 7) + 128 * sel + (n0 & 127);
            p0_transpose_item(gp(a, sel ? I_WU : I_WG) + (size_t)l * DM * D_FF, DM, D_FF, (bf16*)(ws + WS_WGU) + (size_t)l * 2 * D_FF * DM, 64 * kb, n0, drow0, gp(a, I_NFFN) + l * DM, scr, lane); continue; }
        r -= 2 * IT_G;
        { const int kb = r / 32, nb = r % 32;
            p0_transpose_item(gp(a, I_WD) + (size_t)l * D_FF * DM, D_FF, DM, (bf16*)(ws + WS_WDN) + (size_t)l * DM * D_FF, 64 * kb, 32 * nb, 32 * nb, nullptr, scr, lane); }
    }
}

__device__ __forceinline__ void p0_prologue(const Args& a, LAS unsigned char* lds, int tid, int lane, int wave) {
    unsigned char* ws = gws(a);
    LAS float* scr = (LAS float*)(lds + wave * 16384);
    const int gw = blockIdx.x * NWAVES + wave, NGW = gridDim.x * NWAVES;
    convert_weights(a, 0, lds, lane, wave, gw, NGW, 0);
    {
        bf16* XB = (bf16*)(ws + WS_XB); float* SS0 = (float*)(ws + WS_SSP);
        for (int m0 = gw; m0 < M_TOK; m0 += 3 * NGW) {
            f32x4 v[3][4];
#pragma unroll
            for (int r = 0; r < 3; ++r) { const int m = m0 + r * NGW; if (m < M_TOK) { const float* xrow = (m < M_PROMPT) ? gp(a, I_XP) + (size_t)m * DM : gp(a, I_XS) + (size_t)(m - M_PROMPT) * DM; const f32x4* xr = (const f32x4*)xrow + lane;
#pragma unroll
                for (int j = 0; j < 4; ++j) v[r][j] = xr[64 * j]; } }
#pragma unroll
            for (int r = 0; r < 3; ++r) { const int m = m0 + r * NGW; if (m < M_TOK) { float s = 0.f; unsigned long long* o8 = (unsigned long long*)(XB + (size_t)m * DM) + lane;
#pragma unroll
                for (int j = 0; j < 4; ++j) { const f32x4 x = v[r][j]; s += (x.x * x.x + x.y * x.y) + (x.z * x.z + x.w * x.w); o8[64 * j] = (unsigned long long)pk2(x.x, x.y) | ((unsigned long long)pk2(x.z, x.w) << 32); }
                s = wave_sum(s); if (lane < 16) SS0[(size_t)m * 16 + lane] = (lane == 0) ? s : 0.f; } }
        }
    }
    unsigned char* sm = ws + WS_SMALL;
    const int NGT = gridDim.x * NTHREADS, gt = NGT - 1 - (blockIdx.x * NTHREADS + tid);
    for (int i = gt; i < 2 * DA; i += NGT) {
        const int l = i / DA, j = i % DA; float v = 0.f;
        if (l == 1) { const float l0 = gp(a, I_HLB)[j], l1 = gp(a, I_HLB)[DA + j]; v = 1.0f / (1.0f + expf(l0 - l1)); }
        ((float*)(sm + SM_LBS))[i] = v;
    }
    for (int i = gt; i < 2 * DC; i += NGT) { const float lam = gp(a, I_LLAM)[i]; ((float*)(sm + SM_SP))[i] = -8.0f * log1pf(expf(-lam)); }
    for (int i = gt; i < 2 * 16 * 64; i += NGT) {
        const int lg = i >> 6, p = i & 63;
        const float dt = expf(gp(a, I_S5DT)[lg]); const float lr = fminf(gp(a, I_S5LR)[i], -1e-4f), li = gp(a, I_S5LI)[i];
        const float mag = expf(lr * dt); const float are = mag * cosf(li * dt), aim = mag * sinf(li * dt);
        ((f32x2v*)(sm + SM_S5A))[i] = (f32x2v){are, aim};
        float pr = are, pi = aim;
#pragma unroll
        for (int s = 0; s < 6; ++s) { const float nr_ = pr * pr - pi * pi, ni_ = 2.0f * pr * pi; pr = nr_; pi = ni_; }
        ((f32x2v*)(sm + SM_S5A64))[i] = (f32x2v){pr, pi};
        const float den = lr * lr + li * li, nr = are - 1.0f;
        const float gre = (nr * lr + aim * li) / den, gim = (aim * lr - nr * li) / den;
        bf16* BB = (bf16*)(sm + SM_BB) + ((size_t)lg * 128 + 2 * p) * 16;
#pragma unroll
        for (int n = 0; n < 16; ++n) { const float br = gp(a, I_S5BR)[(size_t)i * 16 + n], bi = gp(a, I_S5BI)[(size_t)i * 16 + n];
            BB[n] = f2bf(gre * br - gim * bi); BB[16 + n] = f2bf(gre * bi + gim * br); }
        bf16* CC = (bf16*)(sm + SM_CC) + (size_t)lg * 16 * 128;
#pragma unroll
        for (int n = 0; n < 16; ++n) { const float cr = gp(a, I_S5CR)[((size_t)lg * 16 + n) * 64 + p], ci = gp(a, I_S5CI)[((size_t)lg * 16 + n) * 64 + p];
            CC[n * 128 + 2 * p] = f2bf(cr); CC[n * 128 + 2 * p + 1] = f2bf(-ci); }
    }
    for (int i = gt; i < 2 * 256 * 256; i += NGT) { const int l = i >> 16, n = (i >> 8) & 255, k = i & 255; ((bf16*)(sm + SM_WGT))[i] = f2bf(gp(a, I_S5WG)[((size_t)l * 256 + k) * 256 + n]); }
    for (int i = gt; i < 2 * 6 * 64 * 64; i += NGT) { const int lh = i >> 12, j = (i >> 6) & 63, ii = i & 63;
        ((bf16*)(sm + SM_WAT))[i] = f2bf(gp(a, I_LWA)[((size_t)lh * 64 + ii) * 64 + j]); ((bf16*)(sm + SM_WXT))[i] = f2bf(gp(a, I_LWX)[((size_t)lh * 64 + ii) * 64 + j]); }
}

constexpr int HG_S = 72;
constexpr int HG_QG = 0, HG_KG = 2304, HG_QE = 4608, HG_KET = 6912, HG_VT = 8960, HG_EGL = 11008, HG_GT = 11264, HG_WAVE_BYTES = 13568;
template <int CTRL> __device__ __forceinline__ float dpp_f(float v) { return __int_as_float(__builtin_amdgcn_update_dpp(0, __float_as_int(v), CTRL, 0xF, 0xF, true)); }
__device__ __forceinline__ float bfe(const v4u (&w)[2], int e) { const unsigned x = w[e >> 3][(e >> 1) & 3]; return __uint_as_float((e & 1) ? (x & 0xffff0000u) : (x << 16)); }
__device__ __forceinline__ bf16 bfraw(const v4u (&w)[2], int e) { const unsigned x = w[e >> 3][(e >> 1) & 3]; return (bf16)((e & 1) ? (x >> 16) : (x & 0xffffu)); }
template <bool OUT>
__device__ __forceinline__ void hgrn_unit(const Args& a, int layer, int cid, int h, LAS unsigned char* wl, int lane) {
    const int fr = lane & 15, fq = lane >> 4;
    unsigned char* ws = gws(a);
    const bf16* proj = (const bf16*)(ws + WS_PROJ) + (size_t)cid * 64 * D_IN;
    const float* lbp = (const float*)(ws + WS_SMALL + SM_LBS) + layer * DA + h * 64 + 16 * fq;
    float* HST = (float*)(ws + WS_HST);
    f32x4 S[4][4];
    {
        const float* s0 = nullptr;
        if (cid >= NPCH) s0 = gp(a, I_SH) + (((size_t)layer * 32 + (cid - NPCH)) * 6 + h) * 4096;
        else if (OUT && (cid & 63) != 0) s0 = HST + ((size_t)(cid - 1) * 6 + h) * 4096;
        if (s0) {
            const float* sp = s0 + (4 * fq) * 64 + fr;
#pragma unroll
            for (int dt = 0; dt < 4; ++dt)
#pragma unroll
                for (int vt = 0; vt < 4; ++vt)
#pragma unroll
                    for (int j = 0; j < 4; ++j) S[dt][vt][j] = sp[(16 * dt + j) * 64 + 16 * vt];
        } else {
#pragma unroll
            for (int dt = 0; dt < 4; ++dt)
#pragma unroll
                for (int vt = 0; vt < 4; ++vt) S[dt][vt] = (f32x4){0.f, 0.f, 0.f, 0.f};
        }
    }
    float gtot[OUT ? 1 : 16];
#pragma unroll
    for (int e = 0; e < (OUT ? 1 : 16); ++e) gtot[e] = 0.f;
    LAS bf16* QG = (LAS bf16*)(wl + HG_QG); LAS bf16* KG = (LAS bf16*)(wl + HG_KG); LAS bf16* QE = (LAS bf16*)(wl + HG_QE);
    LAS bf16* KET = (LAS bf16*)(wl + HG_KET); LAS bf16* VT = (LAS bf16*)(wl + HG_VT); LAS float* EGL = (LAS float*)(wl + HG_EGL); LAS bf16* GT = (LAS bf16*)(wl + HG_GT);
    const bf16x8 zero8 = {0, 0, 0, 0, 0, 0, 0, 0};
    const int rb7 = (lane & 48) | 7, rb15 = (lane & 48) | 15;
#pragma unroll 1
    for (int sb = 0; sb < 4; ++sb) {
        const bf16* prow = proj + (size_t)(sb * 16 + fr) * D_IN + h * 64 + 16 * fq;
        {
            v4u fw[2], iw[2], qw[2], gw[2];
            fw[0] = *(const v4u*)(prow + CF); fw[1] = *(const v4u*)(prow + CF + 8); iw[0] = *(const v4u*)(prow + CI); iw[1] = *(const v4u*)(prow + CI + 8);
            if (OUT) { qw[0] = *(const v4u*)(prow + CQ); qw[1] = *(const v4u*)(prow + CQ + 8); gw[0] = *(const v4u*)(prow + CG); gw[1] = *(const v4u*)(prow + CG + 8); }
            f32x4 lb4[4];
#pragma unroll
            for (int q = 0; q < 4; ++q) lb4[q] = *(const f32x4*)(lbp + 4 * q);
            float G[16], kv[16];
#pragma unroll
            for (int e = 0; e < 16; ++e) { const float lb = lb4[e >> 2][e & 3], oml = 1.0f - lb; const float sg = sigm(bfe(fw, e));
                kv[e] = oml * (1.0f - sg); G[e] = __logf(lb + oml * sg); }
#pragma unroll
            for (int e = 0; e < 16; ++e) { G[e] += dpp_f<0x111>(G[e]); G[e] += dpp_f<0x112>(G[e]); G[e] += dpp_f<0x114>(G[e]); G[e] += dpp_f<0x118>(G[e]); }
            unsigned qgp[8], kgp[8], qep[8]; float egl[16];
#pragma unroll
            for (int e = 0; e < 16; e += 2) {
                float qg2[2], kg2[2], qe2[2];
#pragma unroll
                for (int o = 0; o < 2; ++o) { const int ee = e + o;
                    const float Gr = __shfl(G[ee], rb7), Gl = __shfl(G[ee], rb15);
                    const float eGr = __expf(Gr), eGlr = __expf(Gl - Gr); egl[ee] = eGr * eGlr; if (!OUT) gtot[ee] += Gl;
                    const float e2 = __expf(Gr - G[ee]); const float kg = kv[ee] * e2;
                    KET[(16 * fq + ee) * 16 + fr] = f2bf(kg * eGlr);
                    VT[(16 * fq + ee) * 16 + fr] = bfraw(iw, ee);
                    if (OUT) { const float e1 = __expf(G[ee] - Gr); const float qg = bfe(qw, ee) * e1; qg2[o] = qg; kg2[o] = kg; qe2[o] = qg * eGr; } }
                if (OUT) { qgp[e >> 1] = pk2(qg2[0], qg2[1]); kgp[e >> 1] = pk2(kg2[0], kg2[1]); qep[e >> 1] = pk2(qe2[0], qe2[1]); }
            }
            if (fr == 15) {
#pragma unroll
                for (int q = 0; q < 4; ++q) *(LAS f32x4*)(EGL + 16 * fq + 4 * q) = (f32x4){egl[4 * q], egl[4 * q + 1], egl[4 * q + 2], egl[4 * q + 3]}; }
            if (OUT) {
                *(LAS v4u*)(QG + fr * HG_S + 16 * fq) = (v4u){qgp[0], qgp[1], qgp[2], qgp[3]}; *(LAS v4u*)(QG + fr * HG_S + 16 * fq + 8) = (v4u){qgp[4], qgp[5], qgp[6], qgp[7]};
                *(LAS v4u*)(KG + fr * HG_S + 16 * fq) = (v4u){kgp[0], kgp[1], kgp[2], kgp[3]}; *(LAS v4u*)(KG + fr * HG_S + 16 * fq + 8) = (v4u){kgp[4], kgp[5], kgp[6], kgp[7]};
                *(LAS v4u*)(QE + fr * HG_S + 16 * fq) = (v4u){qep[0], qep[1], qep[2], qep[3]}; *(LAS v4u*)(QE + fr * HG_S + 16 * fq + 8) = (v4u){qep[4], qep[5], qep[6], qep[7]};
                *(LAS v4u*)(GT + fr * HG_S + 16 * fq) = gw[0]; *(LAS v4u*)(GT + fr * HG_S + 16 * fq + 8) = gw[1];
            }
        }
        WAVE_SYNC();
        if (OUT) {
            f32x4 at = {0.f, 0.f, 0.f, 0.f};
#pragma unroll
            for (int kk = 0; kk < 2; ++kk) { const bf16x8 A = *(const LAS bf16x8*)(KG + fr * HG_S + kk * 32 + fq * 8), B = *(const LAS bf16x8*)(QG + fr * HG_S + kk * 32 + fq * 8); at = MFMA16(A, B, at); }
#pragma unroll
            for (int j = 0; j < 4; ++j) if (4 * fq + j > fr) at[j] = 0.f;
            union { bf16x8 v; unsigned u[4]; } Aatt; Aatt.u[0] = pk2(at[0], at[1]); Aatt.u[1] = pk2(at[2], at[3]); Aatt.u[2] = 0u; Aatt.u[3] = 0u;
            union { bf16x8 v; v2u h[2]; } Aq[2];
#pragma unroll
            for (int kk = 0; kk < 2; ++kk) { Aq[kk].h[0] = *(const LAS v2u*)(QE + fr * HG_S + kk * 32 + 4 * fq); Aq[kk].h[1] = *(const LAS v2u*)(QE + fr * HG_S + kk * 32 + 16 + 4 * fq); }
            f32x4 ov[4]; float ssq[4] = {0.f, 0.f, 0.f, 0.f};
#pragma unroll
            for (int vt = 0; vt < 4; ++vt) {
                union { bf16x8 v; v2u h[2]; } Bv; Bv.h[0] = *(const LAS v2u*)(VT + (16 * vt + fr) * 16 + 4 * fq); Bv.h[1] = (v2u){0u, 0u};
                f32x4 o = {0.f, 0.f, 0.f, 0.f};
                o = MFMA16(Aatt.v, Bv.v, o);
#pragma unroll
                for (int kk = 0; kk < 2; ++kk) { union { bf16x8 v; unsigned u[4]; } Bs;
                    Bs.u[0] = pk2(S[2 * kk][vt][0], S[2 * kk][vt][1]); Bs.u[1] = pk2(S[2 * kk][vt][2], S[2 * kk][vt][3]);
                    Bs.u[2] = pk2(S[2 * kk + 1][vt][0], S[2 * kk + 1][vt][1]); Bs.u[3] = pk2(S[2 * kk + 1][vt][2], S[2 * kk + 1][vt][3]);
                    o = MFMA16(Aq[kk].v, Bs.v, o); }
                ov[vt] = o;
#pragma unroll
                for (int j = 0; j < 4; ++j) ssq[j] += o[j] * o[j];
            }
#pragma unroll
            for (int j = 0; j < 4; ++j) { float s = ssq[j]; s += __shfl_xor(s, 1); s += __shfl_xor(s, 2); s += __shfl_xor(s, 4); s += __shfl_xor(s, 8); ssq[j] = __builtin_amdgcn_rsqf(s * (1.0f / 64.0f) + EPS); }
#pragma unroll
            for (int vt = 0; vt < 4; ++vt) { const float nw = gp(a, I_HNORM)[layer * DA + h * 64 + 16 * vt + fr];
#pragma unroll
                for (int j = 0; j < 4; ++j) { const int t = 4 * fq + j; const float g = bf2f(GT[t * HG_S + 16 * vt + fr]);
                    QG[t * HG_S + 16 * vt + fr] = f2bf(ov[vt][j] * ssq[j] * nw * g * sigm(g)); } }
            WAVE_SYNC();
            { const v4u o0 = *(const LAS v4u*)(QG + fr * HG_S + 8 * fq), o1 = *(const LAS v4u*)(QG + fr * HG_S + 32 + 8 * fq);
              bf16* dst = (bf16*)(ws + WS_MIX) + ((size_t)cid * 64 + sb * 16 + fr) * DM + h * 64 + 8 * fq; *(v4u*)dst = o0; *(v4u*)(dst + 32) = o1; }
        }
        {
            bf16x8 Bv[4];
#pragma unroll
            for (int vt = 0; vt < 4; ++vt) Bv[vt] = (fq < 2) ? *(const LAS bf16x8*)(VT + (16 * vt + fr) * 16 + fq * 8) : zero8;
#pragma unroll
            for (int dt = 0; dt < 4; ++dt) { const f32x4 eg = *(const LAS f32x4*)(EGL + 16 * dt + 4 * fq);
                const bf16x8 A = (fq < 2) ? *(const LAS bf16x8*)(KET + (16 * dt + fr) * 16 + fq * 8) : zero8;
#pragma unroll
                for (int vt = 0; vt < 4; ++vt) S[dt][vt] = MFMA16(A, Bv[vt], S[dt][vt] * eg); }
        }
        WAVE_SYNC();
    }
    {
        float* dst = nullptr;
        if (OUT) { if (cid >= NPCH) dst = gout(a) + O_HS + (((size_t)layer * 32 + (cid - NPCH)) * 6 + h) * 4096;
                   else if ((cid & 63) == 63) dst = gout(a) + O_HP + (((size_t)layer * 4 + (cid >> 6)) * 6 + h) * 4096; }
        else { dst = HST + ((size_t)cid * 6 + h) * 4096;
            if (fr == 0) { float* hd = (float*)(ws + WS_HD) + ((size_t)cid * 6 + h) * 64 + 16 * fq;
#pragma unroll
                for (int q = 0; q < 4; ++q) *(f32x4*)(hd + 4 * q) = (f32x4){__expf(gtot[(OUT ? 0 : 4 * q)]), __expf(gtot[(OUT ? 0 : 4 * q + 1)]), __expf(gtot[(OUT ? 0 : 4 * q + 2)]), __expf(gtot[(OUT ? 0 : 4 * q + 3)])}; } }
        if (dst) {
#pragma unroll
            for (int dt = 0; dt < 4; ++dt)
#pragma unroll
                for (int vt = 0; vt < 4; ++vt)
#pragma unroll
                    for (int j = 0; j < 4; ++j) dst[(4 * fq) * 64 + fr + (16 * dt + j) * 64 + 16 * vt] = S[dt][vt][j];
        }
    }
}

constexpr int S5_US = 264, S5_BS = 132, S5_HS = 136;
constexpr int S5_UT = 0, S5_BUT = 8448, S5_HT = 76032, S5_ZT = 110848, S5_ZF = 119296;
template <bool OUT>
__device__ __forceinline__ void s5_phase(const Args& a, int layer, LAS unsigned char* lds, int tid, int lane, int wave, int NU) {
    const int fr = lane & 15, fq = lane >> 4;
    unsigned char* ws = gws(a); const unsigned char* sm = ws + WS_SMALL;
    f32x2v* ST = (f32x2v*)(ws + WS_S5ST);
    LAS bf16* UT = (LAS bf16*)(lds + S5_UT); LAS float* BUT = (LAS float*)(lds + S5_BUT) + wave * (16 * S5_BS); LAS bf16* HT = (LAS bf16*)(lds + S5_HT) + wave * (16 * S5_HS);
    LAS bf16* ZT = (LAS bf16*)(lds + S5_ZT); LAS float* ZF = (LAS float*)(lds + S5_ZF);
    const bf16x8 zero8 = {0, 0, 0, 0, 0, 0, 0, 0};
    bf16x8 BBr[8], CCr[2][4], WGr[2][8]; float are[2], aim[2], dd[2], bgv[2];
    {
        const bf16* BB = (const bf16*)(sm + SM_BB) + ((size_t)(layer * 16 + (fq < 2 ? wave : 8 + wave)) * 128) * 16;
#pragma unroll
        for (int nt = 0; nt < 8; ++nt) BBr[nt] = *(const bf16x8*)(BB + (16 * nt + fr) * 16 + (fq & 1) * 8);
    }
    const int r_ut = tid >> 5, c8 = (tid & 31) * 8;
#pragma unroll
    for (int hf = 0; hf < 2; ++hf) { const int g = hf * 8 + wave;
        const f32x2v av = ((const f32x2v*)(sm + SM_S5A))[(layer * 16 + g) * 64 + lane]; are[hf] = av.x; aim[hf] = av.y;
        if (OUT) { const bf16* CC = (const bf16*)(sm + SM_CC) + (size_t)(layer * 16 + g) * 16 * 128;
#pragma unroll
            for (int kk = 0; kk < 4; ++kk) CCr[hf][kk] = *(const bf16x8*)(CC + fr * 128 + 32 * kk + 8 * fq);
            dd[hf] = gp(a, I_S5D)[layer * DB + g * 16 + fr]; } }
    if (OUT) { const bf16* WG = (const bf16*)(sm + SM_WGT) + (size_t)layer * 65536;
#pragma unroll
        for (int i = 0; i < 2; ++i) { const int nt = 2 * wave + i;
#pragma unroll
            for (int kk = 0; kk < 8; ++kk) WGr[i][kk] = *(const bf16x8*)(WG + (size_t)(16 * nt + fr) * 256 + 32 * kk + 8 * fq);
            bgv[i] = gp(a, I_S5BG)[layer * DB + 16 * nt + fr]; }
        }
#pragma unroll 1
    for (int u = blockIdx.x; u < NU; u += gridDim.x) {
        const int cid = OUT ? u : (u / 63) * 64 + (u % 63);
        const bf16* proj = (const bf16*)(ws + WS_PROJ) + (size_t)cid * 64 * D_IN;
        float hre[2], him[2];
#pragma unroll
        for (int hf = 0; hf < 2; ++hf) { const int g = hf * 8 + wave;
            if (cid >= NPCH) { const size_t o = (((size_t)layer * 32 + (cid - NPCH)) * 16 + g) * 64 + lane; hre[hf] = gp(a, I_SSR)[o]; him[hf] = gp(a, I_SSI)[o]; }
            else if (OUT && (cid & 63) != 0) { const f32x2v hv = ST[((size_t)(cid - 1) * 16 + g) * 64 + lane]; hre[hf] = hv.x; him[hf] = hv.y; }
            else { hre[hf] = 0.f; him[hf] = 0.f; } }
        v4u unext = *(const v4u*)(proj + (size_t)r_ut * D_IN + CU + c8);
#pragma unroll 1
        for (int tt = 0; tt < 4; ++tt) {
            *(LAS v4u*)(UT + r_ut * S5_US + c8) = unext;
            if (tt < 3) unext = *(const v4u*)(proj + (size_t)((tt + 1) * 16 + r_ut) * D_IN + CU + c8);
            BSYNC();
#pragma unroll
            for (int hf = 0; hf < 2; ++hf) {
                const int g = hf * 8 + wave;
                {
                    const bf16x8 A = ((fq < 2) == (hf == 0)) ? *(const LAS bf16x8*)(UT + fr * S5_US + g * 16 + (fq & 1) * 8) : zero8;
                    f32x4 cc[8];
#pragma unroll
                    for (int nt = 0; nt < 8; ++nt) { cc[nt] = (f32x4){0.f, 0.f, 0.f, 0.f}; cc[nt] = MFMA16(A, BBr[nt], cc[nt]); }
                    __builtin_amdgcn_sched_barrier(0); asm volatile("s_nop 7\n\ts_nop 7" ::: "memory"); __builtin_amdgcn_sched_barrier(0);
#pragma unroll
                    for (int nt = 0; nt < 8; ++nt)
#pragma unroll
                        for (int j = 0; j < 4; ++j) BUT[(4 * fq + j) * S5_BS + 16 * nt + fr] = cc[nt][j];
                }
                BSYNC();
                {
                    float hr = hre[hf], hi = him[hf]; const float ar = are[hf], ai = aim[hf];
#pragma unroll
                    for (int th = 0; th < 4; ++th) { f32x2v bv[4];
#pragma unroll
                        for (int t = 0; t < 4; ++t) bv[t] = *(const LAS f32x2v*)(BUT + (4 * th + t) * S5_BS + 2 * lane);
#pragma unroll
                        for (int t = 0; t < 4; ++t) { const float nr = ar * hr - ai * hi + bv[t].x, ni = ar * hi + ai * hr + bv[t].y; hr = nr; hi = ni;
                            if (OUT) *(LAS unsigned*)(HT + (4 * th + t) * S5_HS + 2 * lane) = pk2(hr, hi); } }
                    hre[hf] = hr; him[hf] = hi;
                }
                BSYNC();
                if (OUT) {
                    f32x4 y = {0.f, 0.f, 0.f, 0.f};
#pragma unroll
                    for (int kk = 0; kk < 4; ++kk) { const bf16x8 A = *(const LAS bf16x8*)(HT + fr * S5_HS + 32 * kk + 8 * fq); y = MFMA16(A, CCr[hf][kk], y); }
                    const int ch = g * 16 + fr;
#pragma unroll
                    for (int j = 0; j < 4; ++j) { const int tok = 4 * fq + j; const float uu = bf2f(UT[tok * S5_US + ch]); const float z = gelu_tanh(y[j] + dd[hf] * uu);
                        ZT[tok * S5_US + ch] = f2bf(z); ZF[tok * 256 + ch] = z; }
                }
            }
            if (OUT) {
                BSYNC();
#pragma unroll
                for (int i = 0; i < 2; ++i) { const int nt = 2 * wave + i; f32x4 p = {0.f, 0.f, 0.f, 0.f};
#pragma unroll
                    for (int kk = 0; kk < 8; ++kk) { const bf16x8 A = *(const LAS bf16x8*)(ZT + fr * S5_US + 32 * kk + 8 * fq); p = MFMA16(A, WGr[i][kk], p); }
                    const int n = 16 * nt + fr;
#pragma unroll
                    for (int j = 0; j < 4; ++j) { const int tok = 4 * fq + j; ZF[tok * 256 + n] = ZF[tok * 256 + n] * sigm(p[j] + bgv[i]); } }
                BSYNC();
                { const f32x4 v0 = *(const LAS f32x4*)(ZF + r_ut * 256 + c8), v1 = *(const LAS f32x4*)(ZF + r_ut * 256 + c8 + 4);
                  float s = (v0.x * v0.x + v0.y * v0.y) + (v0.z * v0.z + v0.w * v0.w) + (v1.x * v1.x + v1.y * v1.y) + (v1.z * v1.z + v1.w * v1.w);
                  s += __shfl_xor(s, 1); s += __shfl_xor(s, 2); s += __shfl_xor(s, 4); s += __shfl_xor(s, 8); s += __shfl_xor(s, 16);
                  const float rs = __builtin_amdgcn_rsqf(s * (1.0f / 256.0f) + EPS); const f32x4 nw0 = *(const f32x4*)(gp(a, I_S5N) + layer * DB + c8), nw1 = *(const f32x4*)(gp(a, I_S5N) + layer * DB + c8 + 4);
                  v4u o; o.x = pk2(v0.x * rs * nw0.x, v0.y * rs * nw0.y); o.y = pk2(v0.z * rs * nw0.z, v0.w * rs * nw0.w); o.z = pk2(v1.x * rs * nw1.x, v1.y * rs * nw1.y); o.w = pk2(v1.z * rs * nw1.z, v1.w * rs * nw1.w);
                  *(v4u*)((bf16*)(ws + WS_MIX) + ((size_t)cid * 64 + tt * 16 + r_ut) * DM + DA + c8) = o; }
            }
            BSYNC();
        }
#pragma unroll
        for (int hf = 0; hf < 2; ++hf) { const int g = hf * 8 + wave;
            if (OUT) { if (cid >= NPCH) { const size_t o = (((size_t)layer * 32 + (cid - NPCH)) * 16 + g) * 64 + lane; gout(a)[O_SRS + o] = hre[hf]; gout(a)[O_SIS + o] = him[hf]; }
                       else if ((cid & 63) == 63) { const size_t o = (((size_t)layer * 4 + (cid >> 6)) * 16 + g) * 64 + lane; gout(a)[O_SRP + o] = hre[hf]; gout(a)[O_SIP + o] = him[hf]; } }
            else ST[((size_t)cid * 16 + g) * 64 + lane] = (f32x2v){hre[hf], him[hf]}; }
    }
    __syncthreads();
}

constexpr int LR_XS = 392, LR_AS = 388;
constexpr int LR_XC = 0, LR_AL = 25088, LR_BL = 74752;
template <bool OUT>
__device__ __forceinline__ void lru_phase(const Args& a, int layer, LAS unsigned char* lds, int tid, int lane, int wave, int NU) {
    const int fr = lane & 15, fq = lane >> 4;
    unsigned char* ws = gws(a); const unsigned char* sm = ws + WS_SMALL;
    f32x2v* ST = (f32x2v*)(ws + WS_LRUST);
    LAS bf16* XC = (LAS bf16*)(lds + LR_XC); LAS float* AL = (LAS float*)(lds + LR_AL); LAS float* BL = (LAS float*)(lds + LR_BL);
    const bool act = tid < DC; const int c = act ? tid : 0;
    const float cw0 = gp(a, I_LCW)[(layer * 4 + 0) * DC + c], cw1 = gp(a, I_LCW)[(layer * 4 + 1) * DC + c], cw2 = gp(a, I_LCW)[(layer * 4 + 2) * DC + c], cw3 = gp(a, I_LCW)[(layer * 4 + 3) * DC + c];
    const float cb = gp(a, I_LCB)[layer * DC + c];
    bf16x8 BA0[3], BA1[3], BX0[3], BX1[3]; float bav[3], bxv[3], spv[3];
#pragma unroll
    for (int i = 0; i < 3; ++i) { const int ntg = 3 * wave + i, hd = ntg >> 2, jn = (ntg & 3) * 16; const int ch = 16 * ntg + fr;
        const bf16* WA = (const bf16*)(sm + SM_WAT) + ((size_t)(layer * 6 + hd) * 64 + jn + fr) * 64; const bf16* WX = (const bf16*)(sm + SM_WXT) + ((size_t)(layer * 6 + hd) * 64 + jn + fr) * 64;
        BA0[i] = *(const bf16x8*)(WA + 8 * fq); BA1[i] = *(const bf16x8*)(WA + 32 + 8 * fq); BX0[i] = *(const bf16x8*)(WX + 8 * fq); BX1[i] = *(const bf16x8*)(WX + 32 + 8 * fq);
        bav[i] = gp(a, I_LBA)[layer * DC + ch]; bxv[i] = gp(a, I_LBX)[layer * DC + ch]; spv[i] = ((const float*)(sm + SM_SP))[layer * DC + ch]; }
    const int ntok = tid >> 4, c0 = (tid & 15) * 24;
#pragma unroll 1
    for (int k = 0; k * (int)gridDim.x < NU; ++k) {
        const int G_ = (int)gridDim.x, u = k * G_ + (((int)blockIdx.x + G_ - (8 * k) % G_) % G_); if (u >= NU) continue;
        const int cid = OUT ? u : (u / 63) * 64 + (u % 63);
        const bf16* proj = (const bf16*)(ws + WS_PROJ) + (size_t)cid * 64 * D_IN;
        float xm3 = 0.f, xm2 = 0.f, xm1 = 0.f, h = 0.f, P = 1.f;
        if (cid >= NPCH) { const size_t sb = (size_t)layer * 32 + (cid - NPCH); xm3 = gp(a, I_SC)[(sb * 3 + 0) * DC + c]; xm2 = gp(a, I_SC)[(sb * 3 + 1) * DC + c]; xm1 = gp(a, I_SC)[(sb * 3 + 2) * DC + c]; h = gp(a, I_SL)[sb * DC + c]; }
        else if ((cid & 63) != 0) { xm3 = bf2f(proj[-3 * D_IN + CXR + c]); xm2 = bf2f(proj[-2 * D_IN + CXR + c]); xm1 = bf2f(proj[-1 * D_IN + CXR + c]); if (OUT) h = ST[(size_t)(cid - 1) * DC + c].y; }
#pragma unroll 1
        for (int tile = 0; tile < 2; ++tile) {
            const bf16* pr = proj + (size_t)tile * 32 * D_IN;
            bf16 gr[32];
            {   bf16 xr[32];
#pragma unroll
                for (int t = 0; t < 32; ++t) xr[t] = pr[(size_t)t * D_IN + CXR + c];
                if (OUT) {
#pragma unroll
                    for (int t = 0; t < 32; ++t) gr[t] = pr[(size_t)t * D_IN + CGR + c]; }
                if (act) {
#pragma unroll
                    for (int t = 0; t < 32; ++t) { const float x = bf2f(xr[t]); const float xc = cb + cw0 * xm3 + cw1 * xm2 + cw2 * xm1 + cw3 * x; XC[t * LR_XS + c] = f2bf(xc); xm3 = xm2; xm2 = xm1; xm1 = x; } }
            }
            BSYNC();
#pragma unroll
            for (int i = 0; i < 3; ++i) { const int ntg = 3 * wave + i, hd = ntg >> 2; const int ch = 16 * ntg + fr;
#pragma unroll
                for (int mt = 0; mt < 2; ++mt) { const bf16x8 A0 = *(const LAS bf16x8*)(XC + (16 * mt + fr) * LR_XS + hd * 64 + 8 * fq), A1 = *(const LAS bf16x8*)(XC + (16 * mt + fr) * LR_XS + hd * 64 + 32 + 8 * fq);
                    f32x4 r = {0.f, 0.f, 0.f, 0.f}, ii = {0.f, 0.f, 0.f, 0.f};
                    r = MFMA16(A0, BA0[i], r); r = MFMA16(A1, BA1[i], r); ii = MFMA16(A0, BX0[i], ii); ii = MFMA16(A1, BX1[i], ii);
#pragma unroll
                    for (int j = 0; j < 4; ++j) { const int tok = 16 * mt + 4 * fq + j; const float rg = sigm(r[j] + bav[i]), ig = sigm(ii[j] + bxv[i]); const float la = spv[i] * rg; const float av = __expf(la);
                        const float xcv = bf2f(XC[tok * LR_XS + ch]); AL[tok * LR_AS + ch] = av; BL[tok * LR_AS + ch] = __builtin_amdgcn_sqrtf(fmaxf(1.0f - av * av, 0.f)) * ig * xcv; } } }
            BSYNC();
            if (act) {
#pragma unroll
                for (int t = 0; t < 32; ++t) { const float av = AL[t * LR_AS + c]; h = av * h + BL[t * LR_AS + c]; P *= av;
                    if (OUT) BL[t * LR_AS + c] = h * gelu_tanh(bf2f(gr[t])); }
            }
            if (OUT) {
                BSYNC();
                float v[24]; float s = 0.f; const int sub = tid & 15;
#pragma unroll
                for (int q = 0; q < 3; ++q) { const f32x4 x0 = *(const LAS f32x4*)(BL + ntok * LR_AS + 128 * q + 8 * sub), x1 = *(const LAS f32x4*)(BL + ntok * LR_AS + 128 * q + 8 * sub + 4);
                    v[8 * q] = x0.x; v[8 * q + 1] = x0.y; v[8 * q + 2] = x0.z; v[8 * q + 3] = x0.w; v[8 * q + 4] = x1.x; v[8 * q + 5] = x1.y; v[8 * q + 6] = x1.z; v[8 * q + 7] = x1.w;
                    s += ((x0.x * x0.x + x0.y * x0.y) + (x0.z * x0.z + x0.w * x0.w)) + ((x1.x * x1.x + x1.y * x1.y) + (x1.z * x1.z + x1.w * x1.w)); }
                s += __shfl_xor(s, 1); s += __shfl_xor(s, 2); s += __shfl_xor(s, 4); s += __shfl_xor(s, 8);
                const float rs = __builtin_amdgcn_rsqf(s * (1.0f / 384.0f) + EPS);
                bf16* dst = (bf16*)(ws + WS_MIX) + ((size_t)cid * 64 + tile * 32 + ntok) * DM + DA + DB + 8 * sub;
#pragma unroll
                for (int q = 0; q < 3; ++q) { const float* nw = gp(a, I_LNORM) + layer * DC + 128 * q + 8 * sub; const f32x4 n0 = *(const f32x4*)nw, n1 = *(const f32x4*)(nw + 4);
                    v4u o; o.x = pk2(v[8 * q] * rs * n0.x, v[8 * q + 1] * rs * n0.y); o.y = pk2(v[8 * q + 2] * rs * n0.z, v[8 * q + 3] * rs * n0.w);
                    o.z = pk2(v[8 * q + 4] * rs * n1.x, v[8 * q + 5] * rs * n1.y); o.w = pk2(v[8 * q + 6] * rs * n1.z, v[8 * q + 7] * rs * n1.w); *(v4u*)(dst + 128 * q) = o; }
            }
        }
        if (act) {
            if (OUT) {
                float* ho = nullptr; float* co = nullptr;
                if (cid >= NPCH) { const size_t sb = (size_t)layer * 32 + (cid - NPCH); ho = gout(a) + O_LS + sb * DC; co = gout(a) + O_CS + sb * 3 * DC; }
                else if ((cid & 63) == 63) { const size_t sb = (size_t)layer * 4 + (cid >> 6); ho = gout(a) + O_LP + sb * DC; co = gout(a) + O_CP + sb * 3 * DC; }
                if (ho) { ho[c] = h; co[c] = xm3; co[DC + c] = xm2; co[2 * DC + c] = xm1; }
            } else ST[(size_t)cid * DC + c] = (f32x2v){P, h};
        }
        __syncthreads();
    }
}

__device__ __forceinline__ void carry_phase(const Args& a, int layer, int tid) {
    unsigned char* ws = gws(a);
    const int gt = blockIdx.x * NTHREADS + tid, NGT = gridDim.x * NTHREADS;
    for (int i = gt; i < 4 * 6 * 4096; i += NGT) {
        const int b = i / 24576, rem = i % 24576, hh = rem >> 12, e = rem & 4095, d = e >> 6;
        float* HST = (float*)(ws + WS_HST) + ((size_t)(b * 64) * 6 + hh) * 4096 + e; const float* HD = (const float*)(ws + WS_HD) + ((size_t)(b * 64) * 6 + hh) * 64 + d;
        float S = 0.f;
#pragma unroll 21
        for (int cc = 0; cc < 63; ++cc) { S = HD[(size_t)cc * 6 * 64] * S + HST[(size_t)cc * 6 * 4096]; HST[(size_t)cc * 6 * 4096] = S; }
    }
    const int off5 = (NGT >= 4 * 6 * 4096 + 4 * 1024 + 4 * DC) ? 4 * 6 * 4096 : 0, offl = off5 ? off5 + 4 * 1024 : 0;
    for (int i = gt - off5; i < 4 * 1024; i += NGT) { if (i < 0) continue;
        const int b = i >> 10, gp = i & 1023; const f32x2v A = ((const f32x2v*)(ws + WS_SMALL + SM_S5A64))[layer * 1024 + gp];
        f32x2v* ST = (f32x2v*)(ws + WS_S5ST) + (size_t)(b * 64) * 1024 + gp; float hr = 0.f, hi = 0.f;
#pragma unroll 21
        for (int cc = 0; cc < 63; ++cc) { const f32x2v l = ST[(size_t)cc * 1024]; const float nr = A.x * hr - A.y * hi + l.x, ni = A.x * hi + A.y * hr + l.y; hr = nr; hi = ni; ST[(size_t)cc * 1024] = (f32x2v){hr, hi}; }
    }
    for (int i = gt - offl; i < 4 * DC; i += NGT) { if (i < 0) continue;
        const int b = i / DC, c = i % DC; f32x2v* ST = (f32x2v*)(ws + WS_LRUST) + (size_t)(b * 64) * DC + c; float h = 0.f;
#pragma unroll 21
        for (int cc = 0; cc < 63; ++cc) { const f32x2v l = ST[(size_t)cc * DC]; h = l.x * h + l.y; ST[(size_t)cc * DC] = (f32x2v){l.x, h}; }
    }
}

#ifndef MIXSLOW
#define MIXSLOW 0
#endif
#define MSLOW(bit) do { if (MIXSLOW) { asm volatile("s_waitcnt vmcnt(0) lgkmcnt(0)" ::: "memory"); __syncthreads(); const unsigned long long t1_ = __builtin_amdgcn_s_memrealtime(); if (MIXSLOW & (bit)) { const unsigned long long d_ = t1_ - t_m; while (__builtin_amdgcn_s_memrealtime() - t1_ < d_) __builtin_amdgcn_s_sleep(8); } t_m = __builtin_amdgcn_s_memrealtime(); } } while (0)
template <bool OUT>
__device__ __forceinline__ void mixer_phase(int layer, LAS unsigned char* lds, int tid0) {
#ifndef MIXSEL
#define MIXSEL 7
#endif
    unsigned long long t_m = MIXSLOW ? __builtin_amdgcn_s_memrealtime() : 0ull;
    if (MIXSEL & 1) {
        int tid = tid0; LAUNDER_V(tid); const int lane = tid & 63, wave = __builtin_amdgcn_readfirstlane(tid >> 6);
        const int gw = blockIdx.x * NWAVES + wave, NGW = gridDim.x * NWAVES;
        LAS unsigned char* wl = lds + wave * HG_WAVE_BYTES;
        const Args& a = kargs();
        if (OUT) {
            const int hb = ((int)gridDim.x * NWAVES > NCHUNK * 6) ? ((int)gridDim.x * NWAVES - NCHUNK * 6) / NWAVES : 0;
            if ((int)blockIdx.x >= hb) for (int u = ((int)blockIdx.x - hb) * NWAVES + wave; u < NCHUNK * 6; u += ((int)gridDim.x - hb) * NWAVES) hgrn_unit<true>(a, layer, u / 6, u % 6, wl, lane); }
        else     { for (int u = gw; u < 4 * 63 * 6; u += NGW) { const int b = u / 378, rem = u % 378; hgrn_unit<false>(a, layer, b * 64 + rem / 6, rem % 6, wl, lane); } }
    }
    __syncthreads();
    MSLOW(1);
    const int NU = OUT ? NCHUNK : 4 * 63;
    if (MIXSEL & 2) {
        int tid = tid0; LAUNDER_V(tid); const int lane = tid & 63, wave = __builtin_amdgcn_readfirstlane(tid >> 6);
        s5_phase<OUT>(kargs(), layer, lds, tid, lane, wave, NU);
    }
    MSLOW(2);
    if (MIXSEL & 4) {
        int tid = tid0; LAUNDER_V(tid); const int lane = tid & 63, wave = __builtin_amdgcn_readfirstlane(tid >> 6);
        lru_phase<OUT>(kargs(), layer, lds, tid, lane, wave, NU);
    }
    MSLOW(4);
}

__device__ __forceinline__ void final_norm(const Args& a, int lane, int wave) {
    const int gw = blockIdx.x * NWAVES + wave, NGW = gridDim.x * NWAVES;
    const float* SS = (const float*)(gws(a) + WS_SSP) + (size_t)4 * M_TOK * 16; const f32x4* nw = (const f32x4*)gp(a, I_NFIN) + lane;
    const bf16* XB = (const bf16*)(gws(a) + WS_XB);
    f32x4 w[4];
#pragma unroll
    for (int j = 0; j < 4; ++j) w[j] = nw[64 * j];
    for (int m = gw; m < M_TOK; m += NGW) { const float rs = pg8::row_rstd(SS, (size_t)m); f32x4* xr = (f32x4*)(gout(a) + (size_t)m * DM) + lane; const v2u* xb = (const v2u*)(XB + (size_t)m * DM) + lane;
#pragma unroll
        for (int j = 0; j < 4; ++j) { const v2u b = xb[64 * j]; f32x4 v; v[0] = __uint_as_float(b.x << 16); v[1] = __uint_as_float(b.x & 0xffff0000u); v[2] = __uint_as_float(b.y << 16); v[3] = __uint_as_float(b.y & 0xffff0000u);
            v = v * rs * w[j]; xr[64 * j] = v; } }
}

#ifndef PHSEL
#define PHSEL 0xFF
#endif
#ifndef MK_MULTI
#define MK_MULTI 0
#endif
struct KArgs { Args a; int ph_lo, ph_hi; };
__global__ void __launch_bounds__(NTHREADS, 2) fwd_megakernel(KArgs ka) {
    extern __shared__ __attribute__((aligned(16))) unsigned char lds_raw[];
    LAS unsigned char* lds = (LAS unsigned char*)lds_raw;
    const int tid = threadIdx.x, lane = tid & 63, wave = __builtin_amdgcn_readfirstlane(tid >> 6);
    unsigned char* ws = ka.a.ws; float* const out = ka.a.out; unsigned char* const ws_early = ws;
    const Args& a = ka.a;
    float* SS = (float*)(ws + WS_SSP);
    bf16* XB = (bf16*)(ws + WS_XB); bf16* PROJ = (bf16*)(ws + WS_PROJ); bf16* MIX = (bf16*)(ws + WS_MIX); bf16* HID = (bf16*)(ws + WS_HID);
    int ph = 0;
#if MK_MULTI
#define SEAM() do { ++ph; } while (0)
#define RUN(b) (((PHSEL) >> (b)) & 1) && (ph >= ka.ph_lo && ph < ka.ph_hi)
#else
    cg::grid_group grid = cg::this_grid();
    volatile LAS unsigned* xb_st = (volatile LAS unsigned*)(lds + XB_LDS_OFF);
    if (threadIdx.x < 2) xb_st[threadIdx.x] = 0u;
    __syncthreads();
    const XcdBarrier xbar = xcd_barrier_post((unsigned*)(ws_early + WS_CTL + 16384), xb_st);
#define SEAM() do { if (ka.ph_hi < 0) grid.sync(); xcd_barrier(xbar); ++ph; } while (0)
#define RUN(b) ((((PHSEL) >> (b)) & 1) != 0)
#endif
#ifndef STOP_AFTER
#define STOP_AFTER 999
#endif
#ifndef DUMP_OFF
#define DUMP_OFF WS_MIX
#endif
#ifndef DUMP_F32
#define DUMP_F32 0
#endif
#define PROBE() do { if (ph == STOP_AFTER) { if (DUMP_F32 == 2) { const bf16* src = (const bf16*)(ws + WS_PROJ); for (size_t i = (size_t)blockIdx.x * NTHREADS + tid; i < (size_t)M_TOK * 256; i += (size_t)gridDim.x * NTHREADS) out[i] = bf2f(src[(i >> 8) * D_IN + CU + (i & 255)]); } else if (DUMP_F32) { const float* src = (const float*)(ws + DUMP_OFF); for (size_t i = (size_t)blockIdx.x * NTHREADS + tid; i < (size_t)7602176; i += (size_t)gridDim.x * NTHREADS) out[i] = src[i]; } \
    else { const bf16* src = (const bf16*)(ws + DUMP_OFF); for (size_t i = (size_t)blockIdx.x * NTHREADS + tid; i < (size_t)M_TOK * DM; i += (size_t)gridDim.x * NTHREADS) out[i] = bf2f(src[i]); } return; } } while (0)
#define IDLE_CONVERT(nwg_, lay_, part_) do { const int rem_ = (nwg_) % (int)gridDim.x; if ((int)blockIdx.x >= rem_) {     int t2 = tid; LAUNDER_V(t2); const int w2 = __builtin_amdgcn_readfirstlane(t2 >> 6); \
        convert_weights(kargs(), (lay_), lds, t2 & 63, w2, ((int)blockIdx.x - rem_) * NWAVES + w2, ((int)gridDim.x - rem_) * NWAVES, (part_)); } } while (0)
#ifndef SLOWMASK
#define SLOWMASK 0
#endif
    unsigned long long t_ph = SLOWMASK ? __builtin_amdgcn_s_memrealtime() : 0ull;
#define SLOW(bit) do { if (SLOWMASK) { const unsigned long long t1_ = __builtin_amdgcn_s_memrealtime(); if (SLOWMASK & (bit)) { const unsigned long long d_ = t1_ - t_ph; while (__builtin_amdgcn_s_memrealtime() - t1_ < d_) __builtin_amdgcn_s_sleep(8); } t_ph = __builtin_amdgcn_s_memrealtime(); } } while (0)
    if (RUN(0)) { int t3 = tid; LAUNDER_V(t3); p0_prologue(kargs(), lds, t3, t3 & 63, __builtin_amdgcn_readfirstlane(t3 >> 6)); if (blockIdx.x == 0 && tid < 38) ((unsigned long long*)(ws + WS_TAB))[tid] = (tid < 36) ? (unsigned long long)ka.a.in[tid] : (tid == 36 ? (unsigned long long)ka.a.out : (unsigned long long)ka.a.ws); }
    SEAM(); PROBE(); SLOW(1);
#pragma unroll 1
    for (int l = 0; l < 2; ++l) {
        if (RUN(1)) { pg8::Gemm g{XB, (const bf16*)(ws + WS_WIN) + (size_t)l * D_IN * DM, M_TOK, D_IN, DM}; pg8::StaticOrder S; S.init(M_TOK, D_IN, gridDim.x, blockIdx.x);
            pg8::EpiProj E{PROJ, D_IN, SS + (size_t)(2 * l) * M_TOK * 16};
            pg8::gemm_phase<pg8::EpiProj, pg8::StaticOrder, true, true>(lds, g, S, E);
            IDLE_CONVERT(72 * 10, l, 1); }
        SEAM(); PROBE(); SLOW(2);
        if (RUN(2)) mixer_phase<false>(l, lds, tid);
        SEAM(); PROBE(); SLOW(4);
        if (RUN(3)) { int t3 = tid; LAUNDER_V(t3); carry_phase(kargs(), l, t3); }
        SEAM(); PROBE(); SLOW(4);
        if (RUN(4)) mixer_phase<true>(l, lds, tid);
        SEAM(); PROBE(); SLOW(4);
        if (RUN(5)) { pg8::Gemm g{MIX, (const bf16*)(ws + WS_WOUT) + (size_t)l * DM * DM, M_TOK, DM, DM}; pg8::StaticOrder S; S.init(M_TOK, DM, gridDim.x, blockIdx.x);
            pg8::EpiRes E{XB, SS + (size_t)(2 * l + 1) * M_TOK * 16};
            pg8::gemm_phase<pg8::EpiRes, pg8::StaticOrder, true, true>(lds, g, S, E);
            IDLE_CONVERT(72 * 4, l, 2); IDLE_CONVERT(72 * 4, l, 3); if (l == 0) IDLE_CONVERT(72 * 4, 1, 0); }
        SEAM(); PROBE(); SLOW(8);
        {
            const int G_ = (int)gridDim.x, total = 72 * 22, full = (total / G_) * G_, c0 = total - full;
#define Wgu ((const bf16*)(ws + WS_WGU) + (size_t)l * 2 * D_FF * DM)
#define Wdn ((const bf16*)(ws + WS_WDN) + (size_t)l * DM * D_FF)
            const int nlow = (G_ == 256) ? 32 : 0, t_lo = G_ + 3 * nlow;
#pragma unroll 1
            for (int step = 0; step < 2; ++step) {
                if (step == 1 && RUN(6)) { pg8::Gemm g{HID, Wdn, M_TOK, DM, D_FF}; pg8::SampleOrder S; S.c0 = 0; S.c = (nlow ? (int)blockIdx.x : -1);
                    pg8::EpiRes E{XB, SS + (size_t)(2 * l + 2) * M_TOK * 16};
                    pg8::gemm_phase<pg8::EpiRes, pg8::SampleOrder, true, true>(lds, g, S, E); }
                if (RUN(6)) { pg8::Gemm g{XB, Wgu, M_TOK, 2 * D_FF, DM}; pg8::GuOrder S; S.init(M_PROMPT, 2 * D_FF, G_, blockIdx.x); S.npre = 8 * 22;
                    if (step == 0) { S.lo = 0; S.hi = G_; }
                    else if ((int)blockIdx.x < nlow) { S.G = nlow; S.lo = G_; S.hi = t_lo; }
                    else { S.G = G_ - nlow; S.c = (int)blockIdx.x - nlow; S.lo = t_lo; S.hi = total; }
                    pg8::EpiGateUp E{HID, D_FF, SS + (size_t)(2 * l + 1) * M_TOK * 16};
                    pg8::gemm_phase<pg8::EpiGateUp, pg8::GuOrder, true, true>(lds, g, S, E); }
                if (step == 0) xcd_barrier(xbar);
            }
            if (!nlow && RUN(6)) {
                xcd_barrier(xbar);
                pg8::Gemm g{HID, Wdn, M_TOK, DM, D_FF}; pg8::SampleOrder S; S.c0 = 0; S.c = blockIdx.x;
                pg8::EpiRes E{XB, SS + (size_t)(2 * l + 2) * M_TOK * 16};
                pg8::gemm_phase<pg8::EpiRes, pg8::SampleOrder, true, true>(lds, g, S, E); }
            SEAM(); PROBE(); SLOW(16);
            if (RUN(7)) { pg8::Gemm g{HID, Wdn, M_PROMPT, DM, D_FF}; pg8::StaticOrder S; S.init(M_PROMPT, DM, G_, blockIdx.x);
                pg8::EpiRes E{XB, SS + (size_t)(2 * l + 2) * M_TOK * 16};
                pg8::gemm_phase<pg8::EpiRes, pg8::StaticOrder, true, true>(lds, g, S, E); }
        }
        SEAM(); PROBE(); SLOW(32);
    }
    if (RUN(3)) { int t3 = tid; LAUNDER_V(t3); final_norm(kargs(), t3 & 63, __builtin_amdgcn_readfirstlane(t3 >> 6)); }
}
constexpr int N_PHASES = 1 + 2 * 7 + 1;

extern "C" void kernel_launch(void* const* d_in, const int* in_sizes, int n_in, void* d_out, int out_size, void* d_ws, size_t ws_size, hipStream_t stream) {
    static int grid = 0;
    if (grid == 0) {
        if (n_in != 36 || in_sizes[0] != M_PROMPT * DM || (size_t)out_size != O_END || ws_size < WS_END) {
            fprintf(stderr, "kernel_launch: unexpected shapes: n_in %d in0 %d out %d ws %zu\n", n_in, n_in > 0 ? in_sizes[0] : -1, out_size, ws_size); }
        int dev = 0, cus = 0, per_cu = 0;
        hipGetDevice(&dev); hipDeviceGetAttribute(&cus, hipDeviceAttributeMultiprocessorCount, dev);
        if (hipFuncSetAttribute((const void*)fwd_megakernel, hipFuncAttributeMaxDynamicSharedMemorySize, LDS_BYTES) != hipSuccess) { fprintf(stderr, "kernel_launch: hipFuncSetAttribute failed\n"); grid = -1; return; }
        if (hipOccupancyMaxActiveBlocksPerMultiprocessor(&per_cu, (const void*)fwd_megakernel, NTHREADS, LDS_BYTES) != hipSuccess || per_cu < 1) { fprintf(stderr, "kernel_launch: occupancy query failed (%d)\n", per_cu); (void)hipGetLastError(); per_cu = 1; }
        grid = cus * (per_cu > 1 ? 1 : per_cu);
        fprintf(stderr, "kernel_launch: grid %d (cus %d, per_cu %d)\n", grid, cus, per_cu);
    }
    if (grid < 0) return;
    (void)hipMemsetAsync((char*)d_ws + WS_CTL, 0, 65536, stream);
    KArgs ka{};
    for (int i = 0; i < 36; ++i) ka.a.in[i] = (const float*)d_in[i];
    ka.a.out = (float*)d_out; ka.a.ws = (unsigned char*)d_ws;
#if MK_MULTI
    for (int p = 0; p < N_PHASES; ++p) { ka.ph_lo = p; ka.ph_hi = p + 1; hipLaunchKernelGGL(fwd_megakernel, dim3(grid), dim3(NTHREADS), LDS_BYTES, stream, ka); }
#else
    ka.ph_lo = 0; ka.ph_hi = N_PHASES;
    void* args[] = {&ka};
    hipError_t e = hipLaunchCooperativeKernel((const void*)fwd_megakernel, dim3(grid), dim3(NTHREADS), args, LDS_BYTES, stream);
    if (e != hipSuccess) fprintf(stderr, "cooperative launch failed: %s (grid %d)\n", hipGetErrorString(e), grid);
#endif
}
```

```cpp
#include <hip/hip_runtime.h>
#include <hip/hip_cooperative_groups.h>
#include <cstdio>
#include <cstdint>
namespace pg8 {
#define PG8_LAS __attribute__((address_space(3)))
typedef unsigned short bf16_t;
typedef short bf16x8 __attribute__((ext_vector_type(8)));
typedef float f32x4 __attribute__((ext_vector_type(4)));
typedef unsigned u32x4 __attribute__((ext_vector_type(4)));
constexpr int BM = 256, BK = 64, HALF = 128, HTB = HALF * BK * 2  , STAGE_BYTES = 8 * HTB, NXCD = 8, WGM = 8;

__host__ __device__ __forceinline__ int lds_byte(int r, int c) { const int st = (r >> 4) * 2 + (c >> 5), rr = r & 15, cc = c & 31, ob = rr * 64 + cc * 2; return st * 1024 + (ob ^ (((ob >> 9) & 1) << 5)); }
__host__ __device__ __forceinline__ void stage_rc(int b, int& R, int& C) { const int st = b / 1024, sb = b % 1024, swz = sb ^ (((sb >> 9) & 1) << 5); R = (st >> 1) * 16 + swz / 64; C = (st & 1) * 32 + (swz % 64) / 2; }
__host__ __device__ __forceinline__ int perm32(int rho) { const int n = rho >> 4, i = rho & 15; return 8 * (i >> 2) + 4 * n + (i & 3); }

struct Unit { int pm, pn; };
struct Gemm { const bf16_t* A; const bf16_t* Bt; int M, N, K; };

struct StaticOrder {
    int nM, nN, nwg, G, c;
    __host__ __device__ void init(int M, int N, int G_, int c_) { nM = M / BM; nN = N / BM; nwg = nM * nN; G = G_; c = c_; }
    __host__ __device__ bool next(int i, Unit& u) const {
        const long L = (long)i * G + c; if (L >= nwg) return false;
        int wgid = (int)L; { const int q = nwg / NXCD, r = nwg % NXCD, xcd = wgid % NXCD, off = wgid / NXCD; wgid = (xcd < r ? xcd * (q + 1) : r * (q + 1) + (xcd - r) * q) + off; }
        const int nig = WGM * nN, gid = wgid / nig, fm = gid * WGM, gsz = (nM - fm) < WGM ? (nM - fm) : WGM;
        u.pm = fm + ((wgid % nig) % gsz); u.pn = (wgid % nig) / gsz; return true;
    }
    __device__ __forceinline__ void a_ready(const Unit&) const {}
    __device__ __forceinline__ void done(const Unit&) const {}
};

__device__ __forceinline__ unsigned cvt_pk_bf16(float lo, float hi) { unsigned r; asm volatile("v_cvt_pk_bf16_f32 %0, %1, %2" : "=v"(r) : "v"(lo), "v"(hi)); return r; }
typedef float f32x2 __attribute__((ext_vector_type(2)));
constexpr float RMS_EPS = 1e-6f;
__device__ __forceinline__ float row_rstd(const float* ssp, size_t row) {
    const f32x4* p = (const f32x4*)(ssp + row * 16); const f32x4 a = p[0], b = p[1], c = p[2], d = p[3];
    const float s = (((a[0] + a[1]) + (a[2] + a[3])) + ((b[0] + b[1]) + (b[2] + b[3]))) + (((c[0] + c[1]) + (c[2] + c[3])) + ((d[0] + d[1]) + (d[2] + d[3])));
    return __builtin_amdgcn_rsqf(s * (1.0f / 1024.0f) + RMS_EPS);
}
__device__ __forceinline__ float row_rstd_q(const float* ssp, size_t row, int fq) {
    const f32x4 a = *(const f32x4*)(ssp + row * 16 + 4 * fq);
    float s = (a[0] + a[1]) + (a[2] + a[3]);
    s += __shfl_xor(s, 16); s += __shfl_xor(s, 32);
    return __builtin_amdgcn_rsqf(s * (1.0f / 1024.0f) + RMS_EPS);
}
__device__ __forceinline__ float fast_sigmoid(float x) { return __builtin_amdgcn_rcpf(1.0f + __builtin_amdgcn_exp2f(-1.4426950408889634f * x)); }
struct EpiProj {
    static constexpr bool PERM = true, AFTER_DRAIN = false;
    bf16_t* O; int ldc; const float* ss;
    __device__ __forceinline__ void operator()(const f32x4 (&acc)[2][2][4][2], const Unit& u, int wr, int wc, int fr, int fq) const {
        const int row0 = u.pm * BM + wr * 64 + fr, col0 = u.pn * BM + wc * 32 + 8 * fq;
#pragma unroll
        for (int ai = 0; ai < 2; ++ai)
#pragma unroll
            for (int m = 0; m < 4; ++m) {
                const int row = row0 + ai * HALF + m * 16;
                const float rs = row_rstd_q(ss, (size_t)row, fq);
                bf16_t* rowp = O + (size_t)row * ldc + col0;
#pragma unroll
                for (int bj = 0; bj < 2; ++bj) { const f32x4 v0 = acc[ai][bj][m][0] * rs, v1 = acc[ai][bj][m][1] * rs;
                    u32x4 w; w.x = cvt_pk_bf16(v0[0], v0[1]); w.y = cvt_pk_bf16(v0[2], v0[3]); w.z = cvt_pk_bf16(v1[0], v1[1]); w.w = cvt_pk_bf16(v1[2], v1[3]);
                    *(u32x4*)(rowp + bj * HALF) = w; }
            }
    }
};
struct EpiGateUp {
    static constexpr bool PERM = true, AFTER_DRAIN = false;
    bf16_t* O; int ldc; const float* ss;
    __device__ __forceinline__ void operator()(const f32x4 (&acc)[2][2][4][2], const Unit& u, int wr, int wc, int fr, int fq) const {
        const int row0 = u.pm * BM + wr * 64 + fr, col0 = u.pn * HALF + wc * 32 + 8 * fq;
#pragma unroll
        for (int ai = 0; ai < 2; ++ai)
#pragma unroll
            for (int m = 0; m < 4; ++m) {
                const int row = row0 + ai * HALF + m * 16;
                const float rs = row_rstd_q(ss, (size_t)row, fq);
                float hv[8];
#pragma unroll
                for (int n = 0; n < 2; ++n)
#pragma unroll
                    for (int e = 0; e < 4; ++e) { const float g = acc[ai][0][m][n][e] * rs, up = acc[ai][1][m][n][e] * rs; hv[n * 4 + e] = g * fast_sigmoid(g) * up; }
                u32x4 w; w.x = cvt_pk_bf16(hv[0], hv[1]); w.y = cvt_pk_bf16(hv[2], hv[3]); w.z = cvt_pk_bf16(hv[4], hv[5]); w.w = cvt_pk_bf16(hv[6], hv[7]);
                *(u32x4*)(O + (size_t)row * ldc + col0) = w;
            }
    }
};
struct EpiRes {
    static constexpr bool PERM = true, AFTER_DRAIN = false;
    bf16_t* xb; float* ssn;
    __device__ __forceinline__ void operator()(const f32x4 (&acc)[2][2][4][2], const Unit& u, int wr, int wc, int fr, int fq) const {
        const int col0 = u.pn * BM + wc * 32 + 8 * fq;
#pragma unroll
        for (int ai = 0; ai < 2; ++ai)
#pragma unroll
            for (int m = 0; m < 4; ++m) {
                const size_t row = (size_t)u.pm * BM + ai * HALF + wr * 64 + m * 16 + fr;
                float ssq = 0.f;
#pragma unroll
                for (int bj = 0; bj < 2; ++bj) { bf16_t* p = xb + row * 1024 + col0 + bj * HALF;
                    const u32x4 b = *(const u32x4*)p; const f32x4 a0 = acc[ai][bj][m][0], a1 = acc[ai][bj][m][1];
                    float o[8];
                    o[0] = __uint_as_float(b.x << 16) + a0[0]; o[1] = __uint_as_float(b.x & 0xffff0000u) + a0[1]; o[2] = __uint_as_float(b.y << 16) + a0[2]; o[3] = __uint_as_float(b.y & 0xffff0000u) + a0[3];
                    o[4] = __uint_as_float(b.z << 16) + a1[0]; o[5] = __uint_as_float(b.z & 0xffff0000u) + a1[1]; o[6] = __uint_as_float(b.w << 16) + a1[2]; o[7] = __uint_as_float(b.w & 0xffff0000u) + a1[3];
                    ssq += ((o[0] * o[0] + o[1] * o[1]) + (o[2] * o[2] + o[3] * o[3])) + ((o[4] * o[4] + o[5] * o[5]) + (o[6] * o[6] + o[7] * o[7]));
                    u32x4 w; w.x = cvt_pk_bf16(o[0], o[1]); w.y = cvt_pk_bf16(o[2], o[3]); w.z = cvt_pk_bf16(o[4], o[5]); w.w = cvt_pk_bf16(o[6], o[7]); *(u32x4*)p = w; }
                ssq += __shfl_xor(ssq, 16); ssq += __shfl_xor(ssq, 32);
                if (fq == 0) ssn[row * 16 + u.pn * 4 + wc] = ssq;
            }
    }
};

struct GuOrder : StaticOrder {
    int npre, lo, hi;
    __device__ __forceinline__ bool next(int i, Unit& u) const {
        const long L = (long)lo + (long)i * G + c; if (L >= hi) return false;
        if (L < npre) { u.pm = 64 + (int)L / nN; u.pn = (int)L % nN; return true; }
        int wgid = (int)(L - npre); { const int q = nwg / NXCD, r = nwg % NXCD, xcd = wgid % NXCD, off = wgid / NXCD; wgid = (xcd < r ? xcd * (q + 1) : r * (q + 1) + (xcd - r) * q) + off; }
        const int nig = WGM * nN, gid = wgid / nig, fm = gid * WGM, gsz = (nM - fm) < WGM ? (nM - fm) : WGM;
        u.pm = fm + ((wgid % nig) % gsz); u.pn = (wgid % nig) / gsz; return true;
    }
    __device__ __forceinline__ void a_ready(const Unit&) const {}
    __device__ __forceinline__ void done(const Unit&) const {}
};
struct SampleOrder {
    int c0, c;
    __device__ __forceinline__ bool next(int i, Unit& u) const { if (i != 0 || c < c0 || c >= c0 + 32) return false; u.pm = 64 + (c - c0) / 4; u.pn = (c - c0) % 4; return true; }
    __device__ __forceinline__ void a_ready(const Unit&) const {}
    __device__ __forceinline__ void done(const Unit&) const {}
};
template <class Epi, class Sched, bool ALIGN_EPI = false, bool SP2 = false>
__device__ __forceinline__ void gemm_phase(PG8_LAS unsigned char* lds, const Gemm g, const Sched& S, const Epi& E) {
    int tid_ = threadIdx.x; asm volatile("" : "+v"(tid_));
    const int tid = tid_, wid = __builtin_amdgcn_readfirstlane(tid >> 6), lane = tid & 63, wr = wid >> 2, wc = wid & 3, fr = lane & 15, fq = lane >> 4;
    const int K = g.K, nt = K / BK;
    unsigned voffA[2], voffB[2];
#pragma unroll
    for (int i = 0; i < 2; ++i) { int R, C; stage_rc(tid * 16 + i * 8192, R, C); const int Rb = Epi::PERM ? ((R & ~31) + perm32(R & 31)) : R;
        voffA[i] = (unsigned)(R * K + C) * 2u; voffB[i] = (unsigned)(Rb * K + C) * 2u; }
    const size_t kstep = (size_t)(BK * 2);
    const size_t hstep = (size_t)HALF * K * 2;
    const size_t tstep = 2 * hstep;
    const unsigned ldsw = (unsigned)wid * 1024u;
    const int aoff = lds_byte(wr * 64 + fr, fq * 8), boff = lds_byte(wc * 32 + fr, fq * 8);
#define PG8_SA(b, h) (((b) * 2 + (h)) * HTB)
#define PG8_SB(b, h) ((4 + (b) * 2 + (h)) * HTB)
#define PG8_STAGE(bufoff, gbase, voff) do { _Pragma("unroll") for (int _i = 0; _i < 2; ++_i) \
        __builtin_amdgcn_global_load_lds((const unsigned*)((const char*)(gbase) + (voff)[_i]), (PG8_LAS unsigned*)(lds + (bufoff) + ldsw + _i * 8192), 16, 0, 0); } while (0)
#define PG8_LDA(dst, b, h) do { _Pragma("unroll") for (int m = 0; m < 4; ++m) _Pragma("unroll") for (int k = 0; k < 2; ++k) dst[m][k] = *(const PG8_LAS bf16x8*)(lds + PG8_SA(b, h) + aoff + m * 2048 + k * 1024); } while (0)
#define PG8_LDB(dst, b, h) do { _Pragma("unroll") for (int n = 0; n < 2; ++n) _Pragma("unroll") for (int k = 0; k < 2; ++k) dst[n][k] = *(const PG8_LAS bf16x8*)(lds + PG8_SB(b, h) + boff + n * 2048 + k * 1024); } while (0)
#define PG8_MMA(ai, bj, At, Bt) do { __builtin_amdgcn_s_setprio(1); _Pragma("unroll") for (int m = 0; m < 4; ++m) _Pragma("unroll") for (int n = 0; n < 2; ++n) _Pragma("unroll") for (int k = 0; k < 2; ++k) \
        acc[ai][bj][m][n] = __builtin_amdgcn_mfma_f32_16x16x32_bf16(Bt[n][k], At[m][k], acc[ai][bj][m][n], 0, 0, 0); __builtin_amdgcn_s_setprio(0); } while (0)
#define PG8_WAIT_V(n) asm volatile("s_waitcnt vmcnt(" #n ")" ::: "memory")
#define PG8_WAIT_L(n) asm volatile("s_waitcnt lgkmcnt(" #n ")" ::: "memory")
#define PG8_BAR __builtin_amdgcn_s_barrier()
#define PG8_SCHED __builtin_amdgcn_sched_barrier(0)
    Unit cur, nxt; int ui = 0;
    if (!S.next(0, cur)) return;
    f32x4 acc[2][2][4][2];
#pragma unroll
    for (int a = 0; a < 2; ++a)
#pragma unroll
        for (int b = 0; b < 2; ++b)
#pragma unroll
            for (int m = 0; m < 4; ++m)
#pragma unroll
                for (int n = 0; n < 2; ++n) acc[a][b][m][n] = (f32x4){0.f, 0.f, 0.f, 0.f};
    bf16x8 At[4][2], B0[2][2], B1[2][2];
    const char* cA = (const char*)g.A + (size_t)cur.pm * tstep; const char* cB = (const char*)g.Bt + (size_t)cur.pn * tstep;
    S.a_ready(cur);
    if constexpr (SP2) {
        PG8_STAGE(PG8_SB(0, 0), cB, voffB); PG8_STAGE(PG8_SB(0, 1), cB + hstep, voffB); PG8_STAGE(PG8_SA(0, 0), cA, voffA); PG8_STAGE(PG8_SA(0, 1), cA + hstep, voffA);
        if (wr == 1) PG8_BAR;
        PG8_WAIT_V(2); PG8_BAR;
        PG8_STAGE(PG8_SB(1, 0), cB + kstep, voffB); PG8_STAGE(PG8_SA(1, 0), cA + kstep, voffA); PG8_STAGE(PG8_SB(1, 1), cB + hstep + kstep, voffB);
        PG8_WAIT_V(6); PG8_BAR;
    } else {
        PG8_STAGE(PG8_SB(0, 0), cB, voffB); PG8_STAGE(PG8_SA(0, 0), cA, voffA); PG8_STAGE(PG8_SB(0, 1), cB + hstep, voffB); PG8_STAGE(PG8_SA(0, 1), cA + hstep, voffA);
        if (wr == 1) PG8_BAR;
        PG8_WAIT_V(4); PG8_BAR;
        PG8_STAGE(PG8_SB(1, 0), cB + kstep, voffB); PG8_STAGE(PG8_SA(1, 0), cA + kstep, voffA); PG8_STAGE(PG8_SB(1, 1), cB + hstep + kstep, voffB);
        PG8_WAIT_V(6); PG8_BAR;
    }
    for (;;) {
        const bool has_next = S.next(ui + 1, nxt);
        const char* nA = has_next ? (const char*)g.A + (size_t)nxt.pm * tstep : cA; const char* nB = has_next ? (const char*)g.Bt + (size_t)nxt.pn * tstep : cB;
        for (int t = 0; t < nt; t += 2) {
            const bool last = (t == nt - 2);
            const char* a1 = cA + (size_t)(t + 1) * kstep;
            const char* a2 = last ? nA : cA + (size_t)(t + 2) * kstep; const char* b2 = last ? nB : cB + (size_t)(t + 2) * kstep;
            const char* a3 = a2 + kstep; const char* b3 = b2 + kstep;
            if (last && has_next) S.a_ready(nxt);
            if constexpr (SP2) {
            PG8_LDB(B0, 0, 0); PG8_LDB(B1, 0, 1); PG8_SCHED; PG8_LDA(At, 0, 0); PG8_STAGE(PG8_SA(1, 1), a1 + hstep, voffA);
            PG8_WAIT_V(8); PG8_WAIT_L(0); PG8_BAR; PG8_MMA(0, 0, At, B0); PG8_MMA(0, 1, At, B1); PG8_BAR; PG8_SCHED;
            PG8_LDA(At, 0, 1); PG8_STAGE(PG8_SB(0, 0), b2, voffB); PG8_STAGE(PG8_SB(0, 1), b2 + hstep, voffB); PG8_STAGE(PG8_SA(0, 0), a2, voffA);
            PG8_WAIT_V(8); PG8_WAIT_L(0); PG8_BAR; PG8_MMA(1, 0, At, B0); PG8_MMA(1, 1, At, B1); PG8_BAR; PG8_SCHED;
            PG8_LDB(B0, 1, 0); PG8_LDB(B1, 1, 1); PG8_SCHED; PG8_LDA(At, 1, 0); PG8_STAGE(PG8_SA(0, 1), a2 + hstep, voffA);
            PG8_WAIT_V(8); PG8_WAIT_L(0); PG8_BAR; PG8_MMA(0, 0, At, B0); PG8_MMA(0, 1, At, B1); PG8_BAR; PG8_SCHED;
            PG8_LDA(At, 1, 1); PG8_STAGE(PG8_SB(1, 0), b3, voffB); PG8_STAGE(PG8_SB(1, 1), b3 + hstep, voffB); PG8_STAGE(PG8_SA(1, 0), a3, voffA);
            PG8_WAIT_V(8); PG8_WAIT_L(0); PG8_BAR; PG8_MMA(1, 0, At, B0); PG8_MMA(1, 1, At, B1); PG8_BAR; PG8_SCHED;
            } else {
            PG8_LDB(B0, 0, 0); PG8_SCHED; PG8_LDA(At, 0, 0); PG8_STAGE(PG8_SA(1, 1), a1 + hstep, voffA);
            PG8_WAIT_L(8); PG8_BAR; PG8_WAIT_L(0); PG8_MMA(0, 0, At, B0); PG8_BAR; PG8_SCHED;
            PG8_LDB(B1, 0, 1); PG8_STAGE(PG8_SB(0, 0), b2, voffB);
            PG8_BAR; PG8_WAIT_L(0); PG8_MMA(0, 1, At, B1); PG8_BAR;
            PG8_LDA(At, 0, 1); PG8_STAGE(PG8_SA(0, 0), a2, voffA);
            PG8_BAR; PG8_WAIT_L(0); PG8_MMA(1, 0, At, B0); PG8_BAR; PG8_SCHED;
            PG8_STAGE(PG8_SB(0, 1), b2 + hstep, voffB);
            PG8_WAIT_V(6); PG8_BAR; PG8_MMA(1, 1, At, B1); PG8_BAR;
            PG8_LDB(B0, 1, 0); PG8_SCHED; PG8_LDA(At, 1, 0); PG8_STAGE(PG8_SA(0, 1), a2 + hstep, voffA);
            PG8_WAIT_L(8); PG8_BAR; PG8_WAIT_L(0); PG8_MMA(0, 0, At, B0); PG8_BAR; PG8_SCHED;
            PG8_LDB(B1, 1, 1); PG8_STAGE(PG8_SB(1, 0), b3, voffB);
            PG8_BAR; PG8_WAIT_L(0); PG8_MMA(0, 1, At, B1); PG8_BAR;
            PG8_LDA(At, 1, 1); PG8_STAGE(PG8_SA(1, 0), a3, voffA);
            PG8_BAR; PG8_WAIT_L(0); PG8_MMA(1, 0, At, B0); PG8_BAR; PG8_SCHED;
            PG8_STAGE(PG8_SB(1, 1), b3 + hstep, voffB);
            PG8_WAIT_V(6); PG8_BAR; PG8_MMA(1, 1, At, B1); PG8_BAR;
            }
        }
        if constexpr (ALIGN_EPI) { if (wr == 0) PG8_BAR; }
        if constexpr (!Epi::AFTER_DRAIN) { E(acc, cur, wr, wc, fr, fq); S.done(cur); }
        if (!has_next) break;
#pragma unroll
        for (int a = 0; a < 2; ++a)
#pragma unroll
            for (int b = 0; b < 2; ++b)
#pragma unroll
                for (int m = 0; m < 4; ++m)
#pragma unroll
                    for (int n = 0; n < 2; ++n) acc[a][b][m][n] = (f32x4){0.f, 0.f, 0.f, 0.f};
        cur = nxt; cA = nA; cB = nB; ++ui;
        if constexpr (ALIGN_EPI) { if (wr == 1) PG8_BAR; }
    }
    PG8_WAIT_V(0);
    if constexpr (!ALIGN_EPI) { if (wr == 0) PG8_BAR; }
    PG8_BAR;
    if constexpr (Epi::AFTER_DRAIN) { E.fused(acc, cur, wr, wc, fr, fq, lds, wid, lane); S.done(cur); }
#undef PG8_SA
#undef PG8_SB
#undef PG8_STAGE
#undef PG8_LDA
#undef PG8_LDB
#undef PG8_MMA
#undef PG8_WAIT_V
#undef PG8_WAIT_L
#undef PG8_BAR
#undef PG8_SCHED
}
}
namespace cg = cooperative_groups;
#define LAS __attribute__((address_space(3)))
typedef unsigned short bf16;
typedef unsigned v4u __attribute__((ext_vector_type(4)));
typedef unsigned v2u __attribute__((ext_vector_type(2)));
typedef float f32x4 __attribute__((ext_vector_type(4)));
typedef float f32x2v __attribute__((ext_vector_type(2)));
typedef short bf16x8 __attribute__((ext_vector_type(8)));
typedef short bf16x4 __attribute__((ext_vector_type(4)));

constexpr int NWAVES = 8, NTHREADS = 512;
constexpr int DM = 1024, M_TOK = 18432, M_PROMPT = 16384, NCHUNK = 288, NPCH = 256;
constexpr int D_IN = 2560, D_FF = 2816, DA = 384, DB = 256, DC = 384;
constexpr int CQ = 0, CF = 384, CI = 768, CG = 1152, CU = 1536, CXR = 1792, CGR = 2176;
constexpr float EPS = 1e-6f;
constexpr size_t O_Y = 0, O_HP = 18874368, O_SRP = O_HP + 196608, O_SIP = O_SRP + 8192, O_LP = O_SIP + 8192, O_CP = O_LP + 3072,
                 O_HS = O_CP + 9216, O_SRS = O_HS + 1572864, O_SIS = O_SRS + 65536, O_LS = O_SIS + 65536, O_CS = O_LS + 24576, O_END = O_CS + 73728;
constexpr size_t MiB = 1u << 20;
constexpr size_t WS_CTL = 0, CTL_ZERO_BYTES = 1 * MiB, WS_SS = 64 * 1024, WS_TAB = 1 * MiB;
constexpr size_t WS_WIN = 2 * MiB, WS_WOUT = 12 * MiB, WS_WGU = 16 * MiB, WS_WDN = 38 * MiB, WS_SMALL = 49 * MiB;
constexpr size_t SM_LBS = 0, SM_S5A = 4096, SM_S5A64 = SM_S5A + 16384, SM_BB = SM_S5A64 + 16384, SM_CC = SM_BB + 131072, SM_WGT = SM_CC + 131072,
                 SM_WAT = SM_WGT + 262144, SM_WXT = SM_WAT + 98304, SM_SP = SM_WXT + 98304, SM_END = SM_SP + 4096;
static_assert(SM_END <= 3 * MiB, "small tables");
constexpr size_t WS_XB = 52 * MiB, WS_PROJ = 88 * MiB, WS_MIX = 178 * MiB, WS_HID = 88 * MiB;
constexpr size_t WS_HST = 214 * MiB, WS_HD = 238 * MiB, WS_S5ST = 239 * MiB, WS_LRUST = 241 * MiB, WS_SSP = 243 * MiB, WS_END = 249 * MiB;
constexpr int LDS_BYTES = 147456, XB_LDS_OFF = 147456 - 256;

struct Args { const float* in[36]; float* out; unsigned char* ws; };
enum { I_XP = 0, I_XS, I_SH, I_SSR, I_SSI, I_SL, I_SC, I_NMIX, I_WIN, I_HLB, I_HNORM, I_S5LR, I_S5LI, I_S5DT, I_S5BR, I_S5BI, I_S5CR, I_S5CI, I_S5D, I_S5WG, I_S5BG, I_S5N,
       I_LCW, I_LCB, I_LWA, I_LBA, I_LWX, I_LBX, I_LLAM, I_LNORM, I_WOUT, I_NFFN, I_WG, I_WU, I_WD, I_NFIN };


__device__ __forceinline__ unsigned long long rfl64(unsigned long long v) { return ((unsigned long long)(unsigned)__builtin_amdgcn_readfirstlane((int)(unsigned)(v >> 32)) << 32) | (unsigned long long)(unsigned)__builtin_amdgcn_readfirstlane((int)(unsigned)v); }
#define GAS __attribute__((address_space(1)))
typedef __attribute__((address_space(4))) const unsigned char KSEG;
__device__ __forceinline__ const Args& kargs() { KSEG* p = (KSEG*)__builtin_amdgcn_kernarg_segment_ptr(); asm volatile("" : "+s"(p)); return *(const Args*)(const void*)p; }
__device__ __forceinline__ const float* gp(const Args& a, int k) { return (const float*)(const GAS float*)a.in[k]; }
__device__ __forceinline__ unsigned char* gws(const Args& a) { return (unsigned char*)(GAS unsigned char*)a.ws; }
__device__ __forceinline__ float* gout(const Args& a) { return (float*)(GAS float*)a.out; }
__device__ __forceinline__ float bf2f(bf16 b) { return __uint_as_float((unsigned)b << 16); }
__device__ __forceinline__ unsigned pk2(float lo, float hi) { return pg8::cvt_pk_bf16(lo, hi); }
__device__ __forceinline__ bf16 f2bf(float f) { return (bf16)(pk2(f, 0.f) & 0xffffu); }
__device__ __forceinline__ float sigm(float x) { return __builtin_amdgcn_rcpf(1.0f + __builtin_amdgcn_exp2f(-1.4426950408889634f * x)); }
__device__ __forceinline__ float gelu_tanh(float x) { const float u = 0.7978845608028654f * (x + 0.044715f * x * x * x); return x * sigm(2.0f * u); }
#define LAUNDER_V(x) asm volatile("" : "+v"(x))
#define BSYNC() asm volatile("s_waitcnt lgkmcnt(0)\n\ts_barrier" ::: "memory")
#define LDS_WAIT() asm volatile("s_waitcnt lgkmcnt(0)" ::: "memory")
#define WAVE_SYNC() do { asm volatile("s_waitcnt lgkmcnt(0)" ::: "memory"); __builtin_amdgcn_wave_barrier(); } while (0)
#define MFMA16(a, b, c) __builtin_amdgcn_mfma_f32_16x16x32_bf16((a), (b), (c), 0, 0, 0)
__device__ __forceinline__ float wave_sum(float v) {
#pragma unroll
    for (int o = 1; o < 64; o <<= 1) v += __shfl_xor(v, o);
    return v;
}

#define XB_TMO      128
#define XB_XCNT(j)  (256  + 64 * (j))
#define XB_XSUB(j)  (1280 + 64 * (j))
#define XB_XGEN(j)  (2304 + 64 * (j))
#define XB_TOP      3328
#define XB_TOPGEN   3392
#define XCD_BAR_WORDS 3456
#define XB_SPIN_CAP (1u << 18)

__device__ __forceinline__ unsigned xb_ld(unsigned* p)              { return __hip_atomic_load(p, __ATOMIC_RELAXED, __HIP_MEMORY_SCOPE_AGENT); }
__device__ __forceinline__ unsigned xb_add(unsigned* p, unsigned v) { return __hip_atomic_fetch_add(p, v, __ATOMIC_RELAXED, __HIP_MEMORY_SCOPE_AGENT); }
__device__ __forceinline__ unsigned xb_xcc_id() { return (unsigned)__builtin_amdgcn_s_getreg((3 << 11) | 20) & 0xFu; }
#define XB_SPIN(cond, bar) do { unsigned _sp = 0; while (cond) { __builtin_amdgcn_s_sleep(1); \
    if ((++_sp & 255u) == 0u) { if (xb_ld(&(bar)[XB_TMO])) break; if (_sp > XB_SPIN_CAP) { atomicAdd(&(bar)[XB_TMO], 1u); break; } } } } while (0)

struct XcdBarrier {
    unsigned* bar; unsigned x;
    volatile LAS unsigned* st;
};

__device__ __forceinline__ XcdBarrier xcd_barrier_post(unsigned* bar, volatile LAS unsigned* st) {
    XcdBarrier b; b.bar = bar; b.x = xb_xcc_id(); b.st = st;
    if (threadIdx.x == 0) (void)xb_add(&bar[XB_XCNT(b.x)], 1u);
    return b;
}
__device__ __forceinline__ void xcd_barrier_complete(unsigned* bar, unsigned x, unsigned& nloc, unsigned& nx) {
    const unsigned G = gridDim.x * gridDim.y * gridDim.z;
    unsigned sum, cnt, mine, sp = 0u;
    for (;;) {
        sum = 0u; cnt = 0u; mine = 0u;
#pragma unroll
        for (unsigned j = 0; j < 16; ++j) { const unsigned c = xb_ld(&bar[XB_XCNT(j)]); sum += c; cnt += (c > 0u) ? 1u : 0u; mine = (j == x) ? c : mine; }
        if (sum == G) break;
        __builtin_amdgcn_s_sleep(1);
        if ((++sp & 255u) == 0u) { if (xb_ld(&bar[XB_TMO])) break; if (sp > XB_SPIN_CAP) { atomicAdd(&bar[XB_TMO], 1u); break; } }
    }
    nloc = mine > 0u ? mine : 1u; nx = cnt > 0u ? cnt : 1u;
}

__device__ __forceinline__ void xcd_barrier(const XcdBarrier& b) {
    asm volatile("s_waitcnt vmcnt(0)" ::: "memory");
    __syncthreads();
    if (threadIdx.x == 0) {
        unsigned* bar = b.bar;
        __builtin_amdgcn_s_waitcnt(0);
        unsigned nloc = b.st[0], nx = b.st[1];
        if (nloc == 0u) { xcd_barrier_complete(bar, b.x, nloc, nx); b.st[0] = nloc; b.st[1] = nx; }
        const unsigned old = xb_add(&bar[XB_XSUB(b.x)], 1u);
        const unsigned gen = old / nloc;
        if (old + 1u == (gen + 1u) * nloc) {
            __builtin_amdgcn_fence(__ATOMIC_RELEASE, "agent");
            asm volatile("s_waitcnt vmcnt(0)" ::: "memory");
            const unsigned og = xb_add(&bar[XB_TOP], 1u);
            const unsigned tg = og / nx;
            if (og + 1u == (tg + 1u) * nx) xb_add(&bar[XB_TOPGEN], 1u);
            else XB_SPIN(xb_ld(&bar[XB_TOPGEN]) == tg, bar);
            __builtin_amdgcn_fence(__ATOMIC_ACQUIRE, "agent");
            xb_add(&bar[XB_XGEN(b.x)], 1u);
            asm volatile("s_waitcnt vmcnt(0)" ::: "memory");
        } else {
            XB_SPIN(xb_ld(&bar[XB_XGEN(b.x)]) == gen, bar);
            __builtin_amdgcn_fence(__ATOMIC_ACQUIRE, "agent");
            asm volatile("s_waitcnt vmcnt(0)" ::: "memory");
        }
    }
    __syncthreads();
}

__device__ __forceinline__ void p0_transpose_item(const float* W, int K, int N, bf16* WT, int k0, int n0, int drow0, const float* kscale, LAS float* scr, int lane) {
    const int c = lane & 7;
    f32x4 ks0 = {1.f, 1.f, 1.f, 1.f}, ks1 = {1.f, 1.f, 1.f, 1.f};
    if (kscale) { ks0 = *(const f32x4*)(kscale + k0 + 8 * c); ks1 = *(const f32x4*)(kscale + k0 + 8 * c + 4); }
    const float* wp = W + (size_t)(k0 + (lane >> 5)) * N + n0 + (lane & 31);
#pragma unroll
    for (int i = 0; i < 32; ++i) scr[(2 * i + (lane >> 5)) * 33 + (lane & 31)] = wp[(size_t)(2 * i) * N];
    LDS_WAIT(); asm volatile("" ::: "memory");
#pragma unroll
    for (int j = 0; j < 4; ++j) { const int n = (lane >> 3) + 8 * j; const LAS float* s = scr + (8 * c) * 33 + n;
        v4u o; o.x = pk2(s[0 * 33] * ks0.x, s[1 * 33] * ks0.y); o.y = pk2(s[2 * 33] * ks0.z, s[3 * 33] * ks0.w); o.z = pk2(s[4 * 33] * ks1.x, s[5 * 33] * ks1.y); o.w = pk2(s[6 * 33] * ks1.z, s[7 * 33] * ks1.w);
        *(v4u*)(WT + (size_t)(drow0 + n) * K + k0 + 8 * c) = o; }
    LDS_WAIT(); asm volatile("" ::: "memory");
}

__device__ __forceinline__ void convert_weights(const Args& a, int l, LAS unsigned char* lds, int lane, int wave, int w, int nw, int part = 4  ) {
    unsigned char* ws = gws(a);
    LAS float* scr = (LAS float*)(lds + wave * 16384);
    constexpr int IT_IN = 16 * 80, IT_OUT = 16 * 32, IT_G = 16 * 88, IT_D = 44 * 32;
    constexpr int NITEMS = IT_IN + IT_OUT + 2 * IT_G + IT_D;
    const int it_lo = part == 4 ? 0 : (part == 0 ? 0 : part == 1 ? IT_IN : part == 2 ? IT_IN + IT_OUT : IT_IN + IT_OUT + 2 * IT_G);
    const int it_hi = part == 4 ? NITEMS : (part == 0 ? IT_IN : part == 1 ? IT_IN + IT_OUT : part == 2 ? IT_IN + IT_OUT + 2 * IT_G : NITEMS);
    for (int it = it_lo + w; it < it_hi; it += nw) {
        int r = it;
        if (r < IT_IN) { const int kb = r / 80, nb = r % 80;
            p0_transpose_item(gp(a, I_WIN) + (size_t)l * DM * D_IN, DM, D_IN, (bf16*)(ws + WS_WIN) + (size_t)l * D_IN * DM, 64 * kb, 32 * nb, 32 * nb, gp(a, I_NMIX) + l * DM, scr, lane); continue; }
        r -= IT_IN;
        if (r < IT_OUT) { const int kb = r / 32, nb = r % 32;
            p0_transpose_item(gp(a, I_WOUT) + (size_t)l * DM * DM, DM, DM, (bf16*)(ws + WS_WOUT) + (size_t)l * DM * DM, 64 * kb, 32 * nb, 32 * nb, nullptr, scr, lane); continue; }
        r -= IT_OUT;
        if (r < 2 * IT_G) { const int sel = r / IT_G; r -= sel * IT_G; const int kb = r / 88, nb = r % 88; const int n0 = 32 * nb;
            const int drow0 = 256 * (n0 >> 7) + 128 * sel + (n0 & 127);
            p0_transpose_item(gp(a, sel ? I_WU : I_WG) + (size_t)l * DM * D_FF, DM, D_FF, (bf16*)(ws + WS_WGU) + (size_t)l * 2 * D_FF * DM, 64 * kb, n0, drow0, gp(a, I_NFFN) + l * DM, scr, lane); continue; }
        r -= 2 * IT_G;
        { const int kb = r / 32, nb = r % 32;
            p0_transpose_item(gp(a, I_WD) + (size_t)l * D_FF * DM, D_FF, DM, (bf16*)(ws + WS_WDN) + (size_t)l * DM * D_FF, 64 * kb, 32 * nb, 32 * nb, nullptr, scr, lane); }
    }
}

__device__ __forceinline__ void p0_prologue(const Args& a, LAS unsigned char* lds, int tid, int lane, int wave) {
    unsigned char* ws = gws(a);
    LAS float* scr = (LAS float*)(lds + wave * 16384);
    const int gw = blockIdx.x * NWAVES + wave, NGW = gridDim.x * NWAVES;
    convert_weights(a, 0, lds, lane, wave, gw, NGW, 0);
    {
        bf16* XB = (bf16*)(ws + WS_XB); float* SS0 = (float*)(ws + WS_SSP);
        for (int m0 = gw; m0 < M_TOK; m0 += 3 * NGW) {
            f32x4 v[3][4];
#pragma unroll
            for (int r = 0; r < 3; ++r) { const int m = m0 + r * NGW; if (m < M_TOK) { const float* xrow = (m < M_PROMPT) ? gp(a, I_XP) + (size_t)m * DM : gp(a, I_XS) + (size_t)(m - M_PROMPT) * DM; const f32x4* xr = (const f32x4*)xrow + lane;
#pragma unroll
                for (int j = 0; j < 4; ++j) v[r][j] = xr[64 * j]; } }
#pragma unroll
            for (int r = 0; r < 3; ++r) { const int m = m0 + r * NGW; if (m < M_TOK) { float s = 0.f; unsigned long long* o8 = (unsigned long long*)(XB + (size_t)m * DM) + lane;
#pragma unroll
                for (int j = 0; j < 4; ++j) { const f32x4 x = v[r][j]; s += (x.x * x.x + x.y * x.y) + (x.z * x.z + x.w * x.w); o8[64 * j] = (unsigned long long)pk2(x.x, x.y) | ((unsigned long long)pk2(x.z, x.w) << 32); }
                s = wave_sum(s); if (lane < 16) SS0[(size_t)m * 16 + lane] = (lane == 0) ? s : 0.f; } }
        }
    }
    unsigned char* sm = ws + WS_SMALL;
    const int NGT = gridDim.x * NTHREADS, gt = NGT - 1 - (blockIdx.x * NTHREADS + tid);
    for (int i = gt; i < 2 * DA; i += NGT) {
        const int l = i / DA, j = i % DA; float v = 0.f;
        if (l == 1) { const float l0 = gp(a, I_HLB)[j], l1 = gp(a, I_HLB)[DA + j]; v = 1.0f / (1.0f + expf(l0 - l1)); }
        ((float*)(sm + SM_LBS))[i] = v;
    }
    for (int i = gt; i < 2 * DC; i += NGT) { const float lam = gp(a, I_LLAM)[i]; ((float*)(sm + SM_SP))[i] = -8.0f * log1pf(expf(-lam)); }
    for (int i = gt; i < 2 * 16 * 64; i += NGT) {
        const int lg = i >> 6, p = i & 63;
        const float dt = expf(gp(a, I_S5DT)[lg]); const float lr = fminf(gp(a, I_S5LR)[i], -1e-4f), li = gp(a, I_S5LI)[i];
        const float mag = expf(lr * dt); const float are = mag * cosf(li * dt), aim = mag * sinf(li * dt);
        ((f32x2v*)(sm + SM_S5A))[i] = (f32x2v){are, aim};
        float pr = are, pi = aim;
#pragma unroll
        for (int s = 0; s < 6; ++s) { const float nr_ = pr * pr - pi * pi, ni_ = 2.0f * pr * pi; pr = nr_; pi = ni_; }
        ((f32x2v*)(sm + SM_S5A64))[i] = (f32x2v){pr, pi};
        const float den = lr * lr + li * li, nr = are - 1.0f;
        const float gre = (nr * lr + aim * li) / den, gim = (aim * lr - nr * li) / den;
        bf16* BB = (bf16*)(sm + SM_BB) + ((size_t)lg * 128 + 2 * p) * 16;
#pragma unroll
        for (int n = 0; n < 16; ++n) { const float br = gp(a, I_S5BR)[(size_t)i * 16 + n], bi = gp(a, I_S5BI)[(size_t)i * 16 + n];
            BB[n] = f2bf(gre * br - gim * bi); BB[16 + n] = f2bf(gre * bi + gim * br); }
        bf16* CC = (bf16*)(sm + SM_CC) + (size_t)lg * 16 * 128;
#pragma unroll
        for (int n = 0; n < 16; ++n) { const float cr = gp(a, I_S5CR)[((size_t)lg * 16 + n) * 64 + p], ci = gp(a, I_S5CI)[((size_t)lg * 16 + n) * 64 + p];
            CC[n * 128 + 2 * p] = f2bf(cr); CC[n * 128 + 2 * p + 1] = f2bf(-ci); }
    }
    for (int i = gt; i < 2 * 256 * 256; i += NGT) { const int l = i >> 16, n = (i >> 8) & 255, k = i & 255; ((bf16*)(sm + SM_WGT))[i] = f2bf(gp(a, I_S5WG)[((size_t)l * 256 + k) * 256 + n]); }
    for (int i = gt; i < 2 * 6 * 64 * 64; i += NGT) { const int lh = i >> 12, j = (i >> 6) & 63, ii = i & 63;
        ((bf16*)(sm + SM_WAT))[i] = f2bf(gp(a, I_LWA)[((size_t)lh * 64 + ii) * 64 + j]); ((bf16*)(sm + SM_WXT))[i] = f2bf(gp(a, I_LWX)[((size_t)lh * 64 + ii) * 64 + j]); }
}

constexpr int HG_S = 72;
constexpr int HG_QG = 0, HG_KG = 2304, HG_QE = 4608, HG_KET = 6912, HG_VT = 8960, HG_EGL = 11008, HG_GT = 11264, HG_WAVE_BYTES = 13568;
template <int CTRL> __device__ __forceinline__ float dpp_f(float v) { return __int_as_float(__builtin_amdgcn_update_dpp(0, __float_as_int(v), CTRL, 0xF, 0xF, true)); }
__device__ __forceinline__ float bfe(const v4u (&w)[2], int e) { const unsigned x = w[e >> 3][(e >> 1) & 3]; return __uint_as_float((e & 1) ? (x & 0xffff0000u) : (x << 16)); }
__device__ __forceinline__ bf16 bfraw(const v4u (&w)[2], int e) { const unsigned x = w[e >> 3][(e >> 1) & 3]; return (bf16)((e & 1) ? (x >> 16) : (x & 0xffffu)); }
template <bool OUT>
__device__ __forceinline__ void hgrn_unit(const Args& a, int layer, int cid, int h, LAS unsigned char* wl, int lane) {
    const int fr = lane & 15, fq = lane >> 4;
    unsigned char* ws = gws(a);
    const bf16* proj = (const bf16*)(ws + WS_PROJ) + (size_t)cid * 64 * D_IN;
    const float* lbp = (const float*)(ws + WS_SMALL + SM_LBS) + layer * DA + h * 64 + 16 * fq;
    float* HST = (float*)(ws + WS_HST);
    f32x4 S[4][4];
    {
        const float* s0 = nullptr;
        if (cid >= NPCH) s0 = gp(a, I_SH) + (((size_t)layer * 32 + (cid - NPCH)) * 6 + h) * 4096;
        else if (OUT && (cid & 63) != 0) s0 = HST + ((size_t)(cid - 1) * 6 + h) * 4096;
        if (s0) {
            const float* sp = s0 + (4 * fq) * 64 + fr;
#pragma unroll
            for (int dt = 0; dt < 4; ++dt)
#pragma unroll
                for (int vt = 0; vt < 4; ++vt)
#pragma unroll
                    for (int j = 0; j < 4; ++j) S[dt][vt][j] = sp[(16 * dt + j) * 64 + 16 * vt];
        } else {
#pragma unroll
            for (int dt = 0; dt < 4; ++dt)
#pragma unroll
                for (int vt = 0; vt < 4; ++vt) S[dt][vt] = (f32x4){0.f, 0.f, 0.f, 0.f};
        }
    }
    float gtot[OUT ? 1 : 16];
#pragma unroll
    for (int e = 0; e < (OUT ? 1 : 16); ++e) gtot[e] = 0.f;
    LAS bf16* QG = (LAS bf16*)(wl + HG_QG); LAS bf16* KG = (LAS bf16*)(wl + HG_KG); LAS bf16* QE = (LAS bf16*)(wl + HG_QE);
    LAS bf16* KET = (LAS bf16*)(wl + HG_KET); LAS bf16* VT = (LAS bf16*)(wl + HG_VT); LAS float* EGL = (LAS float*)(wl + HG_EGL); LAS bf16* GT = (LAS bf16*)(wl + HG_GT);
    const bf16x8 zero8 = {0, 0, 0, 0, 0, 0, 0, 0};
    const int rb7 = (lane & 48) | 7, rb15 = (lane & 48) | 15;
#pragma unroll 1
    for (int sb = 0; sb < 4; ++sb) {
        const bf16* prow = proj + (size_t)(sb * 16 + fr) * D_IN + h * 64 + 16 * fq;
        {
            v4u fw[2], iw[2], qw[2], gw[2];
            fw[0] = *(const v4u*)(prow + CF); fw[1] = *(const v4u*)(prow + CF + 8); iw[0] = *(const v4u*)(prow + CI); iw[1] = *(const v4u*)(prow + CI + 8);
            if (OUT) { qw[0] = *(const v4u*)(prow + CQ); qw[1] = *(const v4u*)(prow + CQ + 8); gw[0] = *(const v4u*)(prow + CG); gw[1] = *(const v4u*)(prow + CG + 8); }
            f32x4 lb4[4];
#pragma unroll
            for (int q = 0; q < 4; ++q) lb4[q] = *(const f32x4*)(lbp + 4 * q);
            float G[16], kv[16];
#pragma unroll
            for (int e = 0; e < 16; ++e) { const float lb = lb4[e >> 2][e & 3], oml = 1.0f - lb; const float sg = sigm(bfe(fw, e));
                kv[e] = oml * (1.0f - sg); G[e] = __logf(lb + oml * sg); }
#pragma unroll
            for (int e = 0; e < 16; ++e) { G[e] += dpp_f<0x111>(G[e]); G[e] += dpp_f<0x112>(G[e]); G[e] += dpp_f<0x114>(G[e]); G[e] += dpp_f<0x118>(G[e]); }
            unsigned qgp[8], kgp[8], qep[8]; float egl[16];
#pragma unroll
            for (int e = 0; e < 16; e += 2) {
                float qg2[2], kg2[2], qe2[2];
#pragma unroll
                for (int o = 0; o < 2; ++o) { const int ee = e + o;
                    const float Gr = __shfl(G[ee], rb7), Gl = __shfl(G[ee], rb15);
                    const float eGr = __expf(Gr), eGlr = __expf(Gl - Gr); egl[ee] = eGr * eGlr; if (!OUT) gtot[ee] += Gl;
                    const float e2 = __expf(Gr - G[ee]); const float kg = kv[ee] * e2;
                    KET[(16 * fq + ee) * 16 + fr] = f2bf(kg * eGlr);
                    VT[(16 * fq + ee) * 16 + fr] = bfraw(iw, ee);
                    if (OUT) { const float e1 = __expf(G[ee] - Gr); const float qg = bfe(qw, ee) * e1; qg2[o] = qg; kg2[o] = kg; qe2[o] = qg * eGr; } }
                if (OUT) { qgp[e >> 1] = pk2(qg2[0], qg2[1]); kgp[e >> 1] = pk2(kg2[0], kg2[1]); qep[e >> 1] = pk2(qe2[0], qe2[1]); }
            }
            if (fr == 15) {
#pragma unroll
                for (int q = 0; q < 4; ++q) *(LAS f32x4*)(EGL + 16 * fq + 4 * q) = (f32x4){egl[4 * q], egl[4 * q + 1], egl[4 * q + 2], egl[4 * q + 3]}; }
            if (OUT) {
                *(LAS v4u*)(QG + fr * HG_S + 16 * fq) = (v4u){qgp[0], qgp[1], qgp[2], qgp[3]}; *(LAS v4u*)(QG + fr * HG_S + 16 * fq + 8) = (v4u){qgp[4], qgp[5], qgp[6], qgp[7]};
                *(LAS v4u*)(KG + fr * HG_S + 16 * fq) = (v4u){kgp[0], kgp[1], kgp[2], kgp[3]}; *(LAS v4u*)(KG + fr * HG_S + 16 * fq + 8) = (v4u){kgp[4], kgp[5], kgp[6], kgp[7]};
                *(LAS v4u*)(QE + fr * HG_S + 16 * fq) = (v4u){qep[0], qep[1], qep[2], qep[3]}; *(LAS v4u*)(QE + fr * HG_S + 16 * fq + 8) = (v4u){qep[4], qep[5], qep[6], qep[7]};
                *(LAS v4u*)(GT + fr * HG_S + 16 * fq) = gw[0]; *(LAS v4u*)(GT + fr * HG_S + 16 * fq + 8) = gw[1];
            }
        }
        WAVE_SYNC();
        if (OUT) {
            f32x4 at = {0.f, 0.f, 0.f, 0.f};
#pragma unroll
            for (int kk = 0; kk < 2; ++kk) { const bf16x8 A = *(const LAS bf16x8*)(KG + fr * HG_S + kk * 32 + fq * 8), B = *(const LAS bf16x8*)(QG + fr * HG_S + kk * 32 + fq * 8); at = MFMA16(A, B, at); }
#pragma unroll
            for (int j = 0; j < 4; ++j) if (4 * fq + j > fr) at[j] = 0.f;
            union { bf16x8 v; unsigned u[4]; } Aatt; Aatt.u[0] = pk2(at[0], at[1]); Aatt.u[1] = pk2(at[2], at[3]); Aatt.u[2] = 0u; Aatt.u[3] = 0u;
            union { bf16x8 v; v2u h[2]; } Aq[2];
#pragma unroll
            for (int kk = 0; kk < 2; ++kk) { Aq[kk].h[0] = *(const LAS v2u*)(QE + fr * HG_S + kk * 32 + 4 * fq); Aq[kk].h[1] = *(const LAS v2u*)(QE + fr * HG_S + kk * 32 + 16 + 4 * fq); }
            f32x4 ov[4]; float ssq[4] = {0.f, 0.f, 0.f, 0.f};
#pragma unroll
            for (int vt = 0; vt < 4; ++vt) {
                union { bf16x8 v; v2u h[2]; } Bv; Bv.h[0] = *(const LAS v2u*)(VT + (16 * vt + fr) * 16 + 4 * fq); Bv.h[1] = (v2u){0u, 0u};
                f32x4 o = {0.f, 0.f, 0.f, 0.f};
                o = MFMA16(Aatt.v, Bv.v, o);
#pragma unroll
                for (int kk = 0; kk < 2; ++kk) { union { bf16x8 v; unsigned u[4]; } Bs;
                    Bs.u[0] = pk2(S[2 * kk][vt][0], S[2 * kk][vt][1]); Bs.u[1] = pk2(S[2 * kk][vt][2], S[2 * kk][vt][3]);
                    Bs.u[2] = pk2(S[2 * kk + 1][vt][0], S[2 * kk + 1][vt][1]); Bs.u[3] = pk2(S[2 * kk + 1][vt][2], S[2 * kk + 1][vt][3]);
                    o = MFMA16(Aq[kk].v, Bs.v, o); }
                ov[vt] = o;
#pragma unroll
                for (int j = 0; j < 4; ++j) ssq[j] += o[j] * o[j];
            }
#pragma unroll
            for (int j = 0; j < 4; ++j) { float s = ssq[j]; s += __shfl_xor(s, 1); s += __shfl_xor(s, 2); s += __shfl_xor(s, 4); s += __shfl_xor(s, 8); ssq[j] = __builtin_amdgcn_rsqf(s * (1.0f / 64.0f) + EPS); }
#pragma unroll
            for (int vt = 0; vt < 4; ++vt) { const float nw = gp(a, I_HNORM)[layer * DA + h * 64 + 16 * vt + fr];
#pragma unroll
                for (int j = 0; j < 4; ++j) { const int t = 4 * fq + j; const float g = bf2f(GT[t * HG_S + 16 * vt + fr]);
                    QG[t * HG_S + 16 * vt + fr] = f2bf(ov[vt][j] * ssq[j] * nw * g * sigm(g)); } }
            WAVE_SYNC();
            { const v4u o0 = *(const LAS v4u*)(QG + fr * HG_S + 8 * fq), o1 = *(const LAS v4u*)(QG + fr * HG_S + 32 + 8 * fq);
              bf16* dst = (bf16*)(ws + WS_MIX) + ((size_t)cid * 64 + sb * 16 + fr) * DM + h * 64 + 8 * fq; *(v4u*)dst = o0; *(v4u*)(dst + 32) = o1; }
        }
        {
            bf16x8 Bv[4];
#pragma unroll
            for (int vt = 0; vt < 4; ++vt) Bv[vt] = (fq < 2) ? *(const LAS bf16x8*)(VT + (16 * vt + fr) * 16 + fq * 8) : zero8;
#pragma unroll
            for (int dt = 0; dt < 4; ++dt) { const f32x4 eg = *(const LAS f32x4*)(EGL + 16 * dt + 4 * fq);
                const bf16x8 A = (fq < 2) ? *(const LAS bf16x8*)(KET + (16 * dt + fr) * 16 + fq * 8) : zero8;
#pragma unroll
                for (int vt = 0; vt < 4; ++vt) S[dt][vt] = MFMA16(A, Bv[vt], S[dt][vt] * eg); }
        }
        WAVE_SYNC();
    }
    {
        float* dst = nullptr;
        if (OUT) { if (cid >= NPCH) dst = gout(a) + O_HS + (((size_t)layer * 32 + (cid - NPCH)) * 6 + h) * 4096;
                   else if ((cid & 63) == 63) dst = gout(a) + O_HP + (((size_t)layer * 4 + (cid >> 6)) * 6 + h) * 4096; }
        else { dst = HST + ((size_t)cid * 6 + h) * 4096;
            if (fr == 0) { float* hd = (float*)(ws + WS_HD) + ((size_t)cid * 6 + h) * 64 + 16 * fq;
#pragma unroll
                for (int q = 0; q < 4; ++q) *(f32x4*)(hd + 4 * q) = (f32x4){__expf(gtot[(OUT ? 0 : 4 * q)]), __expf(gtot[(OUT ? 0 : 4 * q + 1)]), __expf(gtot[(OUT ? 0 : 4 * q + 2)]), __expf(gtot[(OUT ? 0 : 4 * q + 3)])}; } }
        if (dst) {
#pragma unroll
            for (int dt = 0; dt < 4; ++dt)
#pragma unroll
                for (int vt = 0; vt < 4; ++vt)
#pragma unroll
                    for (int j = 0; j < 4; ++j) dst[(4 * fq) * 64 + fr + (16 * dt + j) * 64 + 16 * vt] = S[dt][vt][j];
        }
    }
}

constexpr int S5_US = 264, S5_BS = 132, S5_HS = 136;
constexpr int S5_UT = 0, S5_BUT = 8448, S5_HT = 76032, S5_ZT = 110848, S5_ZF = 119296;
template <bool OUT>
__device__ __forceinline__ void s5_phase(const Args& a, int layer, LAS unsigned char* lds, int tid, int lane, int wave, int NU) {
    const int fr = lane & 15, fq = lane >> 4;
    unsigned char* ws = gws(a); const unsigned char* sm = ws + WS_SMALL;
    f32x2v* ST = (f32x2v*)(ws + WS_S5ST);
    LAS bf16* UT = (LAS bf16*)(lds + S5_UT); LAS float* BUT = (LAS float*)(lds + S5_BUT) + wave * (16 * S5_BS); LAS bf16* HT = (LAS bf16*)(lds + S5_HT) + wave * (16 * S5_HS);
    LAS bf16* ZT = (LAS bf16*)(lds + S5_ZT); LAS float* ZF = (LAS float*)(lds + S5_ZF);
    const bf16x8 zero8 = {0, 0, 0, 0, 0, 0, 0, 0};
    bf16x8 BBr[8], CCr[2][4], WGr[2][8]; float are[2], aim[2], dd[2], bgv[2];
    {
        const bf16* BB = (const bf16*)(sm + SM_BB) + ((size_t)(layer * 16 + (fq < 2 ? wave : 8 + wave)) * 128) * 16;
#pragma unroll
        for (int nt = 0; nt < 8; ++nt) BBr[nt] = *(const bf16x8*)(BB + (16 * nt + fr) * 16 + (fq & 1) * 8);
    }
    const int r_ut = tid >> 5, c8 = (tid & 31) * 8;
#pragma unroll
    for (int hf = 0; hf < 2; ++hf) { const int g = hf * 8 + wave;
        const f32x2v av = ((const f32x2v*)(sm + SM_S5A))[(layer * 16 + g) * 64 + lane]; are[hf] = av.x; aim[hf] = av.y;
        if (OUT) { const bf16* CC = (const bf16*)(sm + SM_CC) + (size_t)(layer * 16 + g) * 16 * 128;
#pragma unroll
            for (int kk = 0; kk < 4; ++kk) CCr[hf][kk] = *(const bf16x8*)(CC + fr * 128 + 32 * kk + 8 * fq);
            dd[hf] = gp(a, I_S5D)[layer * DB + g * 16 + fr]; } }
    if (OUT) { const bf16* WG = (const bf16*)(sm + SM_WGT) + (size_t)layer * 65536;
#pragma unroll
        for (int i = 0; i < 2; ++i) { const int nt = 2 * wave + i;
#pragma unroll
            for (int kk = 0; kk < 8; ++kk) WGr[i][kk] = *(const bf16x8*)(WG + (size_t)(16 * nt + fr) * 256 + 32 * kk + 8 * fq);
            bgv[i] = gp(a, I_S5BG)[layer * DB + 16 * nt + fr]; }
        }
#pragma unroll 1
    for (int u = blockIdx.x; u < NU; u += gridDim.x) {
        const int cid = OUT ? u : (u / 63) * 64 + (u % 63);
        const bf16* proj = (const bf16*)(ws + WS_PROJ) + (size_t)cid * 64 * D_IN;
        float hre[2], him[2];
#pragma unroll
        for (int hf = 0; hf < 2; ++hf) { const int g = hf * 8 + wave;
            if (cid >= NPCH) { const size_t o = (((size_t)layer * 32 + (cid - NPCH)) * 16 + g) * 64 + lane; hre[hf] = gp(a, I_SSR)[o]; him[hf] = gp(a, I_SSI)[o]; }
            else if (OUT && (cid & 63) != 0) { const f32x2v hv = ST[((size_t)(cid - 1) * 16 + g) * 64 + lane]; hre[hf] = hv.x; him[hf] = hv.y; }
            else { hre[hf] = 0.f; him[hf] = 0.f; } }
        v4u unext = *(const v4u*)(proj + (size_t)r_ut * D_IN + CU + c8);
#pragma unroll 1
        for (int tt = 0; tt < 4; ++tt) {
            *(LAS v4u*)(UT + r_ut * S5_US + c8) = unext;
            if (tt < 3) unext = *(const v4u*)(proj + (size_t)((tt + 1) * 16 + r_ut) * D_IN + CU + c8);
            BSYNC();
#pragma unroll
            for (int hf = 0; hf < 2; ++hf) {
                const int g = hf * 8 + wave;
                {
                    const bf16x8 A = ((fq < 2) == (hf == 0)) ? *(const LAS bf16x8*)(UT + fr * S5_US + g * 16 + (fq & 1) * 8) : zero8;
                    f32x4 cc[8];
#pragma unroll
                    for (int nt = 0; nt < 8; ++nt) { cc[nt] = (f32x4){0.f, 0.f, 0.f, 0.f}; cc[nt] = MFMA16(A, BBr[nt], cc[nt]); }
                    __builtin_amdgcn_sched_barrier(0); asm volatile("s_nop 7\n\ts_nop 7\n\ts_nop 7" ::: "memory"); __builtin_amdgcn_sched_barrier(0);
#pragma unroll
                    for (int nt = 0; nt < 8; ++nt)
#pragma unroll
                        for (int j = 0; j < 4; ++j) BUT[(4 * fq + j) * S5_BS + 16 * nt + fr] = cc[nt][j];
                }
                BSYNC();
                {
                    float hr = hre[hf], hi = him[hf]; const float ar = are[hf], ai = aim[hf];
#pragma unroll
                    for (int th = 0; th < 4; ++th) { f32x2v bv[4];
#pragma unroll
                        for (int t = 0; t < 4; ++t) bv[t] = *(const LAS f32x2v*)(BUT + (4 * th + t) * S5_BS + 2 * lane);
#pragma unroll
                        for (int t = 0; t < 4; ++t) { const float nr = ar * hr - ai * hi + bv[t].x, ni = ar * hi + ai * hr + bv[t].y; hr = nr; hi = ni;
                            if (OUT) *(LAS unsigned*)(HT + (4 * th + t) * S5_HS + 2 * lane) = pk2(hr, hi); } }
                    hre[hf] = hr; him[hf] = hi;
                }
                BSYNC();
                if (OUT) {
                    f32x4 y = {0.f, 0.f, 0.f, 0.f};
#pragma unroll
                    for (int kk = 0; kk < 4; ++kk) { const bf16x8 A = *(const LAS bf16x8*)(HT + fr * S5_HS + 32 * kk + 8 * fq); y = MFMA16(A, CCr[hf][kk], y); }
                    const int ch = g * 16 + fr;
#pragma unroll
                    for (int j = 0; j < 4; ++j) { const int tok = 4 * fq + j; const float uu = bf2f(UT[tok * S5_US + ch]); const float z = gelu_tanh(y[j] + dd[hf] * uu);
                        ZT[tok * S5_US + ch] = f2bf(z); ZF[tok * 256 + ch] = z; }
                }
            }
            if (OUT) {
                BSYNC();
#pragma unroll
                for (int i = 0; i < 2; ++i) { const int nt = 2 * wave + i; f32x4 p = {0.f, 0.f, 0.f, 0.f};
#pragma unroll
                    for (int kk = 0; kk < 8; ++kk) { const bf16x8 A = *(const LAS bf16x8*)(ZT + fr * S5_US + 32 * kk + 8 * fq); p = MFMA16(A, WGr[i][kk], p); }
                    const int n = 16 * nt + fr;
#pragma unroll
                    for (int j = 0; j < 4; ++j) { const int tok = 4 * fq + j; ZF[tok * 256 + n] = ZF[tok * 256 + n] * sigm(p[j] + bgv[i]); } }
                BSYNC();
                { const f32x4 v0 = *(const LAS f32x4*)(ZF + r_ut * 256 + c8), v1 = *(const LAS f32x4*)(ZF + r_ut * 256 + c8 + 4);
                  float s = (v0.x * v0.x + v0.y * v0.y) + (v0.z * v0.z + v0.w * v0.w) + (v1.x * v1.x + v1.y * v1.y) + (v1.z * v1.z + v1.w * v1.w);
                  s += __shfl_xor(s, 1); s += __shfl_xor(s, 2); s += __shfl_xor(s, 4); s += __shfl_xor(s, 8); s += __shfl_xor(s, 16);
                  const float rs = __builtin_amdgcn_rsqf(s * (1.0f / 256.0f) + EPS); const f32x4 nw0 = *(const f32x4*)(gp(a, I_S5N) + layer * DB + c8), nw1 = *(const f32x4*)(gp(a, I_S5N) + layer * DB + c8 + 4);
                  v4u o; o.x = pk2(v0.x * rs * nw0.x, v0.y * rs * nw0.y); o.y = pk2(v0.z * rs * nw0.z, v0.w * rs * nw0.w); o.z = pk2(v1.x * rs * nw1.x, v1.y * rs * nw1.y); o.w = pk2(v1.z * rs * nw1.z, v1.w * rs * nw1.w);
                  *(v4u*)((bf16*)(ws + WS_MIX) + ((size_t)cid * 64 + tt * 16 + r_ut) * DM + DA + c8) = o; }
            }
            BSYNC();
        }
#pragma unroll
        for (int hf = 0; hf < 2; ++hf) { const int g = hf * 8 + wave;
            if (OUT) { if (cid >= NPCH) { const size_t o = (((size_t)layer * 32 + (cid - NPCH)) * 16 + g) * 64 + lane; gout(a)[O_SRS + o] = hre[hf]; gout(a)[O_SIS + o] = him[hf]; }
                       else if ((cid & 63) == 63) { const size_t o = (((size_t)layer * 4 + (cid >> 6)) * 16 + g) * 64 + lane; gout(a)[O_SRP + o] = hre[hf]; gout(a)[O_SIP + o] = him[hf]; } }
            else ST[((size_t)cid * 16 + g) * 64 + lane] = (f32x2v){hre[hf], him[hf]}; }
    }
    __syncthreads();
}

constexpr int LR_XS = 392, LR_AS = 388;
constexpr int LR_XC = 0, LR_AL = 25088, LR_BL = 74752;
template <bool OUT>
__device__ __forceinline__ void lru_phase(const Args& a, int layer, LAS unsigned char* lds, int tid, int lane, int wave, int NU) {
    const int fr = lane & 15, fq = lane >> 4;
    unsigned char* ws = gws(a); const unsigned char* sm = ws + WS_SMALL;
    f32x2v* ST = (f32x2v*)(ws + WS_LRUST);
    LAS bf16* XC = (LAS bf16*)(lds + LR_XC); LAS float* AL = (LAS float*)(lds + LR_AL); LAS float* BL = (LAS float*)(lds + LR_BL);
    const bool act = tid < DC; const int c = act ? tid : 0;
    const float cw0 = gp(a, I_LCW)[(layer * 4 + 0) * DC + c], cw1 = gp(a, I_LCW)[(layer * 4 + 1) * DC + c], cw2 = gp(a, I_LCW)[(layer * 4 + 2) * DC + c], cw3 = gp(a, I_LCW)[(layer * 4 + 3) * DC + c];
    const float cb = gp(a, I_LCB)[layer * DC + c];
    bf16x8 BA0[3], BA1[3], BX0[3], BX1[3]; float bav[3], bxv[3], spv[3];
#pragma unroll
    for (int i = 0; i < 3; ++i) { const int ntg = 3 * wave + i, hd = ntg >> 2, jn = (ntg & 3) * 16; const int ch = 16 * ntg + fr;
        const bf16* WA = (const bf16*)(sm + SM_WAT) + ((size_t)(layer * 6 + hd) * 64 + jn + fr) * 64; const bf16* WX = (const bf16*)(sm + SM_WXT) + ((size_t)(layer * 6 + hd) * 64 + jn + fr) * 64;
        BA0[i] = *(const bf16x8*)(WA + 8 * fq); BA1[i] = *(const bf16x8*)(WA + 32 + 8 * fq); BX0[i] = *(const bf16x8*)(WX + 8 * fq); BX1[i] = *(const bf16x8*)(WX + 32 + 8 * fq);
        bav[i] = gp(a, I_LBA)[layer * DC + ch]; bxv[i] = gp(a, I_LBX)[layer * DC + ch]; spv[i] = ((const float*)(sm + SM_SP))[layer * DC + ch]; }
    const int ntok = tid >> 4, c0 = (tid & 15) * 24;
#pragma unroll 1
    for (int k = 0; k * (int)gridDim.x < NU; ++k) {
        const int G_ = (int)gridDim.x, u = k * G_ + (((int)blockIdx.x + G_ - (8 * k) % G_) % G_); if (u >= NU) continue;
        const int cid = OUT ? u : (u / 63) * 64 + (u % 63);
        const bf16* proj = (const bf16*)(ws + WS_PROJ) + (size_t)cid * 64 * D_IN;
        float xm3 = 0.f, xm2 = 0.f, xm1 = 0.f, h = 0.f, P = 1.f;
        if (cid >= NPCH) { const size_t sb = (size_t)layer * 32 + (cid - NPCH); xm3 = gp(a, I_SC)[(sb * 3 + 0) * DC + c]; xm2 = gp(a, I_SC)[(sb * 3 + 1) * DC + c]; xm1 = gp(a, I_SC)[(sb * 3 + 2) * DC + c]; h = gp(a, I_SL)[sb * DC + c]; }
        else if ((cid & 63) != 0) { xm3 = bf2f(proj[-3 * D_IN + CXR + c]); xm2 = bf2f(proj[-2 * D_IN + CXR + c]); xm1 = bf2f(proj[-1 * D_IN + CXR + c]); if (OUT) h = ST[(size_t)(cid - 1) * DC + c].y; }
#pragma unroll 1
        for (int tile = 0; tile < 2; ++tile) {
            const bf16* pr = proj + (size_t)tile * 32 * D_IN;
            bf16 gr[32];
            {   bf16 xr[32];
#pragma unroll
                for (int t = 0; t < 32; ++t) xr[t] = pr[(size_t)t * D_IN + CXR + c];
                if (OUT) {
#pragma unroll
                    for (int t = 0; t < 32; ++t) gr[t] = pr[(size_t)t * D_IN + CGR + c]; }
                if (act) {
#pragma unroll
                    for (int t = 0; t < 32; ++t) { const float x = bf2f(xr[t]); const float xc = cb + cw0 * xm3 + cw1 * xm2 + cw2 * xm1 + cw3 * x; XC[t * LR_XS + c] = f2bf(xc); xm3 = xm2; xm2 = xm1; xm1 = x; } }
            }
            BSYNC();
#pragma unroll
            for (int i = 0; i < 3; ++i) { const int ntg = 3 * wave + i, hd = ntg >> 2; const int ch = 16 * ntg + fr;
#pragma unroll
                for (int mt = 0; mt < 2; ++mt) { const bf16x8 A0 = *(const LAS bf16x8*)(XC + (16 * mt + fr) * LR_XS + hd * 64 + 8 * fq), A1 = *(const LAS bf16x8*)(XC + (16 * mt + fr) * LR_XS + hd * 64 + 32 + 8 * fq);
                    f32x4 r = {0.f, 0.f, 0.f, 0.f}, ii = {0.f, 0.f, 0.f, 0.f};
                    r = MFMA16(A0, BA0[i], r); r = MFMA16(A1, BA1[i], r); ii = MFMA16(A0, BX0[i], ii); ii = MFMA16(A1, BX1[i], ii);
#pragma unroll
                    for (int j = 0; j < 4; ++j) { const int tok = 16 * mt + 4 * fq + j; const float rg = sigm(r[j] + bav[i]), ig = sigm(ii[j] + bxv[i]); const float la = spv[i] * rg; const float av = __expf(la);
                        const float xcv = bf2f(XC[tok * LR_XS + ch]); AL[tok * LR_AS + ch] = av; BL[tok * LR_AS + ch] = __builtin_amdgcn_sqrtf(fmaxf(1.0f - av * av, 0.f)) * ig * xcv; } } }
            BSYNC();
            if (act) {
#pragma unroll
                for (int t = 0; t < 32; ++t) { const float av = AL[t * LR_AS + c]; h = av * h + BL[t * LR_AS + c]; P *= av;
                    if (OUT) BL[t * LR_AS + c] = h * gelu_tanh(bf2f(gr[t])); }
            }
            if (OUT) {
                BSYNC();
                float v[24]; float s = 0.f; const int sub = tid & 15;
#pragma unroll
                for (int q = 0; q < 3; ++q) { const f32x4 x0 = *(const LAS f32x4*)(BL + ntok * LR_AS + 128 * q + 8 * sub), x1 = *(const LAS f32x4*)(BL + ntok * LR_AS + 128 * q + 8 * sub + 4);
                    v[8 * q] = x0.x; v[8 * q + 1] = x0.y; v[8 * q + 2] = x0.z; v[8 * q + 3] = x0.w; v[8 * q + 4] = x1.x; v[8 * q + 5] = x1.y; v[8 * q + 6] = x1.z; v[8 * q + 7] = x1.w;
                    s += ((x0.x * x0.x + x0.y * x0.y) + (x0.z * x0.z + x0.w * x0.w)) + ((x1.x * x1.x + x1.y * x1.y) + (x1.z * x1.z + x1.w * x1.w)); }
                s += __shfl_xor(s, 1); s += __shfl_xor(s, 2); s += __shfl_xor(s, 4); s += __shfl_xor(s, 8);
                const float rs = __builtin_amdgcn_rsqf(s * (1.0f / 384.0f) + EPS);
                bf16* dst = (bf16*)(ws + WS_MIX) + ((size_t)cid * 64 + tile * 32 + ntok) * DM + DA + DB + 8 * sub;
#pragma unroll
                for (int q = 0; q < 3; ++q) { const float* nw = gp(a, I_LNORM) + layer * DC + 128 * q + 8 * sub; const f32x4 n0 = *(const f32x4*)nw, n1 = *(const f32x4*)(nw + 4);
                    v4u o; o.x = pk2(v[8 * q] * rs * n0.x, v[8 * q + 1] * rs * n0.y); o.y = pk2(v[8 * q + 2] * rs * n0.z, v[8 * q + 3] * rs * n0.w);
                    o.z = pk2(v[8 * q + 4] * rs * n1.x, v[8 * q + 5] * rs * n1.y); o.w = pk2(v[8 * q + 6] * rs * n1.z, v[8 * q + 7] * rs * n1.w); *(v4u*)(dst + 128 * q) = o; }
            }
        }
        if (act) {
            if (OUT) {
                float* ho = nullptr; float* co = nullptr;
                if (cid >= NPCH) { const size_t sb = (size_t)layer * 32 + (cid - NPCH); ho = gout(a) + O_LS + sb * DC; co = gout(a) + O_CS + sb * 3 * DC; }
                else if ((cid & 63) == 63) { const size_t sb = (size_t)layer * 4 + (cid >> 6); ho = gout(a) + O_LP + sb * DC; co = gout(a) + O_CP + sb * 3 * DC; }
                if (ho) { ho[c] = h; co[c] = xm3; co[DC + c] = xm2; co[2 * DC + c] = xm1; }
            } else ST[(size_t)cid * DC + c] = (f32x2v){P, h};
        }
        __syncthreads();
    }
}

__device__ __forceinline__ void carry_phase(const Args& a, int layer, int tid) {
    unsigned char* ws = gws(a);
    const int gt = blockIdx.x * NTHREADS + tid, NGT = gridDim.x * NTHREADS;
    for (int i = gt; i < 4 * 6 * 4096; i += NGT) {
        const int b = i / 24576, rem = i % 24576, hh = rem >> 12, e = rem & 4095, d = e >> 6;
        float* HST = (float*)(ws + WS_HST) + ((size_t)(b * 64) * 6 + hh) * 4096 + e; const float* HD = (const float*)(ws + WS_HD) + ((size_t)(b * 64) * 6 + hh) * 64 + d;
        float S = 0.f;
#pragma unroll 21
        for (int cc = 0; cc < 63; ++cc) { S = HD[(size_t)cc * 6 * 64] * S + HST[(size_t)cc * 6 * 4096]; HST[(size_t)cc * 6 * 4096] = S; }
    }
    const int off5 = (NGT >= 4 * 6 * 4096 + 4 * 1024 + 4 * DC) ? 4 * 6 * 4096 : 0, offl = off5 ? off5 + 4 * 1024 : 0;
    for (int i = gt - off5; i < 4 * 1024; i += NGT) { if (i < 0) continue;
        const int b = i >> 10, gp = i & 1023; const f32x2v A = ((const f32x2v*)(ws + WS_SMALL + SM_S5A64))[layer * 1024 + gp];
        f32x2v* ST = (f32x2v*)(ws + WS_S5ST) + (size_t)(b * 64) * 1024 + gp; float hr = 0.f, hi = 0.f;
#pragma unroll 21
        for (int cc = 0; cc < 63; ++cc) { const f32x2v l = ST[(size_t)cc * 1024]; const float nr = A.x * hr - A.y * hi + l.x, ni = A.x * hi + A.y * hr + l.y; hr = nr; hi = ni; ST[(size_t)cc * 1024] = (f32x2v){hr, hi}; }
    }
    for (int i = gt - offl; i < 4 * DC; i += NGT) { if (i < 0) continue;
        const int b = i / DC, c = i % DC; f32x2v* ST = (f32x2v*)(ws + WS_LRUST) + (size_t)(b * 64) * DC + c; float h = 0.f;
#pragma unroll 21
        for (int cc = 0; cc < 63; ++cc) { const f32x2v l = ST[(size_t)cc * DC]; h = l.x * h + l.y; ST[(size_t)cc * DC] = (f32x2v){l.x, h}; }
    }
}

#ifndef MIXSLOW
#define MIXSLOW 0
#endif
#define MSLOW(bit) do { if (MIXSLOW) { asm volatile("s_waitcnt vmcnt(0) lgkmcnt(0)" ::: "memory"); __syncthreads(); const unsigned long long t1_ = __builtin_amdgcn_s_memrealtime(); if (MIXSLOW & (bit)) { const unsigned long long d_ = t1_ - t_m; while (__builtin_amdgcn_s_memrealtime() - t1_ < d_) __builtin_amdgcn_s_sleep(8); } t_m = __builtin_amdgcn_s_memrealtime(); } } while (0)
template <bool OUT>
__device__ __forceinline__ void mixer_phase(int layer, LAS unsigned char* lds, int tid0) {
#ifndef MIXSEL
#define MIXSEL 7
#endif
    unsigned long long t_m = MIXSLOW ? __builtin_amdgcn_s_memrealtime() : 0ull;
    if (MIXSEL & 1) {
        int tid = tid0; LAUNDER_V(tid); const int lane = tid & 63, wave = __builtin_amdgcn_readfirstlane(tid >> 6);
        const int gw = blockIdx.x * NWAVES + wave, NGW = gridDim.x * NWAVES;
        LAS unsigned char* wl = lds + wave * HG_WAVE_BYTES;
        const Args& a = kargs();
        if (OUT) {
            const int hb = ((int)gridDim.x * NWAVES > NCHUNK * 6) ? ((int)gridDim.x * NWAVES - NCHUNK * 6) / NWAVES : 0;
            if ((int)blockIdx.x >= hb) for (int u = ((int)blockIdx.x - hb) * NWAVES + wave; u < NCHUNK * 6; u += ((int)gridDim.x - hb) * NWAVES) hgrn_unit<true>(a, layer, u / 6, u % 6, wl, lane); }
        else     { for (int u = gw; u < 4 * 63 * 6; u += NGW) { const int b = u / 378, rem = u % 378; hgrn_unit<false>(a, layer, b * 64 + rem / 6, rem % 6, wl, lane); } }
    }
    __syncthreads();
    MSLOW(1);
    const int NU = OUT ? NCHUNK : 4 * 63;
    if (MIXSEL & 2) {
        int tid = tid0; LAUNDER_V(tid); const int lane = tid & 63, wave = __builtin_amdgcn_readfirstlane(tid >> 6);
        s5_phase<OUT>(kargs(), layer, lds, tid, lane, wave, NU);
    }
    MSLOW(2);
    if (MIXSEL & 4) {
        int tid = tid0; LAUNDER_V(tid); const int lane = tid & 63, wave = __builtin_amdgcn_readfirstlane(tid >> 6);
        lru_phase<OUT>(kargs(), layer, lds, tid, lane, wave, NU);
    }
    MSLOW(4);
}

__device__ __forceinline__ void final_norm(const Args& a, int lane, int wave) {
    const int gw = blockIdx.x * NWAVES + wave, NGW = gridDim.x * NWAVES;
    const float* SS = (const float*)(gws(a) + WS_SSP) + (size_t)4 * M_TOK * 16; const f32x4* nw = (const f32x4*)gp(a, I_NFIN) + lane;
    const bf16* XB = (const bf16*)(gws(a) + WS_XB);
    f32x4 w[4];
#pragma unroll
    for (int j = 0; j < 4; ++j) w[j] = nw[64 * j];
    for (int m = gw; m < M_TOK; m += NGW) { const float rs = pg8::row_rstd(SS, (size_t)m); f32x4* xr = (f32x4*)(gout(a) + (size_t)m * DM) + lane; const v2u* xb = (const v2u*)(XB + (size_t)m * DM) + lane;
#pragma unroll
        for (int j = 0; j < 4; ++j) { const v2u b = xb[64 * j]; f32x4 v; v[0] = __uint_as_float(b.x << 16); v[1] = __uint_as_float(b.x & 0xffff0000u); v[2] = __uint_as_float(b.y << 16); v[3] = __uint_as_float(b.y & 0xffff0000u);
            v = v * rs * w[j]; xr[64 * j] = v; } }
}

#ifndef PHSEL
#define PHSEL 0xFF
#endif
#ifndef MK_MULTI
#define MK_MULTI 0
#endif
struct KArgs { Args a; int ph_lo, ph_hi; };
__global__ void __launch_bounds__(NTHREADS, 2) fwd_megakernel(KArgs ka) {
    extern __shared__ __attribute__((aligned(16))) unsigned char lds_raw[];
    LAS unsigned char* lds = (LAS unsigned char*)lds_raw;
    const int tid = threadIdx.x, lane = tid & 63, wave = __builtin_amdgcn_readfirstlane(tid >> 6);
    unsigned char* ws = ka.a.ws; float* const out = ka.a.out; unsigned char* const ws_early = ws;
    const Args& a = ka.a;
    float* SS = (float*)(ws + WS_SSP);
    bf16* XB = (bf16*)(ws + WS_XB); bf16* PROJ = (bf16*)(ws + WS_PROJ); bf16* MIX = (bf16*)(ws + WS_MIX); bf16* HID = (bf16*)(ws + WS_HID);
    int ph = 0;
#if MK_MULTI
#define SEAM() do { ++ph; } while (0)
#define RUN(b) (((PHSEL) >> (b)) & 1) && (ph >= ka.ph_lo && ph < ka.ph_hi)
#else
    cg::grid_group grid = cg::this_grid();
    volatile LAS unsigned* xb_st = (volatile LAS unsigned*)(lds + XB_LDS_OFF);
    if (threadIdx.x < 2) xb_st[threadIdx.x] = 0u;
    __syncthreads();
    const XcdBarrier xbar = xcd_barrier_post((unsigned*)(ws_early + WS_CTL + 16384), xb_st);
#define SEAM() do { if (ka.ph_hi < 0) grid.sync(); xcd_barrier(xbar); ++ph; } while (0)
#define RUN(b) ((((PHSEL) >> (b)) & 1) != 0)
#endif
#ifndef STOP_AFTER
#define STOP_AFTER 999
#endif
#ifndef DUMP_OFF
#define DUMP_OFF WS_MIX
#endif
#ifndef DUMP_F32
#define DUMP_F32 0
#endif
#define PROBE() do { if (ph == STOP_AFTER) { if (DUMP_F32 == 2) { const bf16* src = (const bf16*)(ws + WS_PROJ); for (size_t i = (size_t)blockIdx.x * NTHREADS + tid; i < (size_t)M_TOK * 256; i += (size_t)gridDim.x * NTHREADS) out[i] = bf2f(src[(i >> 8) * D_IN + CU + (i & 255)]); } else if (DUMP_F32) { const float* src = (const float*)(ws + DUMP_OFF); for (size_t i = (size_t)blockIdx.x * NTHREADS + tid; i < (size_t)7602176; i += (size_t)gridDim.x * NTHREADS) out[i] = src[i]; } \
    else { const bf16* src = (const bf16*)(ws + DUMP_OFF); for (size_t i = (size_t)blockIdx.x * NTHREADS + tid; i < (size_t)M_TOK * DM; i += (size_t)gridDim.x * NTHREADS) out[i] = bf2f(src[i]); } return; } } while (0)
#define IDLE_CONVERT(nwg_, lay_, part_) do { const int rem_ = (nwg_) % (int)gridDim.x; if ((int)blockIdx.x >= rem_) {     int t2 = tid; LAUNDER_V(t2); const int w2 = __builtin_amdgcn_readfirstlane(t2 >> 6); \
        convert_weights(kargs(), (lay_), lds, t2 & 63, w2, ((int)blockIdx.x - rem_) * NWAVES + w2, ((int)gridDim.x - rem_) * NWAVES, (part_)); } } while (0)
#ifndef SLOWMASK
#define SLOWMASK 0
#endif
    unsigned long long t_ph = SLOWMASK ? __builtin_amdgcn_s_memrealtime() : 0ull;
#define SLOW(bit) do { if (SLOWMASK) { const unsigned long long t1_ = __builtin_amdgcn_s_memrealtime(); if (SLOWMASK & (bit)) { const unsigned long long d_ = t1_ - t_ph; while (__builtin_amdgcn_s_memrealtime() - t1_ < d_) __builtin_amdgcn_s_sleep(8); } t_ph = __builtin_amdgcn_s_memrealtime(); } } while (0)
    if (RUN(0)) { int t3 = tid; LAUNDER_V(t3); p0_prologue(kargs(), lds, t3, t3 & 63, __builtin_amdgcn_readfirstlane(t3 >> 6)); if (blockIdx.x == 0 && tid < 38) ((unsigned long long*)(ws + WS_TAB))[tid] = (tid < 36) ? (unsigned long long)ka.a.in[tid] : (tid == 36 ? (unsigned long long)ka.a.out : (unsigned long long)ka.a.ws); }
    SEAM(); PROBE(); SLOW(1);
#pragma unroll 1
    for (int l = 0; l < 2; ++l) {
        if (RUN(1)) { pg8::Gemm g{XB, (const bf16*)(ws + WS_WIN) + (size_t)l * D_IN * DM, M_TOK, D_IN, DM}; pg8::StaticOrder S; S.init(M_TOK, D_IN, gridDim.x, blockIdx.x);
            pg8::EpiProj E{PROJ, D_IN, SS + (size_t)(2 * l) * M_TOK * 16};
            pg8::gemm_phase<pg8::EpiProj, pg8::StaticOrder, true, true>(lds, g, S, E);
            IDLE_CONVERT(72 * 10, l, 1); }
        SEAM(); PROBE(); SLOW(2);
        if (RUN(2)) mixer_phase<false>(l, lds, tid);
        SEAM(); PROBE(); SLOW(4);
        if (RUN(3)) { int t3 = tid; LAUNDER_V(t3); carry_phase(kargs(), l, t3); }
        SEAM(); PROBE(); SLOW(4);
        if (RUN(4)) mixer_phase<true>(l, lds, tid);
        SEAM(); PROBE(); SLOW(4);
        if (RUN(5)) { pg8::Gemm g{MIX, (const bf16*)(ws + WS_WOUT) + (size_t)l * DM * DM, M_TOK, DM, DM}; pg8::StaticOrder S; S.init(M_TOK, DM, gridDim.x, blockIdx.x);
            pg8::EpiRes E{XB, SS + (size_t)(2 * l + 1) * M_TOK * 16};
            pg8::gemm_phase<pg8::EpiRes, pg8::StaticOrder, true, true>(lds, g, S, E);
            IDLE_CONVERT(72 * 4, l, 2); IDLE_CONVERT(72 * 4, l, 3); if (l == 0) IDLE_CONVERT(72 * 4, 1, 0); }
        SEAM(); PROBE(); SLOW(8);
        {
            const int G_ = (int)gridDim.x, total = 72 * 22, full = (total / G_) * G_, c0 = total - full;
#define Wgu ((const bf16*)(ws + WS_WGU) + (size_t)l * 2 * D_FF * DM)
#define Wdn ((const bf16*)(ws + WS_WDN) + (size_t)l * DM * D_FF)
            const int nlow = (G_ == 256) ? 32 : 0, t_lo = G_ + 3 * nlow;
#pragma unroll 1
            for (int step = 0; step < 2; ++step) {
                if (step == 1 && RUN(6)) { pg8::Gemm g{HID, Wdn, M_TOK, DM, D_FF}; pg8::SampleOrder S; S.c0 = 0; S.c = (nlow ? (int)blockIdx.x : -1);
                    pg8::EpiRes E{XB, SS + (size_t)(2 * l + 2) * M_TOK * 16};
                    pg8::gemm_phase<pg8::EpiRes, pg8::SampleOrder, true, true>(lds, g, S, E); }
                if (RUN(6)) { pg8::Gemm g{XB, Wgu, M_TOK, 2 * D_FF, DM}; pg8::GuOrder S; S.init(M_PROMPT, 2 * D_FF, G_, blockIdx.x); S.npre = 8 * 22;
                    if (step == 0) { S.lo = 0; S.hi = G_; }
                    else if ((int)blockIdx.x < nlow) { S.G = nlow; S.lo = G_; S.hi = t_lo; }
                    else { S.G = G_ - nlow; S.c = (int)blockIdx.x - nlow; S.lo = t_lo; S.hi = total; }
                    pg8::EpiGateUp E{HID, D_FF, SS + (size_t)(2 * l + 1) * M_TOK * 16};
                    pg8::gemm_phase<pg8::EpiGateUp, pg8::GuOrder, true, true>(lds, g, S, E); }
                if (step == 0) xcd_barrier(xbar);
            }
            if (!nlow && RUN(6)) {
                xcd_barrier(xbar);
                pg8::Gemm g{HID, Wdn, M_TOK, DM, D_FF}; pg8::SampleOrder S; S.c0 = 0; S.c = blockIdx.x;
                pg8::EpiRes E{XB, SS + (size_t)(2 * l + 2) * M_TOK * 16};
                pg8::gemm_phase<pg8::EpiRes, pg8::SampleOrder, true, true>(lds, g, S, E); }
            SEAM(); PROBE(); SLOW(16);
            if (RUN(7)) { pg8::Gemm g{HID, Wdn, M_PROMPT, DM, D_FF}; pg8::StaticOrder S; S.init(M_PROMPT, DM, G_, blockIdx.x);
                pg8::EpiRes E{XB, SS + (size_t)(2 * l + 2) * M_TOK * 16};
                pg8::gemm_phase<pg8::EpiRes, pg8::StaticOrder, true, true>(lds, g, S, E); }
        }
        SEAM(); PROBE(); SLOW(32);
    }
    if (RUN(3)) { int t3 = tid; LAUNDER_V(t3); final_norm(kargs(), t3 & 63, __builtin_amdgcn_readfirstlane(t3 >> 6)); }
}
constexpr int N_PHASES = 1 + 2 * 7 + 1;

extern "C" void kernel_launch(void* const* d_in, const int* in_sizes, int n_in, void* d_out, int out_size, void* d_ws, size_t ws_size, hipStream_t stream) {
    static int grid = 0;
    if (grid == 0) {
        if (n_in != 36 || in_sizes[0] != M_PROMPT * DM || (size_t)out_size != O_END || ws_size < WS_END) {
            fprintf(stderr, "kernel_launch: unexpected shapes: n_in %d in0 %d out %d ws %zu\n", n_in, n_in > 0 ? in_sizes[0] : -1, out_size, ws_size); }
        int dev = 0, cus = 0, per_cu = 0;
        hipGetDevice(&dev); hipDeviceGetAttribute(&cus, hipDeviceAttributeMultiprocessorCount, dev);
        if (hipFuncSetAttribute((const void*)fwd_megakernel, hipFuncAttributeMaxDynamicSharedMemorySize, LDS_BYTES) != hipSuccess) { fprintf(stderr, "kernel_launch: hipFuncSetAttribute failed\n"); grid = -1; return; }
        if (hipOccupancyMaxActiveBlocksPerMultiprocessor(&per_cu, (const void*)fwd_megakernel, NTHREADS, LDS_BYTES) != hipSuccess || per_cu < 1) { fprintf(stderr, "kernel_launch: occupancy query failed (%d)\n", per_cu); (void)hipGetLastError(); per_cu = 1; }
        grid = cus * (per_cu > 1 ? 1 : per_cu);
        fprintf(stderr, "kernel_launch: grid %d (cus %d, per_cu %d)\n", grid, cus, per_cu);
    }
    if (grid < 0) return;
    (void)hipMemsetAsync((char*)d_ws + WS_CTL, 0, 65536, stream);
    KArgs ka{};
    for (int i = 0; i < 36; ++i) ka.a.in[i] = (const float*)d_in[i];
    ka.a.out = (float*)d_out; ka.a.ws = (unsigned char*)d_ws;
#if MK_MULTI
    for (int p = 0; p < N_PHASES; ++p) { ka.ph_lo = p; ka.ph_hi = p + 1; hipLaunchKernelGGL(fwd_megakernel, dim3(grid), dim3(NTHREADS), LDS_BYTES, stream, ka); }
#else
    ka.ph_lo = 0; ka.ph_hi = N_PHASES;
    void* args[] = {&ka};
    hipError_t e = hipLaunchCooperativeKernel((const void*)fwd_megakernel, dim3(grid), dim3(NTHREADS), args, LDS_BYTES, stream);
    if (e != hipSuccess) fprintf(stderr, "cooperative launch failed: %s (grid %d)\n", hipGetErrorString(e), grid);
#endif
}
```

```cpp
#include <hip/hip_runtime.h>
#include <hip/hip_cooperative_groups.h>
#include <cstdio>
#include <cstdint>
namespace pg8 {
#define PG8_LAS __attribute__((address_space(3)))
typedef unsigned short bf16_t;
typedef short bf16x8 __attribute__((ext_vector_type(8)));
typedef float f32x4 __attribute__((ext_vector_type(4)));
typedef unsigned u32x4 __attribute__((ext_vector_type(4)));
constexpr int BM = 256, BK = 64, HALF = 128, HTB = HALF * BK * 2  , STAGE_BYTES = 8 * HTB, NXCD = 8, WGM = 8;

__host__ __device__ __forceinline__ int lds_byte(int r, int c) { const int st = (r >> 4) * 2 + (c >> 5), rr = r & 15, cc = c & 31, ob = rr * 64 + cc * 2; return st * 1024 + (ob ^ (((ob >> 9) & 1) << 5)); }
__host__ __device__ __forceinline__ void stage_rc(int b, int& R, int& C) { const int st = b / 1024, sb = b % 1024, swz = sb ^ (((sb >> 9) & 1) << 5); R = (st >> 1) * 16 + swz / 64; C = (st & 1) * 32 + (swz % 64) / 2; }
__host__ __device__ __forceinline__ int perm32(int rho) { const int n = rho >> 4, i = rho & 15; return 8 * (i >> 2) + 4 * n + (i & 3); }

struct Unit { int pm, pn; };
struct Gemm { const bf16_t* A; const bf16_t* Bt; int M, N, K; };

struct StaticOrder {
    int nM, nN, nwg, G, c;
    __host__ __device__ void init(int M, int N, int G_, int c_) { nM = M / BM; nN = N / BM; nwg = nM * nN; G = G_; c = c_; }
    __host__ __device__ bool next(int i, Unit& u) const {
        const long L = (long)i * G + c; if (L >= nwg) return false;
        int wgid = (int)L; { const int q = nwg / NXCD, r = nwg % NXCD, xcd = wgid % NXCD, off = wgid / NXCD; wgid = (xcd < r ? xcd * (q + 1) : r * (q + 1) + (xcd - r) * q) + off; }
        const int nig = WGM * nN, gid = wgid / nig, fm = gid * WGM, gsz = (nM - fm) < WGM ? (nM - fm) : WGM;
        u.pm = fm + ((wgid % nig) % gsz); u.pn = (wgid % nig) / gsz; return true;
    }
    __device__ __forceinline__ void a_ready(const Unit&) const {}
    __device__ __forceinline__ void done(const Unit&) const {}
};

__device__ __forceinline__ unsigned cvt_pk_bf16(float lo, float hi) { unsigned r; asm volatile("v_cvt_pk_bf16_f32 %0, %1, %2" : "=v"(r) : "v"(lo), "v"(hi)); return r; }
typedef float f32x2 __attribute__((ext_vector_type(2)));
constexpr float RMS_EPS = 1e-6f;
__device__ __forceinline__ float row_rstd(const float* ssp, size_t row) {
    const f32x4* p = (const f32x4*)(ssp + row * 16); const f32x4 a = p[0], b = p[1], c = p[2], d = p[3];
    const float s = (((a[0] + a[1]) + (a[2] + a[3])) + ((b[0] + b[1]) + (b[2] + b[3]))) + (((c[0] + c[1]) + (c[2] + c[3])) + ((d[0] + d[1]) + (d[2] + d[3])));
    return __builtin_amdgcn_rsqf(s * (1.0f / 1024.0f) + RMS_EPS);
}
__device__ __forceinline__ float row_rstd_q(const float* ssp, size_t row, int fq) {
    const f32x4 a = *(const f32x4*)(ssp + row * 16 + 4 * fq);
    float s = (a[0] + a[1]) + (a[2] + a[3]);
    s += __shfl_xor(s, 16); s += __shfl_xor(s, 32);
    return __builtin_amdgcn_rsqf(s * (1.0f / 1024.0f) + RMS_EPS);
}
__device__ __forceinline__ float fast_sigmoid(float x) { return __builtin_amdgcn_rcpf(1.0f + __builtin_amdgcn_exp2f(-1.4426950408889634f * x)); }
struct EpiProj {
    static constexpr bool PERM = true, AFTER_DRAIN = false;
    bf16_t* O; int ldc; const float* ss;
    __device__ __forceinline__ void operator()(const f32x4 (&acc)[2][2][4][2], const Unit& u, int wr, int wc, int fr, int fq) const {
        const int row0 = u.pm * BM + wr * 64 + fr, col0 = u.pn * BM + wc * 32 + 8 * fq;
#pragma unroll
        for (int ai = 0; ai < 2; ++ai)
#pragma unroll
            for (int m = 0; m < 4; ++m) {
                const int row = row0 + ai * HALF + m * 16;
                const float rs = row_rstd_q(ss, (size_t)row, fq);
                bf16_t* rowp = O + (size_t)row * ldc + col0;
#pragma unroll
                for (int bj = 0; bj < 2; ++bj) { const f32x4 v0 = acc[ai][bj][m][0] * rs, v1 = acc[ai][bj][m][1] * rs;
                    u32x4 w; w.x = cvt_pk_bf16(v0[0], v0[1]); w.y = cvt_pk_bf16(v0[2], v0[3]); w.z = cvt_pk_bf16(v1[0], v1[1]); w.w = cvt_pk_bf16(v1[2], v1[3]);
                    *(u32x4*)(rowp + bj * HALF) = w; }
            }
    }
};
struct EpiGateUp {
    static constexpr bool PERM = true, AFTER_DRAIN = false;
    bf16_t* O; int ldc; const float* ss;
    __device__ __forceinline__ void operator()(const f32x4 (&acc)[2][2][4][2], const Unit& u, int wr, int wc, int fr, int fq) const {
        const int row0 = u.pm * BM + wr * 64 + fr, col0 = u.pn * HALF + wc * 32 + 8 * fq;
#pragma unroll
        for (int ai = 0; ai < 2; ++ai)
#pragma unroll
            for (int m = 0; m < 4; ++m) {
                const int row = row0 + ai * HALF + m * 16;
                const float rs = row_rstd_q(ss, (size_t)row, fq);
                float hv[8];
#pragma unroll
                for (int n = 0; n < 2; ++n)
#pragma unroll
                    for (int e = 0; e < 4; ++e) { const float g = acc[ai][0][m][n][e] * rs, up = acc[ai][1][m][n][e] * rs; hv[n * 4 + e] = g * fast_sigmoid(g) * up; }
                u32x4 w; w.x = cvt_pk_bf16(hv[0], hv[1]); w.y = cvt_pk_bf16(hv[2], hv[3]); w.z = cvt_pk_bf16(hv[4], hv[5]); w.w = cvt_pk_bf16(hv[6], hv[7]);
                *(u32x4*)(O + (size_t)row * ldc + col0) = w;
            }
    }
};
struct EpiRes {
    static constexpr bool PERM = true, AFTER_DRAIN = false;
    bf16_t* xb; float* ssn;
    __device__ __forceinline__ void operator()(const f32x4 (&acc)[2][2][4][2], const Unit& u, int wr, int wc, int fr, int fq) const {
        const int col0 = u.pn * BM + wc * 32 + 8 * fq;
#pragma unroll
        for (int ai = 0; ai < 2; ++ai)
#pragma unroll
            for (int m = 0; m < 4; ++m) {
                const size_t row = (size_t)u.pm * BM + ai * HALF + wr * 64 + m * 16 + fr;
                float ssq = 0.f;
#pragma unroll
                for (int bj = 0; bj < 2; ++bj) { bf16_t* p = xb + row * 1024 + col0 + bj * HALF;
                    const u32x4 b = *(const u32x4*)p; const f32x4 a0 = acc[ai][bj][m][0], a1 = acc[ai][bj][m][1];
                    float o[8];
                    o[0] = __uint_as_float(b.x << 16) + a0[0]; o[1] = __uint_as_float(b.x & 0xffff0000u) + a0[1]; o[2] = __uint_as_float(b.y << 16) + a0[2]; o[3] = __uint_as_float(b.y & 0xffff0000u) + a0[3];
                    o[4] = __uint_as_float(b.z << 16) + a1[0]; o[5] = __uint_as_float(b.z & 0xffff0000u) + a1[1]; o[6] = __uint_as_float(b.w << 16) + a1[2]; o[7] = __uint_as_float(b.w & 0xffff0000u) + a1[3];
                    ssq += ((o[0] * o[0] + o[1] * o[1]) + (o[2] * o[2] + o[3] * o[3])) + ((o[4] * o[4] + o[5] * o[5]) + (o[6] * o[6] + o[7] * o[7]));
                    u32x4 w; w.x = cvt_pk_bf16(o[0], o[1]); w.y = cvt_pk_bf16(o[2], o[3]); w.z = cvt_pk_bf16(o[4], o[5]); w.w = cvt_pk_bf16(o[6], o[7]); *(u32x4*)p = w; }
                ssq += __shfl_xor(ssq, 16); ssq += __shfl_xor(ssq, 32);
                if (fq == 0) ssn[row * 16 + u.pn * 4 + wc] = ssq;
            }
    }
};

struct GuOrder : StaticOrder {
    int npre, lo, hi;
    __device__ __forceinline__ bool next(int i, Unit& u) const {
        const long L = (long)lo + (long)i * G + c; if (L >= hi) return false;
        if (L < npre) { u.pm = 64 + (int)L / nN; u.pn = (int)L % nN; return true; }
        int wgid = (int)(L - npre); { const int q = nwg / NXCD, r = nwg % NXCD, xcd = wgid % NXCD, off = wgid / NXCD; wgid = (xcd < r ? xcd * (q + 1) : r * (q + 1) + (xcd - r) * q) + off; }
        const int nig = WGM * nN, gid = wgid / nig, fm = gid * WGM, gsz = (nM - fm) < WGM ? (nM - fm) : WGM;
        u.pm = fm + ((wgid % nig) % gsz); u.pn = (wgid % nig) / gsz; return true;
    }
    __device__ __forceinline__ void a_ready(const Unit&) const {}
    __device__ __forceinline__ void done(const Unit&) const {}
};
struct SampleOrder {
    int c0, c;
    __device__ __forceinline__ bool next(int i, Unit& u) const { if (i != 0 || c < c0 || c >= c0 + 32) return false; u.pm = 64 + (c - c0) / 4; u.pn = (c - c0) % 4; return true; }
    __device__ __forceinline__ void a_ready(const Unit&) const {}
    __device__ __forceinline__ void done(const Unit&) const {}
};
template <class Epi, class Sched, bool ALIGN_EPI = false, bool SP2 = false>
__device__ __forceinline__ void gemm_phase(PG8_LAS unsigned char* lds, const Gemm g, const Sched& S, const Epi& E) {
    int tid_ = threadIdx.x; asm volatile("" : "+v"(tid_));
    const int tid = tid_, wid = __builtin_amdgcn_readfirstlane(tid >> 6), lane = tid & 63, wr = wid >> 2, wc = wid & 3, fr = lane & 15, fq = lane >> 4;
    const int K = g.K, nt = K / BK;
    unsigned voffA[2], voffB[2];
#pragma unroll
    for (int i = 0; i < 2; ++i) { int R, C; stage_rc(tid * 16 + i * 8192, R, C); const int Rb = Epi::PERM ? ((R & ~31) + perm32(R & 31)) : R;
        voffA[i] = (unsigned)(R * K + C) * 2u; voffB[i] = (unsigned)(Rb * K + C) * 2u; }
    const size_t kstep = (size_t)(BK * 2);
    const size_t hstep = (size_t)HALF * K * 2;
    const size_t tstep = 2 * hstep;
    const unsigned ldsw = (unsigned)wid * 1024u;
    const int aoff = lds_byte(wr * 64 + fr, fq * 8), boff = lds_byte(wc * 32 + fr, fq * 8);
#define PG8_SA(b, h) (((b) * 2 + (h)) * HTB)
#define PG8_SB(b, h) ((4 + (b) * 2 + (h)) * HTB)
#define PG8_STAGE(bufoff, gbase, voff) do { _Pragma("unroll") for (int _i = 0; _i < 2; ++_i) \
        __builtin_amdgcn_global_load_lds((const unsigned*)((const char*)(gbase) + (voff)[_i]), (PG8_LAS unsigned*)(lds + (bufoff) + ldsw + _i * 8192), 16, 0, 0); } while (0)
#define PG8_LDA(dst, b, h) do { _Pragma("unroll") for (int m = 0; m < 4; ++m) _Pragma("unroll") for (int k = 0; k < 2; ++k) dst[m][k] = *(const PG8_LAS bf16x8*)(lds + PG8_SA(b, h) + aoff + m * 2048 + k * 1024); } while (0)
#define PG8_LDB(dst, b, h) do { _Pragma("unroll") for (int n = 0; n < 2; ++n) _Pragma("unroll") for (int k = 0; k < 2; ++k) dst[n][k] = *(const PG8_LAS bf16x8*)(lds + PG8_SB(b, h) + boff + n * 2048 + k * 1024); } while (0)
#define PG8_MMA(ai, bj, At, Bt) do { __builtin_amdgcn_s_setprio(1); _Pragma("unroll") for (int m = 0; m < 4; ++m) _Pragma("unroll") for (int n = 0; n < 2; ++n) _Pragma("unroll") for (int k = 0; k < 2; ++k) \
        acc[ai][bj][m][n] = __builtin_amdgcn_mfma_f32_16x16x32_bf16(Bt[n][k], At[m][k], acc[ai][bj][m][n], 0, 0, 0); __builtin_amdgcn_s_setprio(0); } while (0)
#define PG8_WAIT_V(n) asm volatile("s_waitcnt vmcnt(" #n ")" ::: "memory")
#define PG8_WAIT_L(n) asm volatile("s_waitcnt lgkmcnt(" #n ")" ::: "memory")
#define PG8_BAR __builtin_amdgcn_s_barrier()
#define PG8_SCHED __builtin_amdgcn_sched_barrier(0)
    Unit cur, nxt; int ui = 0;
    if (!S.next(0, cur)) return;
    f32x4 acc[2][2][4][2];
#pragma unroll
    for (int a = 0; a < 2; ++a)
#pragma unroll
        for (int b = 0; b < 2; ++b)
#pragma unroll
            for (int m = 0; m < 4; ++m)
#pragma unroll
                for (int n = 0; n < 2; ++n) acc[a][b][m][n] = (f32x4){0.f, 0.f, 0.f, 0.f};
    bf16x8 At[4][2], B0[2][2], B1[2][2];
    const char* cA = (const char*)g.A + (size_t)cur.pm * tstep; const char* cB = (const char*)g.Bt + (size_t)cur.pn * tstep;
    S.a_ready(cur);
    if constexpr (SP2) {
        PG8_STAGE(PG8_SB(0, 0), cB, voffB); PG8_STAGE(PG8_SB(0, 1), cB + hstep, voffB); PG8_STAGE(PG8_SA(0, 0), cA, voffA); PG8_STAGE(PG8_SA(0, 1), cA + hstep, voffA);
        if (wr == 1) PG8_BAR;
        PG8_WAIT_V(2); PG8_BAR;
        PG8_STAGE(PG8_SB(1, 0), cB + kstep, voffB); PG8_STAGE(PG8_SA(1, 0), cA + kstep, voffA); PG8_STAGE(PG8_SB(1, 1), cB + hstep + kstep, voffB);
        PG8_WAIT_V(6); PG8_BAR;
    } else {
        PG8_STAGE(PG8_SB(0, 0), cB, voffB); PG8_STAGE(PG8_SA(0, 0), cA, voffA); PG8_STAGE(PG8_SB(0, 1), cB + hstep, voffB); PG8_STAGE(PG8_SA(0, 1), cA + hstep, voffA);
        if (wr == 1) PG8_BAR;
        PG8_WAIT_V(4); PG8_BAR;
        PG8_STAGE(PG8_SB(1, 0), cB + kstep, voffB); PG8_STAGE(PG8_SA(1, 0), cA + kstep, voffA); PG8_STAGE(PG8_SB(1, 1), cB + hstep + kstep, voffB);
        PG8_WAIT_V(6); PG8_BAR;
    }
    for (;;) {
        const bool has_next = S.next(ui + 1, nxt);
        const char* nA = has_next ? (const char*)g.A + (size_t)nxt.pm * tstep : cA; const char* nB = has_next ? (const char*)g.Bt + (size_t)nxt.pn * tstep : cB;
        for (int t = 0; t < nt; t += 2) {
            const bool last = (t == nt - 2);
            const char* a1 = cA + (size_t)(t + 1) * kstep;
            const char* a2 = last ? nA : cA + (size_t)(t + 2) * kstep; const char* b2 = last ? nB : cB + (size_t)(t + 2) * kstep;
            const char* a3 = a2 + kstep; const char* b3 = b2 + kstep;
            if (last && has_next) S.a_ready(nxt);
            if constexpr (SP2) {
            PG8_LDB(B0, 0, 0); PG8_LDB(B1, 0, 1); PG8_SCHED; PG8_LDA(At, 0, 0); PG8_STAGE(PG8_SA(1, 1), a1 + hstep, voffA);
            PG8_WAIT_V(8); PG8_WAIT_L(0); PG8_BAR; PG8_MMA(0, 0, At, B0); PG8_MMA(0, 1, At, B1); PG8_BAR; PG8_SCHED;
            PG8_LDA(At, 0, 1); PG8_STAGE(PG8_SB(0, 0), b2, voffB); PG8_STAGE(PG8_SB(0, 1), b2 + hstep, voffB); PG8_STAGE(PG8_SA(0, 0), a2, voffA);
            PG8_WAIT_V(8); PG8_WAIT_L(0); PG8_BAR; PG8_MMA(1, 0, At, B0); PG8_MMA(1, 1, At, B1); PG8_BAR; PG8_SCHED;
            PG8_LDB(B0, 1, 0); PG8_LDB(B1, 1, 1); PG8_SCHED; PG8_LDA(At, 1, 0); PG8_STAGE(PG8_SA(0, 1), a2 + hstep, voffA);
            PG8_WAIT_V(8); PG8_WAIT_L(0); PG8_BAR; PG8_MMA(0, 0, At, B0); PG8_MMA(0, 1, At, B1); PG8_BAR; PG8_SCHED;
            PG8_LDA(At, 1, 1); PG8_STAGE(PG8_SB(1, 0), b3, voffB); PG8_STAGE(PG8_SB(1, 1), b3 + hstep, voffB); PG8_STAGE(PG8_SA(1, 0), a3, voffA);
            PG8_WAIT_V(8); PG8_WAIT_L(0); PG8_BAR; PG8_MMA(1, 0, At, B0); PG8_MMA(1, 1, At, B1); PG8_BAR; PG8_SCHED;
            } else {
            PG8_LDB(B0, 0, 0); PG8_SCHED; PG8_LDA(At, 0, 0); PG8_STAGE(PG8_SA(1, 1), a1 + hstep, voffA);
            PG8_WAIT_L(8); PG8_BAR; PG8_WAIT_L(0); PG8_MMA(0, 0, At, B0); PG8_BAR; PG8_SCHED;
            PG8_LDB(B1, 0, 1); PG8_STAGE(PG8_SB(0, 0), b2, voffB);
            PG8_BAR; PG8_WAIT_L(0); PG8_MMA(0, 1, At, B1); PG8_BAR;
            PG8_LDA(At, 0, 1); PG8_STAGE(PG8_SA(0, 0), a2, voffA);
            PG8_BAR; PG8_WAIT_L(0); PG8_MMA(1, 0, At, B0); PG8_BAR; PG8_SCHED;
            PG8_STAGE(PG8_SB(0, 1), b2 + hstep, voffB);
            PG8_WAIT_V(6); PG8_BAR; PG8_MMA(1, 1, At, B1); PG8_BAR;
            PG8_LDB(B0, 1, 0); PG8_SCHED; PG8_LDA(At, 1, 0); PG8_STAGE(PG8_SA(0, 1), a2 + hstep, voffA);
            PG8_WAIT_L(8); PG8_BAR; PG8_WAIT_L(0); PG8_MMA(0, 0, At, B0); PG8_BAR; PG8_SCHED;
            PG8_LDB(B1, 1, 1); PG8_STAGE(PG8_SB(1, 0), b3, voffB);
            PG8_BAR; PG8_WAIT_L(0); PG8_MMA(0, 1, At, B1); PG8_BAR;
            PG8_LDA(At, 1, 1); PG8_STAGE(PG8_SA(1, 0), a3, voffA);
            PG8_BAR; PG8_WAIT_L(0); PG8_MMA(1, 0, At, B0); PG8_BAR; PG8_SCHED;
            PG8_STAGE(PG8_SB(1, 1), b3 + hstep, voffB);
            PG8_WAIT_V(6); PG8_BAR; PG8_MMA(1, 1, At, B1); PG8_BAR;
            }
        }
        if constexpr (ALIGN_EPI) { if (wr == 0) PG8_BAR; }
        if constexpr (!Epi::AFTER_DRAIN) { E(acc, cur, wr, wc, fr, fq); S.done(cur); }
        if (!has_next) break;
#pragma unroll
        for (int a = 0; a < 2; ++a)
#pragma unroll
            for (int b = 0; b < 2; ++b)
#pragma unroll
                for (int m = 0; m < 4; ++m)
#pragma unroll
                    for (int n = 0; n < 2; ++n) acc[a][b][m][n] = (f32x4){0.f, 0.f, 0.f, 0.f};
        cur = nxt; cA = nA; cB = nB; ++ui;
        if constexpr (ALIGN_EPI) { if (wr == 1) PG8_BAR; }
    }
    PG8_WAIT_V(0);
    if constexpr (!ALIGN_EPI) { if (wr == 0) PG8_BAR; }
    PG8_BAR;
    if constexpr (Epi::AFTER_DRAIN) { E.fused(acc, cur, wr, wc, fr, fq, lds, wid, lane); S.done(cur); }
#undef PG8_SA
#undef PG8_SB
#undef PG8_STAGE
#undef PG8_LDA
#undef PG8_LDB
#undef PG8_MMA
#undef PG8_WAIT_V
#undef PG8_WAIT_L
#undef PG8_BAR
#undef PG8_SCHED
}
}
namespace cg = cooperative_groups;
#define LAS __attribute__((address_space(3)))
typedef unsigned short bf16;
typedef unsigned v4u __attribute__((ext_vector_type(4)));
typedef unsigned v2u __attribute__((ext_vector_type(2)));
typedef float f32x4 __attribute__((ext_vector_type(4)));
typedef float f32x2v __attribute__((ext_vector_type(2)));
typedef short bf16x8 __attribute__((ext_vector_type(8)));
typedef short bf16x4 __attribute__((ext_vector_type(4)));

constexpr int NWAVES = 8, NTHREADS = 512;
constexpr int DM = 1024, M_TOK = 18432, M_PROMPT = 16384, NCHUNK = 288, NPCH = 256;
constexpr int D_IN = 2560, D_FF = 2816, DA = 384, DB = 256, DC = 384;
constexpr int CQ = 0, CF = 384, CI = 768, CG = 1152, CU = 1536, CXR = 1792, CGR = 2176;
constexpr float EPS = 1e-6f;
constexpr size_t O_Y = 0, O_HP = 18874368, O_SRP = O_HP + 196608, O_SIP = O_SRP + 8192, O_LP = O_SIP + 8192, O_CP = O_LP + 3072,
                 O_HS = O_CP + 9216, O_SRS = O_HS + 1572864, O_SIS = O_SRS + 65536, O_LS = O_SIS + 65536, O_CS = O_LS + 24576, O_END = O_CS + 73728;
constexpr size_t MiB = 1u << 20;
constexpr size_t WS_CTL = 0, CTL_ZERO_BYTES = 1 * MiB, WS_SS = 64 * 1024, WS_TAB = 1 * MiB;
constexpr size_t WS_WIN = 2 * MiB, WS_WOUT = 12 * MiB, WS_WGU = 16 * MiB, WS_WDN = 38 * MiB, WS_SMALL = 49 * MiB;
constexpr size_t SM_LBS = 0, SM_S5A = 4096, SM_S5A64 = SM_S5A + 16384, SM_BB = SM_S5A64 + 16384, SM_CC = SM_BB + 131072, SM_WGT = SM_CC + 131072,
                 SM_WAT = SM_WGT + 262144, SM_WXT = SM_WAT + 98304, SM_SP = SM_WXT + 98304, SM_END = SM_SP + 4096;
static_assert(SM_END <= 3 * MiB, "small tables");
constexpr size_t WS_XB = 52 * MiB, WS_PROJ = 88 * MiB, WS_MIX = 178 * MiB, WS_HID = 88 * MiB;
constexpr size_t WS_HST = 214 * MiB, WS_HD = 238 * MiB, WS_S5ST = 239 * MiB, WS_LRUST = 241 * MiB, WS_SSP = 243 * MiB, WS_END = 249 * MiB;
constexpr int LDS_BYTES = 147456, XB_LDS_OFF = 147456 - 256;

struct Args { const float* in[36]; float* out; unsigned char* ws; };
enum { I_XP = 0, I_XS, I_SH, I_SSR, I_SSI, I_SL, I_SC, I_NMIX, I_WIN, I_HLB, I_HNORM, I_S5LR, I_S5LI, I_S5DT, I_S5BR, I_S5BI, I_S5CR, I_S5CI, I_S5D, I_S5WG, I_S5BG, I_S5N,
       I_LCW, I_LCB, I_LWA, I_LBA, I_LWX, I_LBX, I_LLAM, I_LNORM, I_WOUT, I_NFFN, I_WG, I_WU, I_WD, I_NFIN };


__device__ __forceinline__ unsigned long long rfl64(unsigned long long v) { return ((unsigned long long)(unsigned)__builtin_amdgcn_readfirstlane((int)(unsigned)(v >> 32)) << 32) | (unsigned long long)(unsigned)__builtin_amdgcn_readfirstlane((int)(unsigned)v); }
#define GAS __attribute__((address_space(1)))
typedef __attribute__((address_space(4))) const unsigned char KSEG;
__device__ __forceinline__ const Args& kargs() { KSEG* p = (KSEG*)__builtin_amdgcn_kernarg_segment_ptr(); asm volatile("" : "+s"(p)); return *(const Args*)(const void*)p; }
__device__ __forceinline__ const float* gp(const Args& a, int k) { return (const float*)(const GAS float*)a.in[k]; }
__device__ __forceinline__ unsigned char* gws(const Args& a) { return (unsigned char*)(GAS unsigned char*)a.ws; }
__device__ __forceinline__ float* gout(const Args& a) { return (float*)(GAS float*)a.out; }
__device__ __forceinline__ float bf2f(bf16 b) { return __uint_as_float((unsigned)b << 16); }
__device__ __forceinline__ unsigned pk2(float lo, float hi) { return pg8::cvt_pk_bf16(lo, hi); }
__device__ __forceinline__ bf16 f2bf(float f) { return (bf16)(pk2(f, 0.f) & 0xffffu); }
__device__ __forceinline__ float sigm(float x) { return __builtin_amdgcn_rcpf(1.0f + __builtin_amdgcn_exp2f(-1.4426950408889634f * x)); }
__device__ __forceinline__ float gelu_tanh(float x) { const float u = 0.7978845608028654f * (x + 0.044715f * x * x * x); return x * sigm(2.0f * u); }
#define LAUNDER_V(x) asm volatile("" : "+v"(x))
#define BSYNC() asm volatile("s_waitcnt lgkmcnt(0)\n\ts_barrier" ::: "memory")
#define LDS_WAIT() asm volatile("s_waitcnt lgkmcnt(0)" ::: "memory")
#define WAVE_SYNC() do { asm volatile("s_waitcnt lgkmcnt(0)" ::: "memory"); __builtin_amdgcn_wave_barrier(); } while (0)
#define MFMA16(a, b, c) __builtin_amdgcn_mfma_f32_16x16x32_bf16((a), (b), (c), 0, 0, 0)
__device__ __forceinline__ float wave_sum(float v) {
#pragma unroll
    for (int o = 1; o < 64; o <<= 1) v += __shfl_xor(v, o);
    return v;
}

#define XB_TMO      128
#define XB_XCNT(j)  (256  + 64 * (j))
#define XB_XSUB(j)  (1280 + 64 * (j))
#define XB_XGEN(j)  (2304 + 64 * (j))
#define XB_TOP      3328
#define XB_TOPGEN   3392
#define XCD_BAR_WORDS 3456
#define XB_SPIN_CAP (1u << 18)

__device__ __forceinline__ unsigned xb_ld(unsigned* p)              { return __hip_atomic_load(p, __ATOMIC_RELAXED, __HIP_MEMORY_SCOPE_AGENT); }
__device__ __forceinline__ unsigned xb_add(unsigned* p, unsigned v) { return __hip_atomic_fetch_add(p, v, __ATOMIC_RELAXED, __HIP_MEMORY_SCOPE_AGENT); }
__device__ __forceinline__ unsigned xb_xcc_id() { return (unsigned)__builtin_amdgcn_s_getreg((3 << 11) | 20) & 0xFu; }
#define XB_SPIN(cond, bar) do { unsigned _sp = 0; while (cond) { __builtin_amdgcn_s_sleep(1); \
    if ((++_sp & 255u) == 0u) { if (xb_ld(&(bar)[XB_TMO])) break; if (_sp > XB_SPIN_CAP) { atomicAdd(&(bar)[XB_TMO], 1u); break; } } } } while (0)

struct XcdBarrier {
    unsigned* bar; unsigned x;
    volatile LAS unsigned* st;
};

__device__ __forceinline__ XcdBarrier xcd_barrier_post(unsigned* bar, volatile LAS unsigned* st) {
    XcdBarrier b; b.bar = bar; b.x = xb_xcc_id(); b.st = st;
    if (threadIdx.x == 0) (void)xb_add(&bar[XB_XCNT(b.x)], 1u);
    return b;
}
__device__ __forceinline__ void xcd_barrier_complete(unsigned* bar, unsigned x, unsigned& nloc, unsigned& nx) {
    const unsigned G = gridDim.x * gridDim.y * gridDim.z;
    unsigned sum, cnt, mine, sp = 0u;
    for (;;) {
        sum = 0u; cnt = 0u; mine = 0u;
#pragma unroll
        for (unsigned j = 0; j < 16; ++j) { const unsigned c = xb_ld(&bar[XB_XCNT(j)]); sum += c; cnt += (c > 0u) ? 1u : 0u; mine = (j == x) ? c : mine; }
        if (sum == G) break;
        __builtin_amdgcn_s_sleep(1);
        if ((++sp & 255u) == 0u) { if (xb_ld(&bar[XB_TMO])) break; if (sp > XB_SPIN_CAP) { atomicAdd(&bar[XB_TMO], 1u); break; } }
    }
    nloc = mine > 0u ? mine : 1u; nx = cnt > 0u ? cnt : 1u;
}

__device__ __forceinline__ void xcd_barrier(const XcdBarrier& b) {
    asm volatile("s_waitcnt vmcnt(0)" ::: "memory");
    __syncthreads();
    if (threadIdx.x == 0) {
        unsigned* bar = b.bar;
        __builtin_amdgcn_s_waitcnt(0);
        unsigned nloc = b.st[0], nx = b.st[1];
        if (nloc == 0u) { xcd_barrier_complete(bar, b.x, nloc, nx); b.st[0] = nloc; b.st[1] = nx; }
        const unsigned old = xb_add(&bar[XB_XSUB(b.x)], 1u);
        const unsigned gen = old / nloc;
        if (old + 1u == (gen + 1u) * nloc) {
            __builtin_amdgcn_fence(__ATOMIC_RELEASE, "agent");
            asm volatile("s_waitcnt vmcnt(0)" ::: "memory");
            const unsigned og = xb_add(&bar[XB_TOP], 1u);
            const unsigned tg = og / nx;
            if (og + 1u == (tg + 1u) * nx) xb_add(&bar[XB_TOPGEN], 1u);
            else XB_SPIN(xb_ld(&bar[XB_TOPGEN]) == tg, bar);
            __builtin_amdgcn_fence(__ATOMIC_ACQUIRE, "agent");
            xb_add(&bar[XB_XGEN(b.x)], 1u);
            asm volatile("s_waitcnt vmcnt(0)" ::: "memory");
        } else {
            XB_SPIN(xb_ld(&bar[XB_XGEN(b.x)]) == gen, bar);
            __builtin_amdgcn_fence(__ATOMIC_ACQUIRE, "agent");
            asm volatile("s_waitcnt vmcnt(0)" ::: "memory");
        }
    }
    __syncthreads();
}

__device__ __forceinline__ void p0_transpose_item(const float* W, int K, int N, bf16* WT, int k0, int n0, int drow0, const float* kscale, LAS float* scr, int lane) {
    const int c = lane & 7;
    f32x4 ks0 = {1.f, 1.f, 1.f, 1.f}, ks1 = {1.f, 1.f, 1.f, 1.f};
    if (kscale) { ks0 = *(const f32x4*)(kscale + k0 + 8 * c); ks1 = *(const f32x4*)(kscale + k0 + 8 * c + 4); }
    const float* wp = W + (size_t)(k0 + (lane >> 5)) * N + n0 + (lane & 31);
#pragma unroll
    for (int i = 0; i < 32; ++i) scr[(2 * i + (lane >> 5)) * 33 + (lane & 31)] = __builtin_nontemporal_load(wp + (size_t)(2 * i) * N);
    LDS_WAIT(); asm volatile("" ::: "memory");
#pragma unroll
    for (int j = 0; j < 4; ++j) { const int n = (lane >> 3) + 8 * j; const LAS float* s = scr + (8 * c) * 33 + n;
        v4u o; o.x = pk2(s[0 * 33] * ks0.x, s[1 * 33] * ks0.y); o.y = pk2(s[2 * 33] * ks0.z, s[3 * 33] * ks0.w); o.z = pk2(s[4 * 33] * ks1.x, s[5 * 33] * ks1.y); o.w = pk2(s[6 * 33] * ks1.z, s[7 * 33] * ks1.w);
        *(v4u*)(WT + (size_t)(drow0 + n) * K + k0 + 8 * c) = o; }
    LDS_WAIT(); asm volatile("" ::: "memory");
}

__device__ __forceinline__ void convert_weights(const Args& a, int l, LAS unsigned char* lds, int lane, int wave, int w, int nw, int part = 4  ) {
    unsigned char* ws = gws(a);
    LAS float* scr = (LAS float*)(lds + wave * 16384);
    constexpr int IT_IN = 16 * 80, IT_OUT = 16 * 32, IT_G = 16 * 88, IT_D = 44 * 32;
    constexpr int NITEMS = IT_IN + IT_OUT + 2 * IT_G + IT_D;
    const int it_lo = part == 4 ? 0 : (part == 0 ? 0 : part == 1 ? IT_IN : part == 2 ? IT_IN + IT_OUT : IT_IN + IT_OUT + 2 * IT_G);
    const int it_hi = part == 4 ? NITEMS : (part == 0 ? IT_IN : part == 1 ? IT_IN + IT_OUT : part == 2 ? IT_IN + IT_OUT + 2 * IT_G : NITEMS);
    for (int it = it_lo + w; it < it_hi; it += nw) {
        int r = it;
        if (r < IT_IN) { const int kb = r / 80, nb = r % 80;
            p0_transpose_item(gp(a, I_WIN) + (size_t)l * DM * D_IN, DM, D_IN, (bf16*)(ws + WS_WIN) + (size_t)l * D_IN * DM, 64 * kb, 32 * nb, 32 * nb, gp(a, I_NMIX) + l * DM, scr, lane); continue; }
        r -= IT_IN;
        if (r < IT_OUT) { const int kb = r / 32, nb = r % 32;
            p0_transpose_item(gp(a, I_WOUT) + (size_t)l * DM * DM, DM, DM, (bf16*)(ws + WS_WOUT) + (size_t)l * DM * DM, 64 * kb, 32 * nb, 32 * nb, nullptr, scr, lane); continue; }
        r -= IT_OUT;
        if (r < 2 * IT_G) { const int sel = r / IT_G; r -= sel * IT_G; const int kb = r / 88, nb = r % 88; const int n0 = 32 * nb;
            const int drow0 = 256 * (n0 >> 7) + 128 * sel + (n0 & 127);
            p0_transpose_item(gp(a, sel ? I_WU : I_WG) + (size_t)l * DM * D_FF, DM, D_FF, (bf16*)(ws + WS_WGU) + (size_t)l * 2 * D_FF * DM, 64 * kb, n0, drow0, gp(a, I_NFFN) + l * DM, scr, lane); continue; }
        r -= 2 * IT_G;
        { const int kb = r / 32, nb = r % 32;
            p0_transpose_item(gp(a, I_WD) + (size_t)l * D_FF * DM, D_FF, DM, (bf16*)(ws + WS_WDN) + (size_t)l * DM * D_FF, 64 * kb, 32 * nb, 32 * nb, nullptr, scr, lane); }
    }
}

__device__ __forceinline__ void p0_prologue(const Args& a, LAS unsigned char* lds, int tid, int lane, int wave) {
    unsigned char* ws = gws(a);
    LAS float* scr = (LAS float*)(lds + wave * 16384);
    const int gw = blockIdx.x * NWAVES + wave, NGW = gridDim.x * NWAVES;
    convert_weights(a, 0, lds, lane, wave, gw, NGW, 0);
    {
        bf16* XB = (bf16*)(ws + WS_XB); float* SS0 = (float*)(ws + WS_SSP);
        for (int m0 = gw; m0 < M_TOK; m0 += 3 * NGW) {
            f32x4 v[3][4];
#pragma unroll
            for (int r = 0; r < 3; ++r) { const int m = m0 + r * NGW; if (m < M_TOK) { const float* xrow = (m < M_PROMPT) ? gp(a, I_XP) + (size_t)m * DM : gp(a, I_XS) + (size_t)(m - M_PROMPT) * DM; const f32x4* xr = (const f32x4*)xrow + lane;
#pragma unroll
                for (int j = 0; j < 4; ++j) v[r][j] = __builtin_nontemporal_load(xr + 64 * j); } }
#pragma unroll
            for (int r = 0; r < 3; ++r) { const int m = m0 + r * NGW; if (m < M_TOK) { float s = 0.f; unsigned long long* o8 = (unsigned long long*)(XB + (size_t)m * DM) + lane;
#pragma unroll
                for (int j = 0; j < 4; ++j) { const f32x4 x = v[r][j]; s += (x.x * x.x + x.y * x.y) + (x.z * x.z + x.w * x.w); o8[64 * j] = (unsigned long long)pk2(x.x, x.y) | ((unsigned long long)pk2(x.z, x.w) << 32); }
                s = wave_sum(s); if (lane < 16) SS0[(size_t)m * 16 + lane] = (lane == 0) ? s : 0.f; } }
        }
    }
    unsigned char* sm = ws + WS_SMALL;
    const int NGT = gridDim.x * NTHREADS, gt = NGT - 1 - (blockIdx.x * NTHREADS + tid);
    for (int i = gt; i < 2 * DA; i += NGT) {
        const int l = i / DA, j = i % DA; float v = 0.f;
        if (l == 1) { const float l0 = gp(a, I_HLB)[j], l1 = gp(a, I_HLB)[DA + j]; v = 1.0f / (1.0f + expf(l0 - l1)); }
        ((float*)(sm + SM_LBS))[i] = v;
    }
    for (int i = gt; i < 2 * DC; i += NGT) { const float lam = gp(a, I_LLAM)[i]; ((float*)(sm + SM_SP))[i] = -8.0f * log1pf(expf(-lam)); }
    for (int i = gt; i < 2 * 16 * 64; i += NGT) {
        const int lg = i >> 6, p = i & 63;
        const float dt = expf(gp(a, I_S5DT)[lg]); const float lr = fminf(gp(a, I_S5LR)[i], -1e-4f), li = gp(a, I_S5LI)[i];
        const float mag = expf(lr * dt); const float are = mag * cosf(li * dt), aim = mag * sinf(li * dt);
        ((f32x2v*)(sm + SM_S5A))[i] = (f32x2v){are, aim};
        float pr = are, pi = aim;
#pragma unroll
        for (int s = 0; s < 6; ++s) { const float nr_ = pr * pr - pi * pi, ni_ = 2.0f * pr * pi; pr = nr_; pi = ni_; }
        ((f32x2v*)(sm + SM_S5A64))[i] = (f32x2v){pr, pi};
        const float den = lr * lr + li * li, nr = are - 1.0f;
        const float gre = (nr * lr + aim * li) / den, gim = (aim * lr - nr * li) / den;
        bf16* BB = (bf16*)(sm + SM_BB) + ((size_t)lg * 128 + 2 * p) * 16;
#pragma unroll
        for (int n = 0; n < 16; ++n) { const float br = gp(a, I_S5BR)[(size_t)i * 16 + n], bi = gp(a, I_S5BI)[(size_t)i * 16 + n];
            BB[n] = f2bf(gre * br - gim * bi); BB[16 + n] = f2bf(gre * bi + gim * br); }
        bf16* CC = (bf16*)(sm + SM_CC) + (size_t)lg * 16 * 128;
#pragma unroll
        for (int n = 0; n < 16; ++n) { const float cr = gp(a, I_S5CR)[((size_t)lg * 16 + n) * 64 + p], ci = gp(a, I_S5CI)[((size_t)lg * 16 + n) * 64 + p];
            CC[n * 128 + 2 * p] = f2bf(cr); CC[n * 128 + 2 * p + 1] = f2bf(-ci); }
    }
    for (int i = gt; i < 2 * 256 * 256; i += NGT) { const int l = i >> 16, n = (i >> 8) & 255, k = i & 255; ((bf16*)(sm + SM_WGT))[i] = f2bf(gp(a, I_S5WG)[((size_t)l * 256 + k) * 256 + n]); }
    for (int i = gt; i < 2 * 6 * 64 * 64; i += NGT) { const int lh = i >> 12, j = (i >> 6) & 63, ii = i & 63;
        ((bf16*)(sm + SM_WAT))[i] = f2bf(gp(a, I_LWA)[((size_t)lh * 64 + ii) * 64 + j]); ((bf16*)(sm + SM_WXT))[i] = f2bf(gp(a, I_LWX)[((size_t)lh * 64 + ii) * 64 + j]); }
}

constexpr int HG_S = 72;
constexpr int HG_QG = 0, HG_KG = 2304, HG_QE = 4608, HG_KET = 6912, HG_VT = 8960, HG_EGL = 11008, HG_GT = 11264, HG_WAVE_BYTES = 13568;
template <int CTRL> __device__ __forceinline__ float dpp_f(float v) { return __int_as_float(__builtin_amdgcn_update_dpp(0, __float_as_int(v), CTRL, 0xF, 0xF, true)); }
__device__ __forceinline__ float bfe(const v4u (&w)[2], int e) { const unsigned x = w[e >> 3][(e >> 1) & 3]; return __uint_as_float((e & 1) ? (x & 0xffff0000u) : (x << 16)); }
__device__ __forceinline__ bf16 bfraw(const v4u (&w)[2], int e) { const unsigned x = w[e >> 3][(e >> 1) & 3]; return (bf16)((e & 1) ? (x >> 16) : (x & 0xffffu)); }
template <bool OUT>
__device__ __forceinline__ void hgrn_unit(const Args& a, int layer, int cid, int h, LAS unsigned char* wl, int lane) {
    const int fr = lane & 15, fq = lane >> 4;
    unsigned char* ws = gws(a);
    const bf16* proj = (const bf16*)(ws + WS_PROJ) + (size_t)cid * 64 * D_IN;
    const float* lbp = (const float*)(ws + WS_SMALL + SM_LBS) + layer * DA + h * 64 + 16 * fq;
    float* HST = (float*)(ws + WS_HST);
    f32x4 S[4][4];
    {
        const float* s0 = nullptr;
        if (cid >= NPCH) s0 = gp(a, I_SH) + (((size_t)layer * 32 + (cid - NPCH)) * 6 + h) * 4096;
        else if (OUT && (cid & 63) != 0) s0 = HST + ((size_t)(cid - 1) * 6 + h) * 4096;
        if (s0) {
            const float* sp = s0 + (4 * fq) * 64 + fr;
#pragma unroll
            for (int dt = 0; dt < 4; ++dt)
#pragma unroll
                for (int vt = 0; vt < 4; ++vt)
#pragma unroll
                    for (int j = 0; j < 4; ++j) S[dt][vt][j] = sp[(16 * dt + j) * 64 + 16 * vt];
        } else {
#pragma unroll
            for (int dt = 0; dt < 4; ++dt)
#pragma unroll
                for (int vt = 0; vt < 4; ++vt) S[dt][vt] = (f32x4){0.f, 0.f, 0.f, 0.f};
        }
    }
    float gtot[OUT ? 1 : 16];
#pragma unroll
    for (int e = 0; e < (OUT ? 1 : 16); ++e) gtot[e] = 0.f;
    LAS bf16* QG = (LAS bf16*)(wl + HG_QG); LAS bf16* KG = (LAS bf16*)(wl + HG_KG); LAS bf16* QE = (LAS bf16*)(wl + HG_QE);
    LAS bf16* KET = (LAS bf16*)(wl + HG_KET); LAS bf16* VT = (LAS bf16*)(wl + HG_VT); LAS float* EGL = (LAS float*)(wl + HG_EGL); LAS bf16* GT = (LAS bf16*)(wl + HG_GT);
    const bf16x8 zero8 = {0, 0, 0, 0, 0, 0, 0, 0};
    const int rb7 = (lane & 48) | 7, rb15 = (lane & 48) | 15;
#pragma unroll 1
    for (int sb = 0; sb < 4; ++sb) {
        const bf16* prow = proj + (size_t)(sb * 16 + fr) * D_IN + h * 64 + 16 * fq;
        {
            v4u fw[2], iw[2], qw[2], gw[2];
            fw[0] = *(const v4u*)(prow + CF); fw[1] = *(const v4u*)(prow + CF + 8); iw[0] = *(const v4u*)(prow + CI); iw[1] = *(const v4u*)(prow + CI + 8);
            if (OUT) { qw[0] = *(const v4u*)(prow + CQ); qw[1] = *(const v4u*)(prow + CQ + 8); gw[0] = *(const v4u*)(prow + CG); gw[1] = *(const v4u*)(prow + CG + 8); }
            f32x4 lb4[4];
#pragma unroll
            for (int q = 0; q < 4; ++q) lb4[q] = *(const f32x4*)(lbp + 4 * q);
            float G[16], kv[16];
#pragma unroll
            for (int e = 0; e < 16; ++e) { const float lb = lb4[e >> 2][e & 3], oml = 1.0f - lb; const float sg = sigm(bfe(fw, e));
                kv[e] = oml * (1.0f - sg); G[e] = __logf(lb + oml * sg); }
#pragma unroll
            for (int e = 0; e < 16; ++e) { G[e] += dpp_f<0x111>(G[e]); G[e] += dpp_f<0x112>(G[e]); G[e] += dpp_f<0x114>(G[e]); G[e] += dpp_f<0x118>(G[e]); }
            unsigned qgp[8], kgp[8], qep[8]; float egl[16];
#pragma unroll
            for (int e = 0; e < 16; e += 2) {
                float qg2[2], kg2[2], qe2[2];
#pragma unroll
                for (int o = 0; o < 2; ++o) { const int ee = e + o;
                    const float Gr = __shfl(G[ee], rb7), Gl = __shfl(G[ee], rb15);
                    const float eGr = __expf(Gr), eGlr = __expf(Gl - Gr); egl[ee] = eGr * eGlr; if (!OUT) gtot[ee] += Gl;
                    const float e2 = __expf(Gr - G[ee]); const float kg = kv[ee] * e2;
                    KET[(16 * fq + ee) * 16 + fr] = f2bf(kg * eGlr);
                    VT[(16 * fq + ee) * 16 + fr] = bfraw(iw, ee);
                    if (OUT) { const float e1 = __expf(G[ee] - Gr); const float qg = bfe(qw, ee) * e1; qg2[o] = qg; kg2[o] = kg; qe2[o] = qg * eGr; } }
                if (OUT) { qgp[e >> 1] = pk2(qg2[0], qg2[1]); kgp[e >> 1] = pk2(kg2[0], kg2[1]); qep[e >> 1] = pk2(qe2[0], qe2[1]); }
            }
            if (fr == 15) {
#pragma unroll
                for (int q = 0; q < 4; ++q) *(LAS f32x4*)(EGL + 16 * fq + 4 * q) = (f32x4){egl[4 * q], egl[4 * q + 1], egl[4 * q + 2], egl[4 * q + 3]}; }
            if (OUT) {
                *(LAS v4u*)(QG + fr * HG_S + 16 * fq) = (v4u){qgp[0], qgp[1], qgp[2], qgp[3]}; *(LAS v4u*)(QG + fr * HG_S + 16 * fq + 8) = (v4u){qgp[4], qgp[5], qgp[6], qgp[7]};
                *(LAS v4u*)(KG + fr * HG_S + 16 * fq) = (v4u){kgp[0], kgp[1], kgp[2], kgp[3]}; *(LAS v4u*)(KG + fr * HG_S + 16 * fq + 8) = (v4u){kgp[4], kgp[5], kgp[6], kgp[7]};
                *(LAS v4u*)(QE + fr * HG_S + 16 * fq) = (v4u){qep[0], qep[1], qep[2], qep[3]}; *(LAS v4u*)(QE + fr * HG_S + 16 * fq + 8) = (v4u){qep[4], qep[5], qep[6], qep[7]};
                *(LAS v4u*)(GT + fr * HG_S + 16 * fq) = gw[0]; *(LAS v4u*)(GT + fr * HG_S + 16 * fq + 8) = gw[1];
            }
        }
        WAVE_SYNC();
        if (OUT) {
            f32x4 at = {0.f, 0.f, 0.f, 0.f};
#pragma unroll
            for (int kk = 0; kk < 2; ++kk) { const bf16x8 A = *(const LAS bf16x8*)(KG + fr * HG_S + kk * 32 + fq * 8), B = *(const LAS bf16x8*)(QG + fr * HG_S + kk * 32 + fq * 8); at = MFMA16(A, B, at); }
#pragma unroll
            for (int j = 0; j < 4; ++j) if (4 * fq + j > fr) at[j] = 0.f;
            union { bf16x8 v; unsigned u[4]; } Aatt; Aatt.u[0] = pk2(at[0], at[1]); Aatt.u[1] = pk2(at[2], at[3]); Aatt.u[2] = 0u; Aatt.u[3] = 0u;
            union { bf16x8 v; v2u h[2]; } Aq[2];
#pragma unroll
            for (int kk = 0; kk < 2; ++kk) { Aq[kk].h[0] = *(const LAS v2u*)(QE + fr * HG_S + kk * 32 + 4 * fq); Aq[kk].h[1] = *(const LAS v2u*)(QE + fr * HG_S + kk * 32 + 16 + 4 * fq); }
            f32x4 ov[4]; float ssq[4] = {0.f, 0.f, 0.f, 0.f};
#pragma unroll
            for (int vt = 0; vt < 4; ++vt) {
                union { bf16x8 v; v2u h[2]; } Bv; Bv.h[0] = *(const LAS v2u*)(VT + (16 * vt + fr) * 16 + 4 * fq); Bv.h[1] = (v2u){0u, 0u};
                f32x4 o = {0.f, 0.f, 0.f, 0.f};
                o = MFMA16(Aatt.v, Bv.v, o);
#pragma unroll
                for (int kk = 0; kk < 2; ++kk) { union { bf16x8 v; unsigned u[4]; } Bs;
                    Bs.u[0] = pk2(S[2 * kk][vt][0], S[2 * kk][vt][1]); Bs.u[1] = pk2(S[2 * kk][vt][2], S[2 * kk][vt][3]);
                    Bs.u[2] = pk2(S[2 * kk + 1][vt][0], S[2 * kk + 1][vt][1]); Bs.u[3] = pk2(S[2 * kk + 1][vt][2], S[2 * kk + 1][vt][3]);
                    o = MFMA16(Aq[kk].v, Bs.v, o); }
                ov[vt] = o;
#pragma unroll
                for (int j = 0; j < 4; ++j) ssq[j] += o[j] * o[j];
            }
#pragma unroll
            for (int j = 0; j < 4; ++j) { float s = ssq[j]; s += __shfl_xor(s, 1); s += __shfl_xor(s, 2); s += __shfl_xor(s, 4); s += __shfl_xor(s, 8); ssq[j] = __builtin_amdgcn_rsqf(s * (1.0f / 64.0f) + EPS); }
#pragma unroll
            for (int vt = 0; vt < 4; ++vt) { const float nw = gp(a, I_HNORM)[layer * DA + h * 64 + 16 * vt + fr];
#pragma unroll
                for (int j = 0; j < 4; ++j) { const int t = 4 * fq + j; const float g = bf2f(GT[t * HG_S + 16 * vt + fr]);
                    QG[t * HG_S + 16 * vt + fr] = f2bf(ov[vt][j] * ssq[j] * nw * g * sigm(g)); } }
            WAVE_SYNC();
            { const v4u o0 = *(const LAS v4u*)(QG + fr * HG_S + 8 * fq), o1 = *(const LAS v4u*)(QG + fr * HG_S + 32 + 8 * fq);
              bf16* dst = (bf16*)(ws + WS_MIX) + ((size_t)cid * 64 + sb * 16 + fr) * DM + h * 64 + 8 * fq; *(v4u*)dst = o0; *(v4u*)(dst + 32) = o1; }
        }
        {
            bf16x8 Bv[4];
#pragma unroll
            for (int vt = 0; vt < 4; ++vt) Bv[vt] = (fq < 2) ? *(const LAS bf16x8*)(VT + (16 * vt + fr) * 16 + fq * 8) : zero8;
#pragma unroll
            for (int dt = 0; dt < 4; ++dt) { const f32x4 eg = *(const LAS f32x4*)(EGL + 16 * dt + 4 * fq);
                const bf16x8 A = (fq < 2) ? *(const LAS bf16x8*)(KET + (16 * dt + fr) * 16 + fq * 8) : zero8;
#pragma unroll
                for (int vt = 0; vt < 4; ++vt) S[dt][vt] = MFMA16(A, Bv[vt], S[dt][vt] * eg); }
        }
        WAVE_SYNC();
    }
    {
        float* dst = nullptr;
        if (OUT) { if (cid >= NPCH) dst = gout(a) + O_HS + (((size_t)layer * 32 + (cid - NPCH)) * 6 + h) * 4096;
                   else if ((cid & 63) == 63) dst = gout(a) + O_HP + (((size_t)layer * 4 + (cid >> 6)) * 6 + h) * 4096; }
        else { dst = HST + ((size_t)cid * 6 + h) * 4096;
            if (fr == 0) { float* hd = (float*)(ws + WS_HD) + ((size_t)cid * 6 + h) * 64 + 16 * fq;
#pragma unroll
                for (int q = 0; q < 4; ++q) *(f32x4*)(hd + 4 * q) = (f32x4){__expf(gtot[(OUT ? 0 : 4 * q)]), __expf(gtot[(OUT ? 0 : 4 * q + 1)]), __expf(gtot[(OUT ? 0 : 4 * q + 2)]), __expf(gtot[(OUT ? 0 : 4 * q + 3)])}; } }
        if (dst) {
#pragma unroll
            for (int dt = 0; dt < 4; ++dt)
#pragma unroll
                for (int vt = 0; vt < 4; ++vt)
#pragma unroll
                    for (int j = 0; j < 4; ++j) dst[(4 * fq) * 64 + fr + (16 * dt + j) * 64 + 16 * vt] = S[dt][vt][j];
        }
    }
}

constexpr int S5_US = 264, S5_BS = 132, S5_HS = 136;
constexpr int S5_UT = 0, S5_BUT = 8448, S5_HT = 76032, S5_ZT = 110848, S5_ZF = 119296;
template <bool OUT>
__device__ __forceinline__ void s5_phase(const Args& a, int layer, LAS unsigned char* lds, int tid, int lane, int wave, int NU) {
    const int fr = lane & 15, fq = lane >> 4;
    unsigned char* ws = gws(a); const unsigned char* sm = ws + WS_SMALL;
    f32x2v* ST = (f32x2v*)(ws + WS_S5ST);
    LAS bf16* UT = (LAS bf16*)(lds + S5_UT); LAS float* BUT = (LAS float*)(lds + S5_BUT) + wave * (16 * S5_BS); LAS bf16* HT = (LAS bf16*)(lds + S5_HT) + wave * (16 * S5_HS);
    LAS bf16* ZT = (LAS bf16*)(lds + S5_ZT); LAS float* ZF = (LAS float*)(lds + S5_ZF);
    const bf16x8 zero8 = {0, 0, 0, 0, 0, 0, 0, 0};
    bf16x8 BBr[8], CCr[2][4], WGr[2][8]; float are[2], aim[2], dd[2], bgv[2];
    {
        const bf16* BB = (const bf16*)(sm + SM_BB) + ((size_t)(layer * 16 + (fq < 2 ? wave : 8 + wave)) * 128) * 16;
#pragma unroll
        for (int nt = 0; nt < 8; ++nt) BBr[nt] = *(const bf16x8*)(BB + (16 * nt + fr) * 16 + (fq & 1) * 8);
    }
    const int r_ut = tid >> 5, c8 = (tid & 31) * 8;
#pragma unroll
    for (int hf = 0; hf < 2; ++hf) { const int g = hf * 8 + wave;
        const f32x2v av = ((const f32x2v*)(sm + SM_S5A))[(layer * 16 + g) * 64 + lane]; are[hf] = av.x; aim[hf] = av.y;
        if (OUT) { const bf16* CC = (const bf16*)(sm + SM_CC) + (size_t)(layer * 16 + g) * 16 * 128;
#pragma unroll
            for (int kk = 0; kk < 4; ++kk) CCr[hf][kk] = *(const bf16x8*)(CC + fr * 128 + 32 * kk + 8 * fq);
            dd[hf] = gp(a, I_S5D)[layer * DB + g * 16 + fr]; } }
    if (OUT) { const bf16* WG = (const bf16*)(sm + SM_WGT) + (size_t)layer * 65536;
#pragma unroll
        for (int i = 0; i < 2; ++i) { const int nt = 2 * wave + i;
#pragma unroll
            for (int kk = 0; kk < 8; ++kk) WGr[i][kk] = *(const bf16x8*)(WG + (size_t)(16 * nt + fr) * 256 + 32 * kk + 8 * fq);
            bgv[i] = gp(a, I_S5BG)[layer * DB + 16 * nt + fr]; }
        }
#pragma unroll 1
    for (int u = blockIdx.x; u < NU; u += gridDim.x) {
        const int cid = OUT ? u : (u / 63) * 64 + (u % 63);
        const bf16* proj = (const bf16*)(ws + WS_PROJ) + (size_t)cid * 64 * D_IN;
        float hre[2], him[2];
#pragma unroll
        for (int hf = 0; hf < 2; ++hf) { const int g = hf * 8 + wave;
            if (cid >= NPCH) { const size_t o = (((size_t)layer * 32 + (cid - NPCH)) * 16 + g) * 64 + lane; hre[hf] = gp(a, I_SSR)[o]; him[hf] = gp(a, I_SSI)[o]; }
            else if (OUT && (cid & 63) != 0) { const f32x2v hv = ST[((size_t)(cid - 1) * 16 + g) * 64 + lane]; hre[hf] = hv.x; him[hf] = hv.y; }
            else { hre[hf] = 0.f; him[hf] = 0.f; } }
        v4u unext = *(const v4u*)(proj + (size_t)r_ut * D_IN + CU + c8);
#pragma unroll 1
        for (int tt = 0; tt < 4; ++tt) {
            *(LAS v4u*)(UT + r_ut * S5_US + c8) = unext;
            if (tt < 3) unext = *(const v4u*)(proj + (size_t)((tt + 1) * 16 + r_ut) * D_IN + CU + c8);
            BSYNC();
#pragma unroll
            for (int hf = 0; hf < 2; ++hf) {
                const int g = hf * 8 + wave;
                {
                    const bf16x8 A = ((fq < 2) == (hf == 0)) ? *(const LAS bf16x8*)(UT + fr * S5_US + g * 16 + (fq & 1) * 8) : zero8;
                    f32x4 cc[8];
#pragma unroll
                    for (int nt = 0; nt < 8; ++nt) { cc[nt] = (f32x4){0.f, 0.f, 0.f, 0.f}; cc[nt] = MFMA16(A, BBr[nt], cc[nt]); }
                    __builtin_amdgcn_sched_barrier(0); asm volatile("s_nop 7\n\ts_nop 7\n\ts_nop 7" ::: "memory"); __builtin_amdgcn_sched_barrier(0);
#pragma unroll
                    for (int nt = 0; nt < 8; ++nt)
#pragma unroll
                        for (int j = 0; j < 4; ++j) BUT[(4 * fq + j) * S5_BS + 16 * nt + fr] = cc[nt][j];
                }
                BSYNC();
                {
                    float hr = hre[hf], hi = him[hf]; const float ar = are[hf], ai = aim[hf];
#pragma unroll
                    for (int th = 0; th < 4; ++th) { f32x2v bv[4];
#pragma unroll
                        for (int t = 0; t < 4; ++t) bv[t] = *(const LAS f32x2v*)(BUT + (4 * th + t) * S5_BS + 2 * lane);
#pragma unroll
                        for (int t = 0; t < 4; ++t) { const float nr = ar * hr - ai * hi + bv[t].x, ni = ar * hi + ai * hr + bv[t].y; hr = nr; hi = ni;
                            if (OUT) *(LAS unsigned*)(HT + (4 * th + t) * S5_HS + 2 * lane) = pk2(hr, hi); } }
                    hre[hf] = hr; him[hf] = hi;
                }
                BSYNC();
                if (OUT) {
                    f32x4 y = {0.f, 0.f, 0.f, 0.f};
#pragma unroll
                    for (int kk = 0; kk < 4; ++kk) { const bf16x8 A = *(const LAS bf16x8*)(HT + fr * S5_HS + 32 * kk + 8 * fq); y = MFMA16(A, CCr[hf][kk], y); }
                    const int ch = g * 16 + fr;
#pragma unroll
                    for (int j = 0; j < 4; ++j) { const int tok = 4 * fq + j; const float uu = bf2f(UT[tok * S5_US + ch]); const float z = gelu_tanh(y[j] + dd[hf] * uu);
                        ZT[tok * S5_US + ch] = f2bf(z); ZF[tok * 256 + ch] = z; }
                }
            }
            if (OUT) {
                BSYNC();
#pragma unroll
                for (int i = 0; i < 2; ++i) { const int nt = 2 * wave + i; f32x4 p = {0.f, 0.f, 0.f, 0.f};
#pragma unroll
                    for (int kk = 0; kk < 8; ++kk) { const bf16x8 A = *(const LAS bf16x8*)(ZT + fr * S5_US + 32 * kk + 8 * fq); p = MFMA16(A, WGr[i][kk], p); }
                    const int n = 16 * nt + fr;
#pragma unroll
                    for (int j = 0; j < 4; ++j) { const int tok = 4 * fq + j; ZF[tok * 256 + n] = ZF[tok * 256 + n] * sigm(p[j] + bgv[i]); } }
                BSYNC();
                { const f32x4 v0 = *(const LAS f32x4*)(ZF + r_ut * 256 + c8), v1 = *(const LAS f32x4*)(ZF + r_ut * 256 + c8 + 4);
                  float s = (v0.x * v0.x + v0.y * v0.y) + (v0.z * v0.z + v0.w * v0.w) + (v1.x * v1.x + v1.y * v1.y) + (v1.z * v1.z + v1.w * v1.w);
                  s += __shfl_xor(s, 1); s += __shfl_xor(s, 2); s += __shfl_xor(s, 4); s += __shfl_xor(s, 8); s += __shfl_xor(s, 16);
                  const float rs = __builtin_amdgcn_rsqf(s * (1.0f / 256.0f) + EPS); const f32x4 nw0 = *(const f32x4*)(gp(a, I_S5N) + layer * DB + c8), nw1 = *(const f32x4*)(gp(a, I_S5N) + layer * DB + c8 + 4);
                  v4u o; o.x = pk2(v0.x * rs * nw0.x, v0.y * rs * nw0.y); o.y = pk2(v0.z * rs * nw0.z, v0.w * rs * nw0.w); o.z = pk2(v1.x * rs * nw1.x, v1.y * rs * nw1.y); o.w = pk2(v1.z * rs * nw1.z, v1.w * rs * nw1.w);
                  *(v4u*)((bf16*)(ws + WS_MIX) + ((size_t)cid * 64 + tt * 16 + r_ut) * DM + DA + c8) = o; }
            }
            BSYNC();
        }
#pragma unroll
        for (int hf = 0; hf < 2; ++hf) { const int g = hf * 8 + wave;
            if (OUT) { if (cid >= NPCH) { const size_t o = (((size_t)layer * 32 + (cid - NPCH)) * 16 + g) * 64 + lane; gout(a)[O_SRS + o] = hre[hf]; gout(a)[O_SIS + o] = him[hf]; }
                       else if ((cid & 63) == 63) { const size_t o = (((size_t)layer * 4 + (cid >> 6)) * 16 + g) * 64 + lane; gout(a)[O_SRP + o] = hre[hf]; gout(a)[O_SIP + o] = him[hf]; } }
            else ST[((size_t)cid * 16 + g) * 64 + lane] = (f32x2v){hre[hf], him[hf]}; }
    }
    __syncthreads();
}

constexpr int LR_XS = 392, LR_AS = 388;
constexpr int LR_XC = 0, LR_AL = 25088, LR_BL = 74752;
template <bool OUT>
__device__ __forceinline__ void lru_phase(const Args& a, int layer, LAS unsigned char* lds, int tid, int lane, int wave, int NU) {
    const int fr = lane & 15, fq = lane >> 4;
    unsigned char* ws = gws(a); const unsigned char* sm = ws + WS_SMALL;
    f32x2v* ST = (f32x2v*)(ws + WS_LRUST);
    LAS bf16* XC = (LAS bf16*)(lds + LR_XC); LAS float* AL = (LAS float*)(lds + LR_AL); LAS float* BL = (LAS float*)(lds + LR_BL);
    const bool act = tid < DC; const int c = act ? tid : 0;
    const float cw0 = gp(a, I_LCW)[(layer * 4 + 0) * DC + c], cw1 = gp(a, I_LCW)[(layer * 4 + 1) * DC + c], cw2 = gp(a, I_LCW)[(layer * 4 + 2) * DC + c], cw3 = gp(a, I_LCW)[(layer * 4 + 3) * DC + c];
    const float cb = gp(a, I_LCB)[layer * DC + c];
    bf16x8 BA0[3], BA1[3], BX0[3], BX1[3]; float bav[3], bxv[3], spv[3];
#pragma unroll
    for (int i = 0; i < 3; ++i) { const int ntg = 3 * wave + i, hd = ntg >> 2, jn = (ntg & 3) * 16; const int ch = 16 * ntg + fr;
        const bf16* WA = (const bf16*)(sm + SM_WAT) + ((size_t)(layer * 6 + hd) * 64 + jn + fr) * 64; const bf16* WX = (const bf16*)(sm + SM_WXT) + ((size_t)(layer * 6 + hd) * 64 + jn + fr) * 64;
        BA0[i] = *(const bf16x8*)(WA + 8 * fq); BA1[i] = *(const bf16x8*)(WA + 32 + 8 * fq); BX0[i] = *(const bf16x8*)(WX + 8 * fq); BX1[i] = *(const bf16x8*)(WX + 32 + 8 * fq);
        bav[i] = gp(a, I_LBA)[layer * DC + ch]; bxv[i] = gp(a, I_LBX)[layer * DC + ch]; spv[i] = ((const float*)(sm + SM_SP))[layer * DC + ch]; }
    const int ntok = tid >> 4, c0 = (tid & 15) * 24;
#pragma unroll 1
    for (int k = 0; k * (int)gridDim.x < NU; ++k) {
        const int G_ = (int)gridDim.x, u = k * G_ + (((int)blockIdx.x + G_ - (8 * k) % G_) % G_); if (u >= NU) continue;
        const int cid = OUT ? u : (u / 63) * 64 + (u % 63);
        const bf16* proj = (const bf16*)(ws + WS_PROJ) + (size_t)cid * 64 * D_IN;
        float xm3 = 0.f, xm2 = 0.f, xm1 = 0.f, h = 0.f, P = 1.f;
        if (cid >= NPCH) { const size_t sb = (size_t)layer * 32 + (cid - NPCH); xm3 = gp(a, I_SC)[(sb * 3 + 0) * DC + c]; xm2 = gp(a, I_SC)[(sb * 3 + 1) * DC + c]; xm1 = gp(a, I_SC)[(sb * 3 + 2) * DC + c]; h = gp(a, I_SL)[sb * DC + c]; }
        else if ((cid & 63) != 0) { xm3 = bf2f(proj[-3 * D_IN + CXR + c]); xm2 = bf2f(proj[-2 * D_IN + CXR + c]); xm1 = bf2f(proj[-1 * D_IN + CXR + c]); if (OUT) h = ST[(size_t)(cid - 1) * DC + c].y; }
#pragma unroll 1
        for (int tile = 0; tile < 2; ++tile) {
            const bf16* pr = proj + (size_t)tile * 32 * D_IN;
            bf16 gr[32];
            {   bf16 xr[32];
#pragma unroll
                for (int t = 0; t < 32; ++t) xr[t] = pr[(size_t)t * D_IN + CXR + c];
                if (OUT) {
#pragma unroll
                    for (int t = 0; t < 32; ++t) gr[t] = pr[(size_t)t * D_IN + CGR + c]; }
                if (act) {
#pragma unroll
                    for (int t = 0; t < 32; ++t) { const float x = bf2f(xr[t]); const float xc = cb + cw0 * xm3 + cw1 * xm2 + cw2 * xm1 + cw3 * x; XC[t * LR_XS + c] = f2bf(xc); xm3 = xm2; xm2 = xm1; xm1 = x; } }
            }
            BSYNC();
#pragma unroll
            for (int i = 0; i < 3; ++i) { const int ntg = 3 * wave + i, hd = ntg >> 2; const int ch = 16 * ntg + fr;
#pragma unroll
                for (int mt = 0; mt < 2; ++mt) { const bf16x8 A0 = *(const LAS bf16x8*)(XC + (16 * mt + fr) * LR_XS + hd * 64 + 8 * fq), A1 = *(const LAS bf16x8*)(XC + (16 * mt + fr) * LR_XS + hd * 64 + 32 + 8 * fq);
                    f32x4 r = {0.f, 0.f, 0.f, 0.f}, ii = {0.f, 0.f, 0.f, 0.f};
                    r = MFMA16(A0, BA0[i], r); r = MFMA16(A1, BA1[i], r); ii = MFMA16(A0, BX0[i], ii); ii = MFMA16(A1, BX1[i], ii);
#pragma unroll
                    for (int j = 0; j < 4; ++j) { const int tok = 16 * mt + 4 * fq + j; const float rg = sigm(r[j] + bav[i]), ig = sigm(ii[j] + bxv[i]); const float la = spv[i] * rg; const float av = __expf(la);
                        const float xcv = bf2f(XC[tok * LR_XS + ch]); AL[tok * LR_AS + ch] = av; BL[tok * LR_AS + ch] = __builtin_amdgcn_sqrtf(fmaxf(1.0f - av * av, 0.f)) * ig * xcv; } } }
            BSYNC();
            if (act) {
#pragma unroll
                for (int t = 0; t < 32; ++t) { const float av = AL[t * LR_AS + c]; h = av * h + BL[t * LR_AS + c]; P *= av;
                    if (OUT) BL[t * LR_AS + c] = h * gelu_tanh(bf2f(gr[t])); }
            }
            if (OUT) {
                BSYNC();
                float v[24]; float s = 0.f; const int sub = tid & 15;
#pragma unroll
                for (int q = 0; q < 3; ++q) { const f32x4 x0 = *(const LAS f32x4*)(BL + ntok * LR_AS + 128 * q + 8 * sub), x1 = *(const LAS f32x4*)(BL + ntok * LR_AS + 128 * q + 8 * sub + 4);
                    v[8 * q] = x0.x; v[8 * q + 1] = x0.y; v[8 * q + 2] = x0.z; v[8 * q + 3] = x0.w; v[8 * q + 4] = x1.x; v[8 * q + 5] = x1.y; v[8 * q + 6] = x1.z; v[8 * q + 7] = x1.w;
                    s += ((x0.x * x0.x + x0.y * x0.y) + (x0.z * x0.z + x0.w * x0.w)) + ((x1.x * x1.x + x1.y * x1.y) + (x1.z * x1.z + x1.w * x1.w)); }
                s += __shfl_xor(s, 1); s += __shfl_xor(s, 2); s += __shfl_xor(s, 4); s += __shfl_xor(s, 8);
                const float rs = __builtin_amdgcn_rsqf(s * (1.0f / 384.0f) + EPS);
                bf16* dst = (bf16*)(ws + WS_MIX) + ((size_t)cid * 64 + tile * 32 + ntok) * DM + DA + DB + 8 * sub;
#pragma unroll
                for (int q = 0; q < 3; ++q) { const float* nw = gp(a, I_LNORM) + layer * DC + 128 * q + 8 * sub; const f32x4 n0 = *(const f32x4*)nw, n1 = *(const f32x4*)(nw + 4);
                    v4u o; o.x = pk2(v[8 * q] * rs * n0.x, v[8 * q + 1] * rs * n0.y); o.y = pk2(v[8 * q + 2] * rs * n0.z, v[8 * q + 3] * rs * n0.w);
                    o.z = pk2(v[8 * q + 4] * rs * n1.x, v[8 * q + 5] * rs * n1.y); o.w = pk2(v[8 * q + 6] * rs * n1.z, v[8 * q + 7] * rs * n1.w); *(v4u*)(dst + 128 * q) = o; }
            }
        }
        if (act) {
            if (OUT) {
                float* ho = nullptr; float* co = nullptr;
                if (cid >= NPCH) { const size_t sb = (size_t)layer * 32 + (cid - NPCH); ho = gout(a) + O_LS + sb * DC; co = gout(a) + O_CS + sb * 3 * DC; }
                else if ((cid & 63) == 63) { const size_t sb = (size_t)layer * 4 + (cid >> 6); ho = gout(a) + O_LP + sb * DC; co = gout(a) + O_CP + sb * 3 * DC; }
                if (ho) { ho[c] = h; co[c] = xm3; co[DC + c] = xm2; co[2 * DC + c] = xm1; }
            } else ST[(size_t)cid * DC + c] = (f32x2v){P, h};
        }
        __syncthreads();
    }
}

__device__ __forceinline__ void carry_phase(const Args& a, int layer, int tid) {
    unsigned char* ws = gws(a);
    const int gt = blockIdx.x * NTHREADS + tid, NGT = gridDim.x * NTHREADS;
    for (int i = gt; i < 4 * 6 * 4096; i += NGT) {
        const int b = i / 24576, rem = i % 24576, hh = rem >> 12, e = rem & 4095, d = e >> 6;
        float* HST = (float*)(ws + WS_HST) + ((size_t)(b * 64) * 6 + hh) * 4096 + e; const float* HD = (const float*)(ws + WS_HD) + ((size_t)(b * 64) * 6 + hh) * 64 + d;
        float S = 0.f;
#pragma unroll 21
        for (int cc = 0; cc < 63; ++cc) { S = HD[(size_t)cc * 6 * 64] * S + HST[(size_t)cc * 6 * 4096]; HST[(size_t)cc * 6 * 4096] = S; }
    }
    const int off5 = (NGT >= 4 * 6 * 4096 + 4 * 1024 + 4 * DC) ? 4 * 6 * 4096 : 0, offl = off5 ? off5 + 4 * 1024 : 0;
    for (int i = gt - off5; i < 4 * 1024; i += NGT) { if (i < 0) continue;
        const int b = i >> 10, gp = i & 1023; const f32x2v A = ((const f32x2v*)(ws + WS_SMALL + SM_S5A64))[layer * 1024 + gp];
        f32x2v* ST = (f32x2v*)(ws + WS_S5ST) + (size_t)(b * 64) * 1024 + gp; float hr = 0.f, hi = 0.f;
#pragma unroll 21
        for (int cc = 0; cc < 63; ++cc) { const f32x2v l = ST[(size_t)cc * 1024]; const float nr = A.x * hr - A.y * hi + l.x, ni = A.x * hi + A.y * hr + l.y; hr = nr; hi = ni; ST[(size_t)cc * 1024] = (f32x2v){hr, hi}; }
    }
    for (int i = gt - offl; i < 4 * DC; i += NGT) { if (i < 0) continue;
        const int b = i / DC, c = i % DC; f32x2v* ST = (f32x2v*)(ws + WS_LRUST) + (size_t)(b * 64) * DC + c; float h = 0.f;
#pragma unroll 21
        for (int cc = 0; cc < 63; ++cc) { const f32x2v l = ST[(size_t)cc * DC]; h = l.x * h + l.y; ST[(size_t)cc * DC] = (f32x2v){l.x, h}; }
    }
}

#ifndef MIXSLOW
#define MIXSLOW 0
#endif
#define MSLOW(bit) do { if (MIXSLOW) { asm volatile("s_waitcnt vmcnt(0) lgkmcnt(0)" ::: "memory"); __syncthreads(); const unsigned long long t1_ = __builtin_amdgcn_s_memrealtime(); if (MIXSLOW & (bit)) { const unsigned long long d_ = t1_ - t_m; while (__builtin_amdgcn_s_memrealtime() - t1_ < d_) __builtin_amdgcn_s_sleep(8); } t_m = __builtin_amdgcn_s_memrealtime(); } } while (0)
template <bool OUT>
__device__ __forceinline__ void mixer_phase(int layer, LAS unsigned char* lds, int tid0) {
#ifndef MIXSEL
#define MIXSEL 7
#endif
    unsigned long long t_m = MIXSLOW ? __builtin_amdgcn_s_memrealtime() : 0ull;
    if (MIXSEL & 1) {
        int tid = tid0; LAUNDER_V(tid); const int lane = tid & 63, wave = __builtin_amdgcn_readfirstlane(tid >> 6);
        const int gw = blockIdx.x * NWAVES + wave, NGW = gridDim.x * NWAVES;
        LAS unsigned char* wl = lds + wave * HG_WAVE_BYTES;
        const Args& a = kargs();
        if (OUT) {
            const int hb = ((int)gridDim.x * NWAVES > NCHUNK * 6) ? ((int)gridDim.x * NWAVES - NCHUNK * 6) / NWAVES : 0;
            if ((int)blockIdx.x >= hb) for (int u = ((int)blockIdx.x - hb) * NWAVES + wave; u < NCHUNK * 6; u += ((int)gridDim.x - hb) * NWAVES) hgrn_unit<true>(a, layer, u / 6, u % 6, wl, lane); }
        else     { for (int u = gw; u < 4 * 63 * 6; u += NGW) { const int b = u / 378, rem = u % 378; hgrn_unit<false>(a, layer, b * 64 + rem / 6, rem % 6, wl, lane); } }
    }
    __syncthreads();
    MSLOW(1);
    const int NU = OUT ? NCHUNK : 4 * 63;
    if (MIXSEL & 2) {
        int tid = tid0; LAUNDER_V(tid); const int lane = tid & 63, wave = __builtin_amdgcn_readfirstlane(tid >> 6);
        s5_phase<OUT>(kargs(), layer, lds, tid, lane, wave, NU);
    }
    MSLOW(2);
    if (MIXSEL & 4) {
        int tid = tid0; LAUNDER_V(tid); const int lane = tid & 63, wave = __builtin_amdgcn_readfirstlane(tid >> 6);
        lru_phase<OUT>(kargs(), layer, lds, tid, lane, wave, NU);
    }
    MSLOW(4);
}

__device__ __forceinline__ void final_norm(const Args& a, int lane, int wave) {
    const int gw = blockIdx.x * NWAVES + wave, NGW = gridDim.x * NWAVES;
    const float* SS = (const float*)(gws(a) + WS_SSP) + (size_t)4 * M_TOK * 16; const f32x4* nw = (const f32x4*)gp(a, I_NFIN) + lane;
    const bf16* XB = (const bf16*)(gws(a) + WS_XB);
    f32x4 w[4];
#pragma unroll
    for (int j = 0; j < 4; ++j) w[j] = nw[64 * j];
    for (int m = gw; m < M_TOK; m += NGW) { const float rs = pg8::row_rstd(SS, (size_t)m); f32x4* xr = (f32x4*)(gout(a) + (size_t)m * DM) + lane; const v2u* xb = (const v2u*)(XB + (size_t)m * DM) + lane;
#pragma unroll
        for (int j = 0; j < 4; ++j) { const v2u b = xb[64 * j]; f32x4 v; v[0] = __uint_as_float(b.x << 16); v[1] = __uint_as_float(b.x & 0xffff0000u); v[2] = __uint_as_float(b.y << 16); v[3] = __uint_as_float(b.y & 0xffff0000u);
            v = v * rs * w[j]; __builtin_nontemporal_store(v, xr + 64 * j); } }
}

#ifndef PHSEL
#define PHSEL 0xFF
#endif
#ifndef MK_MULTI
#define MK_MULTI 0
#endif
struct KArgs { Args a; int ph_lo, ph_hi; };
__global__ void __launch_bounds__(NTHREADS, 2) fwd_megakernel(KArgs ka) {
    extern __shared__ __attribute__((aligned(16))) unsigned char lds_raw[];
    LAS unsigned char* lds = (LAS unsigned char*)lds_raw;
    const int tid = threadIdx.x, lane = tid & 63, wave = __builtin_amdgcn_readfirstlane(tid >> 6);
    unsigned char* ws = ka.a.ws; float* const out = ka.a.out; unsigned char* const ws_early = ws;
    const Args& a = ka.a;
    float* SS = (float*)(ws + WS_SSP);
    bf16* XB = (bf16*)(ws + WS_XB); bf16* PROJ = (bf16*)(ws + WS_PROJ); bf16* MIX = (bf16*)(ws + WS_MIX); bf16* HID = (bf16*)(ws + WS_HID);
    int ph = 0;
#if MK_MULTI
#define SEAM() do { ++ph; } while (0)
#define RUN(b) (((PHSEL) >> (b)) & 1) && (ph >= ka.ph_lo && ph < ka.ph_hi)
#else
    cg::grid_group grid = cg::this_grid();
    volatile LAS unsigned* xb_st = (volatile LAS unsigned*)(lds + XB_LDS_OFF);
    if (threadIdx.x < 2) xb_st[threadIdx.x] = 0u;
    __syncthreads();
    const XcdBarrier xbar = xcd_barrier_post((unsigned*)(ws_early + WS_CTL + 16384), xb_st);
#define SEAM() do { if (ka.ph_hi < 0) grid.sync(); xcd_barrier(xbar); ++ph; } while (0)
#define RUN(b) ((((PHSEL) >> (b)) & 1) != 0)
#endif
#ifndef STOP_AFTER
#define STOP_AFTER 999
#endif
#ifndef DUMP_OFF
#define DUMP_OFF WS_MIX
#endif
#ifndef DUMP_F32
#define DUMP_F32 0
#endif
#define PROBE() do { if (ph == STOP_AFTER) { if (DUMP_F32 == 2) { const bf16* src = (const bf16*)(ws + WS_PROJ); for (size_t i = (size_t)blockIdx.x * NTHREADS + tid; i < (size_t)M_TOK * 256; i += (size_t)gridDim.x * NTHREADS) out[i] = bf2f(src[(i >> 8) * D_IN + CU + (i & 255)]); } else if (DUMP_F32) { const float* src = (const float*)(ws + DUMP_OFF); for (size_t i = (size_t)blockIdx.x * NTHREADS + tid; i < (size_t)7602176; i += (size_t)gridDim.x * NTHREADS) out[i] = src[i]; } \
    else { const bf16* src = (const bf16*)(ws + DUMP_OFF); for (size_t i = (size_t)blockIdx.x * NTHREADS + tid; i < (size_t)M_TOK * DM; i += (size_t)gridDim.x * NTHREADS) out[i] = bf2f(src[i]); } return; } } while (0)
#define IDLE_CONVERT(nwg_, lay_, part_) do { const int rem_ = (nwg_) % (int)gridDim.x; if ((int)blockIdx.x >= rem_) {     int t2 = tid; LAUNDER_V(t2); const int w2 = __builtin_amdgcn_readfirstlane(t2 >> 6); \
        convert_weights(kargs(), (lay_), lds, t2 & 63, w2, ((int)blockIdx.x - rem_) * NWAVES + w2, ((int)gridDim.x - rem_) * NWAVES, (part_)); } } while (0)
#ifndef SLOWMASK
#define SLOWMASK 0
#endif
    unsigned long long t_ph = SLOWMASK ? __builtin_amdgcn_s_memrealtime() : 0ull;
#define SLOW(bit) do { if (SLOWMASK) { const unsigned long long t1_ = __builtin_amdgcn_s_memrealtime(); if (SLOWMASK & (bit)) { const unsigned long long d_ = t1_ - t_ph; while (__builtin_amdgcn_s_memrealtime() - t1_ < d_) __builtin_amdgcn_s_sleep(8); } t_ph = __builtin_amdgcn_s_memrealtime(); } } while (0)
    if (RUN(0)) { int t3 = tid; LAUNDER_V(t3); p0_prologue(kargs(), lds, t3, t3 & 63, __builtin_amdgcn_readfirstlane(t3 >> 6)); if (blockIdx.x == 0 && tid < 38) ((unsigned long long*)(ws + WS_TAB))[tid] = (tid < 36) ? (unsigned long long)ka.a.in[tid] : (tid == 36 ? (unsigned long long)ka.a.out : (unsigned long long)ka.a.ws); }
    SEAM(); PROBE(); SLOW(1);
#pragma unroll 1
    for (int l = 0; l < 2; ++l) {
        if (RUN(1)) { pg8::Gemm g{XB, (const bf16*)(ws + WS_WIN) + (size_t)l * D_IN * DM, M_TOK, D_IN, DM}; pg8::StaticOrder S; S.init(M_TOK, D_IN, gridDim.x, blockIdx.x);
            pg8::EpiProj E{PROJ, D_IN, SS + (size_t)(2 * l) * M_TOK * 16};
            pg8::gemm_phase<pg8::EpiProj, pg8::StaticOrder, true, true>(lds, g, S, E);
            IDLE_CONVERT(72 * 10, l, 1); }
        SEAM(); PROBE(); SLOW(2);
        if (RUN(2)) mixer_phase<false>(l, lds, tid);
        SEAM(); PROBE(); SLOW(4);
        if (RUN(3)) { int t3 = tid; LAUNDER_V(t3); carry_phase(kargs(), l, t3); }
        SEAM(); PROBE(); SLOW(4);
        if (RUN(4)) mixer_phase<true>(l, lds, tid);
        SEAM(); PROBE(); SLOW(4);
        if (RUN(5)) { pg8::Gemm g{MIX, (const bf16*)(ws + WS_WOUT) + (size_t)l * DM * DM, M_TOK, DM, DM}; pg8::StaticOrder S; S.init(M_TOK, DM, gridDim.x, blockIdx.x);
            pg8::EpiRes E{XB, SS + (size_t)(2 * l + 1) * M_TOK * 16};
            pg8::gemm_phase<pg8::EpiRes, pg8::StaticOrder, true, true>(lds, g, S, E);
            IDLE_CONVERT(72 * 4, l, 2); IDLE_CONVERT(72 * 4, l, 3); if (l == 0) IDLE_CONVERT(72 * 4, 1, 0); }
        SEAM(); PROBE(); SLOW(8);
        {
            const int G_ = (int)gridDim.x, total = 72 * 22, full = (total / G_) * G_, c0 = total - full;
#define Wgu ((const bf16*)(ws + WS_WGU) + (size_t)l * 2 * D_FF * DM)
#define Wdn ((const bf16*)(ws + WS_WDN) + (size_t)l * DM * D_FF)
            const int nlow = (G_ == 256) ? 32 : 0, t_lo = G_ + 3 * nlow;
#pragma unroll 1
            for (int step = 0; step < 2; ++step) {
                if (step == 1 && RUN(6)) { pg8::Gemm g{HID, Wdn, M_TOK, DM, D_FF}; pg8::SampleOrder S; S.c0 = 0; S.c = (nlow ? (int)blockIdx.x : -1);
                    pg8::EpiRes E{XB, SS + (size_t)(2 * l + 2) * M_TOK * 16};
                    pg8::gemm_phase<pg8::EpiRes, pg8::SampleOrder, true, true>(lds, g, S, E); }
                if (RUN(6)) { pg8::Gemm g{XB, Wgu, M_TOK, 2 * D_FF, DM}; pg8::GuOrder S; S.init(M_PROMPT, 2 * D_FF, G_, blockIdx.x); S.npre = 8 * 22;
                    if (step == 0) { S.lo = 0; S.hi = G_; }
                    else if ((int)blockIdx.x < nlow) { S.G = nlow; S.lo = G_; S.hi = t_lo; }
                    else { S.G = G_ - nlow; S.c = (int)blockIdx.x - nlow; S.lo = t_lo; S.hi = total; }
                    pg8::EpiGateUp E{HID, D_FF, SS + (size_t)(2 * l + 1) * M_TOK * 16};
                    pg8::gemm_phase<pg8::EpiGateUp, pg8::GuOrder, true, true>(lds, g, S, E); }
                if (step == 0) xcd_barrier(xbar);
            }
            if (!nlow && RUN(6)) {
                xcd_barrier(xbar);
                pg8::Gemm g{HID, Wdn, M_TOK, DM, D_FF}; pg8::SampleOrder S; S.c0 = 0; S.c = blockIdx.x;
                pg8::EpiRes E{XB, SS + (size_t)(2 * l + 2) * M_TOK * 16};
                pg8::gemm_phase<pg8::EpiRes, pg8::SampleOrder, true, true>(lds, g, S, E); }
            SEAM(); PROBE(); SLOW(16);
            if (RUN(7)) { pg8::Gemm g{HID, Wdn, M_PROMPT, DM, D_FF}; pg8::StaticOrder S; S.init(M_PROMPT, DM, G_, blockIdx.x);
                pg8::EpiRes E{XB, SS + (size_t)(2 * l + 2) * M_TOK * 16};
                pg8::gemm_phase<pg8::EpiRes, pg8::StaticOrder, true, true>(lds, g, S, E); }
        }
        SEAM(); PROBE(); SLOW(32);
    }
    if (RUN(3)) { int t3 = tid; LAUNDER_V(t3); final_norm(kargs(), t3 & 63, __builtin_amdgcn_readfirstlane(t3 >> 6)); }
}
constexpr int N_PHASES = 1 + 2 * 7 + 1;

extern "C" void kernel_launch(void* const* d_in, const int* in_sizes, int n_in, void* d_out, int out_size, void* d_ws, size_t ws_size, hipStream_t stream) {
    static int grid = 0;
    if (grid == 0) {
        if (n_in != 36 || in_sizes[0] != M_PROMPT * DM || (size_t)out_size != O_END || ws_size < WS_END) {
            fprintf(stderr, "kernel_launch: unexpected shapes: n_in %d in0 %d out %d ws %zu\n", n_in, n_in > 0 ? in_sizes[0] : -1, out_size, ws_size); }
        int dev = 0, cus = 0, per_cu = 0;
        hipGetDevice(&dev); hipDeviceGetAttribute(&cus, hipDeviceAttributeMultiprocessorCount, dev);
        if (hipFuncSetAttribute((const void*)fwd_megakernel, hipFuncAttributeMaxDynamicSharedMemorySize, LDS_BYTES) != hipSuccess) { fprintf(stderr, "kernel_launch: hipFuncSetAttribute failed\n"); grid = -1; return; }
        if (hipOccupancyMaxActiveBlocksPerMultiprocessor(&per_cu, (const void*)fwd_megakernel, NTHREADS, LDS_BYTES) != hipSuccess || per_cu < 1) { fprintf(stderr, "kernel_launch: occupancy query failed (%d)\n", per_cu); (void)hipGetLastError(); per_cu = 1; }
        grid = cus * (per_cu > 1 ? 1 : per_cu);
        fprintf(stderr, "kernel_launch: grid %d (cus %d, per_cu %d)\n", grid, cus, per_cu);
    }
    if (grid < 0) return;
    (void)hipMemsetAsync((char*)d_ws + WS_CTL, 0, 65536, stream);
    KArgs ka{};
    for (int i = 0; i < 36; ++i) ka.a.in[i] = (const float*)d_in[i];
    ka.a.out = (float*)d_out; ka.a.ws = (unsigned char*)d_ws;
#if MK_MULTI
    for (int p = 0; p < N_PHASES; ++p) { ka.ph_lo = p; ka.ph_hi = p + 1; hipLaunchKernelGGL(fwd_megakernel, dim3(grid), dim3(NTHREADS), LDS_BYTES, stream, ka); }
#else
    ka.ph_lo = 0; ka.ph_hi = N_PHASES;
    void* args[] = {&ka};
    hipError_t e = hipLaunchCooperativeKernel((const void*)fwd_megakernel, dim3(grid), dim3(NTHREADS), args, LDS_BYTES, stream);
    if (e != hipSuccess) fprintf(stderr, "cooperative launch failed: %s (grid %d)\n", hipGetErrorString(e), grid);
#endif
}
```

```cpp
#include <hip/hip_runtime.h>
#include <hip/hip_cooperative_groups.h>
#include <cstdio>
#include <cstdint>
namespace pg8 {
#define PG8_LAS __attribute__((address_space(3)))
typedef unsigned short bf16_t;
typedef short bf16x8 __attribute__((ext_vector_type(8)));
typedef float f32x4 __attribute__((ext_vector_type(4)));
typedef unsigned u32x4 __attribute__((ext_vector_type(4)));
constexpr int BM = 256, BK = 64, HALF = 128, HTB = HALF * BK * 2  , STAGE_BYTES = 8 * HTB, NXCD = 8, WGM = 8;

__host__ __device__ __forceinline__ int lds_byte(int r, int c) { const int st = (r >> 4) * 2 + (c >> 5), rr = r & 15, cc = c & 31, ob = rr * 64 + cc * 2; return st * 1024 + (ob ^ (((ob >> 9) & 1) << 5)); }
__host__ __device__ __forceinline__ void stage_rc(int b, int& R, int& C) { const int st = b / 1024, sb = b % 1024, swz = sb ^ (((sb >> 9) & 1) << 5); R = (st >> 1) * 16 + swz / 64; C = (st & 1) * 32 + (swz % 64) / 2; }
__host__ __device__ __forceinline__ int perm32(int rho) { const int n = rho >> 4, i = rho & 15; return 8 * (i >> 2) + 4 * n + (i & 3); }

struct Unit { int pm, pn; };
struct Gemm { const bf16_t* A; const bf16_t* Bt; int M, N, K; };

struct StaticOrder {
    int nM, nN, nwg, G, c;
    __host__ __device__ void init(int M, int N, int G_, int c_) { nM = M / BM; nN = N / BM; nwg = nM * nN; G = G_; c = c_; }
    __host__ __device__ bool next(int i, Unit& u) const {
        const long L = (long)i * G + c; if (L >= nwg) return false;
        int wgid = (int)L; { const int q = nwg / NXCD, r = nwg % NXCD, xcd = wgid % NXCD, off = wgid / NXCD; wgid = (xcd < r ? xcd * (q + 1) : r * (q + 1) + (xcd - r) * q) + off; }
        const int nig = WGM * nN, gid = wgid / nig, fm = gid * WGM, gsz = (nM - fm) < WGM ? (nM - fm) : WGM;
        u.pm = fm + ((wgid % nig) % gsz); u.pn = (wgid % nig) / gsz; return true;
    }
    __device__ __forceinline__ void a_ready(const Unit&) const {}
    __device__ __forceinline__ void done(const Unit&) const {}
};

__device__ __forceinline__ unsigned cvt_pk_bf16(float lo, float hi) { unsigned r; asm volatile("v_cvt_pk_bf16_f32 %0, %1, %2" : "=v"(r) : "v"(lo), "v"(hi)); return r; }
typedef float f32x2 __attribute__((ext_vector_type(2)));
constexpr float RMS_EPS = 1e-6f;
__device__ __forceinline__ float row_rstd(const float* ssp, size_t row) {
    const f32x4* p = (const f32x4*)(ssp + row * 16); const f32x4 a = p[0], b = p[1], c = p[2], d = p[3];
    const float s = (((a[0] + a[1]) + (a[2] + a[3])) + ((b[0] + b[1]) + (b[2] + b[3]))) + (((c[0] + c[1]) + (c[2] + c[3])) + ((d[0] + d[1]) + (d[2] + d[3])));
    return __builtin_amdgcn_rsqf(s * (1.0f / 1024.0f) + RMS_EPS);
}
__device__ __forceinline__ float row_rstd_q(const float* ssp, size_t row, int fq) {
    const f32x4 a = *(const f32x4*)(ssp + row * 16 + 4 * fq);
    float s = (a[0] + a[1]) + (a[2] + a[3]);
    s += __shfl_xor(s, 16); s += __shfl_xor(s, 32);
    return __builtin_amdgcn_rsqf(s * (1.0f / 1024.0f) + RMS_EPS);
}
__device__ __forceinline__ float fast_sigmoid(float x) { return __builtin_amdgcn_rcpf(1.0f + __builtin_amdgcn_exp2f(-1.4426950408889634f * x)); }
struct EpiProj {
    static constexpr bool PERM = true, AFTER_DRAIN = false;
    bf16_t* O; int ldc; const float* ss;
    __device__ __forceinline__ void operator()(const f32x4 (&acc)[2][2][4][2], const Unit& u, int wr, int wc, int fr, int fq) const {
        const int row0 = u.pm * BM + wr * 64 + fr, col0 = u.pn * BM + wc * 32 + 8 * fq;
#pragma unroll
        for (int ai = 0; ai < 2; ++ai)
#pragma unroll
            for (int m = 0; m < 4; ++m) {
                const int row = row0 + ai * HALF + m * 16;
                const float rs = row_rstd_q(ss, (size_t)row, fq);
                bf16_t* rowp = O + (size_t)row * ldc + col0;
#pragma unroll
                for (int bj = 0; bj < 2; ++bj) { const f32x4 v0 = acc[ai][bj][m][0] * rs, v1 = acc[ai][bj][m][1] * rs;
                    u32x4 w; w.x = cvt_pk_bf16(v0[0], v0[1]); w.y = cvt_pk_bf16(v0[2], v0[3]); w.z = cvt_pk_bf16(v1[0], v1[1]); w.w = cvt_pk_bf16(v1[2], v1[3]);
                    *(u32x4*)(rowp + bj * HALF) = w; }
            }
    }
};
struct EpiGateUp {
    static constexpr bool PERM = true, AFTER_DRAIN = false;
    bf16_t* O; int ldc; const float* ss;
    __device__ __forceinline__ void operator()(const f32x4 (&acc)[2][2][4][2], const Unit& u, int wr, int wc, int fr, int fq) const {
        const int row0 = u.pm * BM + wr * 64 + fr, col0 = u.pn * HALF + wc * 32 + 8 * fq;
#pragma unroll
        for (int ai = 0; ai < 2; ++ai)
#pragma unroll
            for (int m = 0; m < 4; ++m) {
                const int row = row0 + ai * HALF + m * 16;
                const float rs = row_rstd_q(ss, (size_t)row, fq);
                float hv[8];
#pragma unroll
                for (int n = 0; n < 2; ++n)
#pragma unroll
                    for (int e = 0; e < 4; ++e) { const float g = acc[ai][0][m][n][e] * rs, up = acc[ai][1][m][n][e] * rs; hv[n * 4 + e] = g * fast_sigmoid(g) * up; }
                u32x4 w; w.x = cvt_pk_bf16(hv[0], hv[1]); w.y = cvt_pk_bf16(hv[2], hv[3]); w.z = cvt_pk_bf16(hv[4], hv[5]); w.w = cvt_pk_bf16(hv[6], hv[7]);
                *(u32x4*)(O + (size_t)row * ldc + col0) = w;
            }
    }
};
struct EpiRes {
    static constexpr bool PERM = true, AFTER_DRAIN = false;
    bf16_t* xb; float* ssn;
    __device__ __forceinline__ void operator()(const f32x4 (&acc)[2][2][4][2], const Unit& u, int wr, int wc, int fr, int fq) const {
        const int col0 = u.pn * BM + wc * 32 + 8 * fq;
#pragma unroll
        for (int ai = 0; ai < 2; ++ai)
#pragma unroll
            for (int m = 0; m < 4; ++m) {
                const size_t row = (size_t)u.pm * BM + ai * HALF + wr * 64 + m * 16 + fr;
                float ssq = 0.f;
#pragma unroll
                for (int bj = 0; bj < 2; ++bj) { bf16_t* p = xb + row * 1024 + col0 + bj * HALF;
                    const u32x4 b = *(const u32x4*)p; const f32x4 a0 = acc[ai][bj][m][0], a1 = acc[ai][bj][m][1];
                    float o[8];
                    o[0] = __uint_as_float(b.x << 16) + a0[0]; o[1] = __uint_as_float(b.x & 0xffff0000u) + a0[1]; o[2] = __uint_as_float(b.y << 16) + a0[2]; o[3] = __uint_as_float(b.y & 0xffff0000u) + a0[3];
                    o[4] = __uint_as_float(b.z << 16) + a1[0]; o[5] = __uint_as_float(b.z & 0xffff0000u) + a1[1]; o[6] = __uint_as_float(b.w << 16) + a1[2]; o[7] = __uint_as_float(b.w & 0xffff0000u) + a1[3];
                    ssq += ((o[0] * o[0] + o[1] * o[1]) + (o[2] * o[2] + o[3] * o[3])) + ((o[4] * o[4] + o[5] * o[5]) + (o[6] * o[6] + o[7] * o[7]));
                    u32x4 w; w.x = cvt_pk_bf16(o[0], o[1]); w.y = cvt_pk_bf16(o[2], o[3]); w.z = cvt_pk_bf16(o[4], o[5]); w.w = cvt_pk_bf16(o[6], o[7]); *(u32x4*)p = w; }
                ssq += __shfl_xor(ssq, 16); ssq += __shfl_xor(ssq, 32);
                if (fq == 0) ssn[row * 16 + u.pn * 4 + wc] = ssq;
            }
    }
};

struct GuOrder : StaticOrder {
    int npre, lo, hi;
    __device__ __forceinline__ bool next(int i, Unit& u) const {
        const long L = (long)lo + (long)i * G + c; if (L >= hi) return false;
        if (L < npre) { u.pm = 64 + (int)L / nN; u.pn = (int)L % nN; return true; }
        int wgid = (int)(L - npre); { const int q = nwg / NXCD, r = nwg % NXCD, xcd = wgid % NXCD, off = wgid / NXCD; wgid = (xcd < r ? xcd * (q + 1) : r * (q + 1) + (xcd - r) * q) + off; }
        const int nig = WGM * nN, gid = wgid / nig, fm = gid * WGM, gsz = (nM - fm) < WGM ? (nM - fm) : WGM;
        u.pm = fm + ((wgid % nig) % gsz); u.pn = (wgid % nig) / gsz; return true;
    }
    __device__ __forceinline__ void a_ready(const Unit&) const {}
    __device__ __forceinline__ void done(const Unit&) const {}
};
struct SampleOrder {
    int c0, c;
    __device__ __forceinline__ bool next(int i, Unit& u) const { if (i != 0 || c < c0 || c >= c0 + 32) return false; u.pm = 64 + (c - c0) / 4; u.pn = (c - c0) % 4; return true; }
    __device__ __forceinline__ void a_ready(const Unit&) const {}
    __device__ __forceinline__ void done(const Unit&) const {}
};
template <class Epi, class Sched, bool ALIGN_EPI = false, bool SP2 = false>
__device__ __forceinline__ void gemm_phase(PG8_LAS unsigned char* lds, const Gemm g, const Sched& S, const Epi& E) {
    int tid_ = threadIdx.x; asm volatile("" : "+v"(tid_));
    const int tid = tid_, wid = __builtin_amdgcn_readfirstlane(tid >> 6), lane = tid & 63, wr = wid >> 2, wc = wid & 3, fr = lane & 15, fq = lane >> 4;
    const int K = g.K, nt = K / BK;
    unsigned voffA[2], voffB[2];
#pragma unroll
    for (int i = 0; i < 2; ++i) { int R, C; stage_rc(tid * 16 + i * 8192, R, C); const int Rb = Epi::PERM ? ((R & ~31) + perm32(R & 31)) : R;
        voffA[i] = (unsigned)(R * K + C) * 2u; voffB[i] = (unsigned)(Rb * K + C) * 2u; }
    const size_t kstep = (size_t)(BK * 2);
    const size_t hstep = (size_t)HALF * K * 2;
    const size_t tstep = 2 * hstep;
    const unsigned ldsw = (unsigned)wid * 1024u;
    const int aoff = lds_byte(wr * 64 + fr, fq * 8), boff = lds_byte(wc * 32 + fr, fq * 8);
#define PG8_SA(b, h) (((b) * 2 + (h)) * HTB)
#define PG8_SB(b, h) ((4 + (b) * 2 + (h)) * HTB)
#define PG8_STAGE(bufoff, gbase, voff) do { _Pragma("unroll") for (int _i = 0; _i < 2; ++_i) \
        __builtin_amdgcn_global_load_lds((const unsigned*)((const char*)(gbase) + (voff)[_i]), (PG8_LAS unsigned*)(lds + (bufoff) + ldsw + _i * 8192), 16, 0, 0); } while (0)
#define PG8_LDA(dst, b, h) do { _Pragma("unroll") for (int m = 0; m < 4; ++m) _Pragma("unroll") for (int k = 0; k < 2; ++k) dst[m][k] = *(const PG8_LAS bf16x8*)(lds + PG8_SA(b, h) + aoff + m * 2048 + k * 1024); } while (0)
#define PG8_LDB(dst, b, h) do { _Pragma("unroll") for (int n = 0; n < 2; ++n) _Pragma("unroll") for (int k = 0; k < 2; ++k) dst[n][k] = *(const PG8_LAS bf16x8*)(lds + PG8_SB(b, h) + boff + n * 2048 + k * 1024); } while (0)
#define PG8_MMA(ai, bj, At, Bt) do { __builtin_amdgcn_s_setprio(1); _Pragma("unroll") for (int m = 0; m < 4; ++m) _Pragma("unroll") for (int n = 0; n < 2; ++n) _Pragma("unroll") for (int k = 0; k < 2; ++k) \
        acc[ai][bj][m][n] = __builtin_amdgcn_mfma_f32_16x16x32_bf16(Bt[n][k], At[m][k], acc[ai][bj][m][n], 0, 0, 0); __builtin_amdgcn_s_setprio(0); } while (0)
#define PG8_WAIT_V(n) asm volatile("s_waitcnt vmcnt(" #n ")" ::: "memory")
#define PG8_WAIT_L(n) asm volatile("s_waitcnt lgkmcnt(" #n ")" ::: "memory")
#define PG8_BAR __builtin_amdgcn_s_barrier()
#define PG8_SCHED __builtin_amdgcn_sched_barrier(0)
    Unit cur, nxt; int ui = 0;
    if (!S.next(0, cur)) return;
    f32x4 acc[2][2][4][2];
#pragma unroll
    for (int a = 0; a < 2; ++a)
#pragma unroll
        for (int b = 0; b < 2; ++b)
#pragma unroll
            for (int m = 0; m < 4; ++m)
#pragma unroll
                for (int n = 0; n < 2; ++n) acc[a][b][m][n] = (f32x4){0.f, 0.f, 0.f, 0.f};
    bf16x8 At[4][2], B0[2][2], B1[2][2];
    const char* cA = (const char*)g.A + (size_t)cur.pm * tstep; const char* cB = (const char*)g.Bt + (size_t)cur.pn * tstep;
    S.a_ready(cur);
    if constexpr (SP2) {
        PG8_STAGE(PG8_SB(0, 0), cB, voffB); PG8_STAGE(PG8_SB(0, 1), cB + hstep, voffB); PG8_STAGE(PG8_SA(0, 0), cA, voffA); PG8_STAGE(PG8_SA(0, 1), cA + hstep, voffA);
        if (wr == 1) PG8_BAR;
        PG8_WAIT_V(2); PG8_BAR;
        PG8_STAGE(PG8_SB(1, 0), cB + kstep, voffB); PG8_STAGE(PG8_SA(1, 0), cA + kstep, voffA); PG8_STAGE(PG8_SB(1, 1), cB + hstep + kstep, voffB);
        PG8_WAIT_V(6); PG8_BAR;
    } else {
        PG8_STAGE(PG8_SB(0, 0), cB, voffB); PG8_STAGE(PG8_SA(0, 0), cA, voffA); PG8_STAGE(PG8_SB(0, 1), cB + hstep, voffB); PG8_STAGE(PG8_SA(0, 1), cA + hstep, voffA);
        if (wr == 1) PG8_BAR;
        PG8_WAIT_V(4); PG8_BAR;
        PG8_STAGE(PG8_SB(1, 0), cB + kstep, voffB); PG8_STAGE(PG8_SA(1, 0), cA + kstep, voffA); PG8_STAGE(PG8_SB(1, 1), cB + hstep + kstep, voffB);
        PG8_WAIT_V(6); PG8_BAR;
    }
    for (;;) {
        const bool has_next = S.next(ui + 1, nxt);
        const char* nA = has_next ? (const char*)g.A + (size_t)nxt.pm * tstep : cA; const char* nB = has_next ? (const char*)g.Bt + (size_t)nxt.pn * tstep : cB;
        for (int t = 0; t < nt; t += 2) {
            const bool last = (t == nt - 2);
            const char* a1 = cA + (size_t)(t + 1) * kstep;
            const char* a2 = last ? nA : cA + (size_t)(t + 2) * kstep; const char* b2 = last ? nB : cB + (size_t)(t + 2) * kstep;
            const char* a3 = a2 + kstep; const char* b3 = b2 + kstep;
            if (last && has_next) S.a_ready(nxt);
            if constexpr (SP2) {
            PG8_LDB(B0, 0, 0); PG8_LDB(B1, 0, 1); PG8_SCHED; PG8_LDA(At, 0, 0); PG8_STAGE(PG8_SA(1, 1), a1 + hstep, voffA);
            PG8_WAIT_V(8); PG8_WAIT_L(0); PG8_BAR; PG8_MMA(0, 0, At, B0); PG8_MMA(0, 1, At, B1); PG8_BAR; PG8_SCHED;
            PG8_LDA(At, 0, 1); PG8_STAGE(PG8_SB(0, 0), b2, voffB); PG8_STAGE(PG8_SB(0, 1), b2 + hstep, voffB); PG8_STAGE(PG8_SA(0, 0), a2, voffA);
            PG8_WAIT_V(8); PG8_WAIT_L(0); PG8_BAR; PG8_MMA(1, 0, At, B0); PG8_MMA(1, 1, At, B1); PG8_BAR; PG8_SCHED;
            PG8_LDB(B0, 1, 0); PG8_LDB(B1, 1, 1); PG8_SCHED; PG8_LDA(At, 1, 0); PG8_STAGE(PG8_SA(0, 1), a2 + hstep, voffA);
            PG8_WAIT_V(8); PG8_WAIT_L(0); PG8_BAR; PG8_MMA(0, 0, At, B0); PG8_MMA(0, 1, At, B1); PG8_BAR; PG8_SCHED;
            PG8_LDA(At, 1, 1); PG8_STAGE(PG8_SB(1, 0), b3, voffB); PG8_STAGE(PG8_SB(1, 1), b3 + hstep, voffB); PG8_STAGE(PG8_SA(1, 0), a3, voffA);
            PG8_WAIT_V(8); PG8_WAIT_L(0); PG8_BAR; PG8_MMA(1, 0, At, B0); PG8_MMA(1, 1, At, B1); PG8_BAR; PG8_SCHED;
            } else {
            PG8_LDB(B0, 0, 0); PG8_SCHED; PG8_LDA(At, 0, 0); PG8_STAGE(PG8_SA(1, 1), a1 + hstep, voffA);
            PG8_WAIT_L(8); PG8_BAR; PG8_WAIT_L(0); PG8_MMA(0, 0, At, B0); PG8_BAR; PG8_SCHED;
            PG8_LDB(B1, 0, 1); PG8_STAGE(PG8_SB(0, 0), b2, voffB);
            PG8_BAR; PG8_WAIT_L(0); PG8_MMA(0, 1, At, B1); PG8_BAR;
            PG8_LDA(At, 0, 1); PG8_STAGE(PG8_SA(0, 0), a2, voffA);
            PG8_BAR; PG8_WAIT_L(0); PG8_MMA(1, 0, At, B0); PG8_BAR; PG8_SCHED;
            PG8_STAGE(PG8_SB(0, 1), b2 + hstep, voffB);
            PG8_WAIT_V(6); PG8_BAR; PG8_MMA(1, 1, At, B1); PG8_BAR;
            PG8_LDB(B0, 1, 0); PG8_SCHED; PG8_LDA(At, 1, 0); PG8_STAGE(PG8_SA(0, 1), a2 + hstep, voffA);
            PG8_WAIT_L(8); PG8_BAR; PG8_WAIT_L(0); PG8_MMA(0, 0, At, B0); PG8_BAR; PG8_SCHED;
            PG8_LDB(B1, 1, 1); PG8_STAGE(PG8_SB(1, 0), b3, voffB);
            PG8_BAR; PG8_WAIT_L(0); PG8_MMA(0, 1, At, B1); PG8_BAR;
            PG8_LDA(At, 1, 1); PG8_STAGE(PG8_SA(1, 0), a3, voffA);
            PG8_BAR; PG8_WAIT_L(0); PG8_MMA(1, 0, At, B0); PG8_BAR; PG8_SCHED;
            PG8_STAGE(PG8_SB(1, 1), b3 + hstep, voffB);
            PG8_WAIT_V(6); PG8_BAR; PG8_MMA(1, 1, At, B1); PG8_BAR;
            }
        }
        if constexpr (ALIGN_EPI) { if (wr == 0) PG8_BAR; }
        if constexpr (!Epi::AFTER_DRAIN) { E(acc, cur, wr, wc, fr, fq); S.done(cur); }
        if (!has_next) break;
#pragma unroll
        for (int a = 0; a < 2; ++a)
#pragma unroll
            for (int b = 0; b < 2; ++b)
#pragma unroll
                for (int m = 0; m < 4; ++m)
#pragma unroll
                    for (int n = 0; n < 2; ++n) acc[a][b][m][n] = (f32x4){0.f, 0.f, 0.f, 0.f};
        cur = nxt; cA = nA; cB = nB; ++ui;
        if constexpr (ALIGN_EPI) { if (wr == 1) PG8_BAR; }
    }
    PG8_WAIT_V(0);
    if constexpr (!ALIGN_EPI) { if (wr == 0) PG8_BAR; }
    PG8_BAR;
    if constexpr (Epi::AFTER_DRAIN) { E.fused(acc, cur, wr, wc, fr, fq, lds, wid, lane); S.done(cur); }
#undef PG8_SA
#undef PG8_SB
#undef PG8_STAGE
#undef PG8_LDA
#undef PG8_LDB
#undef PG8_MMA
#undef PG8_WAIT_V
#undef PG8_WAIT_L
#undef PG8_BAR
#undef PG8_SCHED
}
}
namespace cg = cooperative_groups;
#define LAS __attribute__((address_space(3)))
typedef unsigned short bf16;
typedef unsigned v4u __attribute__((ext_vector_type(4)));
typedef unsigned v2u __attribute__((ext_vector_type(2)));
typedef float f32x4 __attribute__((ext_vector_type(4)));
typedef float f32x2v __attribute__((ext_vector_type(2)));
typedef short bf16x8 __attribute__((ext_vector_type(8)));
typedef short bf16x4 __attribute__((ext_vector_type(4)));

constexpr int NWAVES = 8, NTHREADS = 512;
constexpr int DM = 1024, M_TOK = 18432, M_PROMPT = 16384, NCHUNK = 288, NPCH = 256;
constexpr int D_IN = 2560, D_FF = 2816, DA = 384, DB = 256, DC = 384;
constexpr int CQ = 0, CF = 384, CI = 768, CG = 1152, CU = 1536, CXR = 1792, CGR = 2176;
constexpr float EPS = 1e-6f;
constexpr size_t O_Y = 0, O_HP = 18874368, O_SRP = O_HP + 196608, O_SIP = O_SRP + 8192, O_LP = O_SIP + 8192, O_CP = O_LP + 3072,
                 O_HS = O_CP + 9216, O_SRS = O_HS + 1572864, O_SIS = O_SRS + 65536, O_LS = O_SIS + 65536, O_CS = O_LS + 24576, O_END = O_CS + 73728;
constexpr size_t MiB = 1u << 20;
constexpr size_t WS_CTL = 0, CTL_ZERO_BYTES = 1 * MiB, WS_SS = 64 * 1024, WS_TAB = 1 * MiB;
constexpr size_t WS_WIN = 2 * MiB, WS_WOUT = 12 * MiB, WS_WGU = 16 * MiB, WS_WDN = 38 * MiB, WS_SMALL = 49 * MiB;
constexpr size_t SM_LBS = 0, SM_S5A = 4096, SM_S5A64 = SM_S5A + 16384, SM_BB = SM_S5A64 + 16384, SM_CC = SM_BB + 131072, SM_WGT = SM_CC + 131072,
                 SM_WAT = SM_WGT + 262144, SM_WXT = SM_WAT + 98304, SM_SP = SM_WXT + 98304, SM_END = SM_SP + 4096;
static_assert(SM_END <= 3 * MiB, "small tables");
constexpr size_t WS_XB = 52 * MiB, WS_PROJ = 88 * MiB, WS_MIX = 178 * MiB, WS_HID = 88 * MiB;
constexpr size_t WS_HST = 214 * MiB, WS_HD = 238 * MiB, WS_S5ST = 239 * MiB, WS_LRUST = 241 * MiB, WS_SSP = 243 * MiB, WS_END = 249 * MiB;
constexpr int LDS_BYTES = 147456, XB_LDS_OFF = 147456 - 256;

struct Args { const float* in[36]; float* out; unsigned char* ws; };
enum { I_XP = 0, I_XS, I_SH, I_SSR, I_SSI, I_SL, I_SC, I_NMIX, I_WIN, I_HLB, I_HNORM, I_S5LR, I_S5LI, I_S5DT, I_S5BR, I_S5BI, I_S5CR, I_S5CI, I_S5D, I_S5WG, I_S5BG, I_S5N,
       I_LCW, I_LCB, I_LWA, I_LBA, I_LWX, I_LBX, I_LLAM, I_LNORM, I_WOUT, I_NFFN, I_WG, I_WU, I_WD, I_NFIN };


__device__ __forceinline__ unsigned long long rfl64(unsigned long long v) { return ((unsigned long long)(unsigned)__builtin_amdgcn_readfirstlane((int)(unsigned)(v >> 32)) << 32) | (unsigned long long)(unsigned)__builtin_amdgcn_readfirstlane((int)(unsigned)v); }
#define GAS __attribute__((address_space(1)))
typedef __attribute__((address_space(4))) const unsigned char KSEG;
__device__ __forceinline__ const Args& kargs() { KSEG* p = (KSEG*)__builtin_amdgcn_kernarg_segment_ptr(); asm volatile("" : "+s"(p)); return *(const Args*)(const void*)p; }
__device__ __forceinline__ const float* gp(const Args& a, int k) { return (const float*)(const GAS float*)a.in[k]; }
__device__ __forceinline__ unsigned char* gws(const Args& a) { return (unsigned char*)(GAS unsigned char*)a.ws; }
__device__ __forceinline__ float* gout(const Args& a) { return (float*)(GAS float*)a.out; }
__device__ __forceinline__ float bf2f(bf16 b) { return __uint_as_float((unsigned)b << 16); }
__device__ __forceinline__ unsigned pk2(float lo, float hi) { return pg8::cvt_pk_bf16(lo, hi); }
__device__ __forceinline__ bf16 f2bf(float f) { return (bf16)(pk2(f, 0.f) & 0xffffu); }
__device__ __forceinline__ float sigm(float x) { return __builtin_amdgcn_rcpf(1.0f + __builtin_amdgcn_exp2f(-1.4426950408889634f * x)); }
__device__ __forceinline__ float gelu_tanh(float x) { const float u = 0.7978845608028654f * (x + 0.044715f * x * x * x); return x * sigm(2.0f * u); }
#define LAUNDER_V(x) asm volatile("" : "+v"(x))
#define BSYNC() asm volatile("s_waitcnt lgkmcnt(0)\n\ts_barrier" ::: "memory")
template <bool NT, class T> __device__ __forceinline__ T ldg(const T* p) { return NT ? __builtin_nontemporal_load(p) : *p; }
#define LDS_WAIT() asm volatile("s_waitcnt lgkmcnt(0)" ::: "memory")
#define WAVE_SYNC() do { asm volatile("s_waitcnt lgkmcnt(0)" ::: "memory"); __builtin_amdgcn_wave_barrier(); } while (0)
#define MFMA16(a, b, c) __builtin_amdgcn_mfma_f32_16x16x32_bf16((a), (b), (c), 0, 0, 0)
__device__ __forceinline__ float wave_sum(float v) {
#pragma unroll
    for (int o = 1; o < 64; o <<= 1) v += __shfl_xor(v, o);
    return v;
}

#define XB_TMO      128
#define XB_XCNT(j)  (256  + 64 * (j))
#define XB_XSUB(j)  (1280 + 64 * (j))
#define XB_XGEN(j)  (2304 + 64 * (j))
#define XB_TOP      3328
#define XB_TOPGEN   3392
#define XCD_BAR_WORDS 3456
#define XB_SPIN_CAP (1u << 18)

__device__ __forceinline__ unsigned xb_ld(unsigned* p)              { return __hip_atomic_load(p, __ATOMIC_RELAXED, __HIP_MEMORY_SCOPE_AGENT); }
__device__ __forceinline__ unsigned xb_add(unsigned* p, unsigned v) { return __hip_atomic_fetch_add(p, v, __ATOMIC_RELAXED, __HIP_MEMORY_SCOPE_AGENT); }
__device__ __forceinline__ unsigned xb_xcc_id() { return (unsigned)__builtin_amdgcn_s_getreg((3 << 11) | 20) & 0xFu; }
#define XB_SPIN(cond, bar) do { unsigned _sp = 0; while (cond) { __builtin_amdgcn_s_sleep(1); \
    if ((++_sp & 255u) == 0u) { if (xb_ld(&(bar)[XB_TMO])) break; if (_sp > XB_SPIN_CAP) { atomicAdd(&(bar)[XB_TMO], 1u); break; } } } } while (0)

struct XcdBarrier {
    unsigned* bar; unsigned x;
    volatile LAS unsigned* st;
};

__device__ __forceinline__ XcdBarrier xcd_barrier_post(unsigned* bar, volatile LAS unsigned* st) {
    XcdBarrier b; b.bar = bar; b.x = xb_xcc_id(); b.st = st;
    if (threadIdx.x == 0) (void)xb_add(&bar[XB_XCNT(b.x)], 1u);
    return b;
}
__device__ __forceinline__ void xcd_barrier_complete(unsigned* bar, unsigned x, unsigned& nloc, unsigned& nx) {
    const unsigned G = gridDim.x * gridDim.y * gridDim.z;
    unsigned sum, cnt, mine, sp = 0u;
    for (;;) {
        sum = 0u; cnt = 0u; mine = 0u;
#pragma unroll
        for (unsigned j = 0; j < 16; ++j) { const unsigned c = xb_ld(&bar[XB_XCNT(j)]); sum += c; cnt += (c > 0u) ? 1u : 0u; mine = (j == x) ? c : mine; }
        if (sum == G) break;
        __builtin_amdgcn_s_sleep(1);
        if ((++sp & 255u) == 0u) { if (xb_ld(&bar[XB_TMO])) break; if (sp > XB_SPIN_CAP) { atomicAdd(&bar[XB_TMO], 1u); break; } }
    }
    nloc = mine > 0u ? mine : 1u; nx = cnt > 0u ? cnt : 1u;
}

__device__ __forceinline__ void xcd_barrier(const XcdBarrier& b) {
    asm volatile("s_waitcnt vmcnt(0)" ::: "memory");
    __syncthreads();
    if (threadIdx.x == 0) {
        unsigned* bar = b.bar;
        __builtin_amdgcn_s_waitcnt(0);
        unsigned nloc = b.st[0], nx = b.st[1];
        if (nloc == 0u) { xcd_barrier_complete(bar, b.x, nloc, nx); b.st[0] = nloc; b.st[1] = nx; }
        const unsigned old = xb_add(&bar[XB_XSUB(b.x)], 1u);
        const unsigned gen = old / nloc;
        if (old + 1u == (gen + 1u) * nloc) {
            __builtin_amdgcn_fence(__ATOMIC_RELEASE, "agent");
            asm volatile("s_waitcnt vmcnt(0)" ::: "memory");
            const unsigned og = xb_add(&bar[XB_TOP], 1u);
            const unsigned tg = og / nx;
            if (og + 1u == (tg + 1u) * nx) xb_add(&bar[XB_TOPGEN], 1u);
            else XB_SPIN(xb_ld(&bar[XB_TOPGEN]) == tg, bar);
            __builtin_amdgcn_fence(__ATOMIC_ACQUIRE, "agent");
            xb_add(&bar[XB_XGEN(b.x)], 1u);
            asm volatile("s_waitcnt vmcnt(0)" ::: "memory");
        } else {
            XB_SPIN(xb_ld(&bar[XB_XGEN(b.x)]) == gen, bar);
            __builtin_amdgcn_fence(__ATOMIC_ACQUIRE, "agent");
            asm volatile("s_waitcnt vmcnt(0)" ::: "memory");
        }
    }
    __syncthreads();
}

__device__ __forceinline__ void p0_transpose_item(const float* W, int K, int N, bf16* WT, int k0, int n0, int drow0, const float* kscale, LAS float* scr, int lane) {
    const int c = lane & 7;
    f32x4 ks0 = {1.f, 1.f, 1.f, 1.f}, ks1 = {1.f, 1.f, 1.f, 1.f};
    if (kscale) { ks0 = *(const f32x4*)(kscale + k0 + 8 * c); ks1 = *(const f32x4*)(kscale + k0 + 8 * c + 4); }
    const float* wp = W + (size_t)(k0 + (lane >> 5)) * N + n0 + (lane & 31);
#pragma unroll
    for (int i = 0; i < 32; ++i) scr[(2 * i + (lane >> 5)) * 33 + (lane & 31)] = __builtin_nontemporal_load(wp + (size_t)(2 * i) * N);
    LDS_WAIT(); asm volatile("" ::: "memory");
#pragma unroll
    for (int j = 0; j < 4; ++j) { const int n = (lane >> 3) + 8 * j; const LAS float* s = scr + (8 * c) * 33 + n;
        v4u o; o.x = pk2(s[0 * 33] * ks0.x, s[1 * 33] * ks0.y); o.y = pk2(s[2 * 33] * ks0.z, s[3 * 33] * ks0.w); o.z = pk2(s[4 * 33] * ks1.x, s[5 * 33] * ks1.y); o.w = pk2(s[6 * 33] * ks1.z, s[7 * 33] * ks1.w);
        *(v4u*)(WT + (size_t)(drow0 + n) * K + k0 + 8 * c) = o; }
    LDS_WAIT(); asm volatile("" ::: "memory");
}

__device__ __forceinline__ void convert_weights(const Args& a, int l, LAS unsigned char* lds, int lane, int wave, int w, int nw, int part = 4  ) {
    unsigned char* ws = gws(a);
    LAS float* scr = (LAS float*)(lds + wave * 16384);
    constexpr int IT_IN = 16 * 80, IT_OUT = 16 * 32, IT_G = 16 * 88, IT_D = 44 * 32;
    constexpr int NITEMS = IT_IN + IT_OUT + 2 * IT_G + IT_D;
    const int it_lo = part == 4 ? 0 : (part == 0 ? 0 : part == 1 ? IT_IN : part == 2 ? IT_IN + IT_OUT : IT_IN + IT_OUT + 2 * IT_G);
    const int it_hi = part == 4 ? NITEMS : (part == 0 ? IT_IN : part == 1 ? IT_IN + IT_OUT : part == 2 ? IT_IN + IT_OUT + 2 * IT_G : NITEMS);
    for (int it = it_lo + w; it < it_hi; it += nw) {
        int r = it;
        if (r < IT_IN) { const int kb = r / 80, nb = r % 80;
            p0_transpose_item(gp(a, I_WIN) + (size_t)l * DM * D_IN, DM, D_IN, (bf16*)(ws + WS_WIN) + (size_t)l * D_IN * DM, 64 * kb, 32 * nb, 32 * nb, gp(a, I_NMIX) + l * DM, scr, lane); continue; }
        r -= IT_IN;
        if (r < IT_OUT) { const int kb = r / 32, nb = r % 32;
            p0_transpose_item(gp(a, I_WOUT) + (size_t)l * DM * DM, DM, DM, (bf16*)(ws + WS_WOUT) + (size_t)l * DM * DM, 64 * kb, 32 * nb, 32 * nb, nullptr, scr, lane); continue; }
        r -= IT_OUT;
        if (r < 2 * IT_G) { const int sel = r / IT_G; r -= sel * IT_G; const int kb = r / 88, nb = r % 88; const int n0 = 32 * nb;
            const int drow0 = 256 * (n0 >> 7) + 128 * sel + (n0 & 127);
            p0_transpose_item(gp(a, sel ? I_WU : I_WG) + (size_t)l * DM * D_FF, DM, D_FF, (bf16*)(ws + WS_WGU) + (size_t)l * 2 * D_FF * DM, 64 * kb, n0, drow0, gp(a, I_NFFN) + l * DM, scr, lane); continue; }
        r -= 2 * IT_G;
        { const int kb = r / 32, nb = r % 32;
            p0_transpose_item(gp(a, I_WD) + (size_t)l * D_FF * DM, D_FF, DM, (bf16*)(ws + WS_WDN) + (size_t)l * DM * D_FF, 64 * kb, 32 * nb, 32 * nb, nullptr, scr, lane); }
    }
}

__device__ __forceinline__ void p0_prologue(const Args& a, LAS unsigned char* lds, int tid, int lane, int wave) {
    unsigned char* ws = gws(a);
    LAS float* scr = (LAS float*)(lds + wave * 16384);
    const int gw = blockIdx.x * NWAVES + wave, NGW = gridDim.x * NWAVES;
    convert_weights(a, 0, lds, lane, wave, gw, NGW, 0);
    {
        bf16* XB = (bf16*)(ws + WS_XB); float* SS0 = (float*)(ws + WS_SSP);
        for (int m0 = gw; m0 < M_TOK; m0 += 3 * NGW) {
            f32x4 v[3][4];
#pragma unroll
            for (int r = 0; r < 3; ++r) { const int m = m0 + r * NGW; if (m < M_TOK) { const float* xrow = (m < M_PROMPT) ? gp(a, I_XP) + (size_t)m * DM : gp(a, I_XS) + (size_t)(m - M_PROMPT) * DM; const f32x4* xr = (const f32x4*)xrow + lane;
#pragma unroll
                for (int j = 0; j < 4; ++j) v[r][j] = __builtin_nontemporal_load(xr + 64 * j); } }
#pragma unroll
            for (int r = 0; r < 3; ++r) { const int m = m0 + r * NGW; if (m < M_TOK) { float s = 0.f; unsigned long long* o8 = (unsigned long long*)(XB + (size_t)m * DM) + lane;
#pragma unroll
                for (int j = 0; j < 4; ++j) { const f32x4 x = v[r][j]; s += (x.x * x.x + x.y * x.y) + (x.z * x.z + x.w * x.w); o8[64 * j] = (unsigned long long)pk2(x.x, x.y) | ((unsigned long long)pk2(x.z, x.w) << 32); }
                s = wave_sum(s); if (lane < 16) SS0[(size_t)m * 16 + lane] = (lane == 0) ? s : 0.f; } }
        }
    }
    unsigned char* sm = ws + WS_SMALL;
    const int NGT = gridDim.x * NTHREADS, gt = NGT - 1 - (blockIdx.x * NTHREADS + tid);
    for (int i = gt; i < 2 * DA; i += NGT) {
        const int l = i / DA, j = i % DA; float v = 0.f;
        if (l == 1) { const float l0 = gp(a, I_HLB)[j], l1 = gp(a, I_HLB)[DA + j]; v = 1.0f / (1.0f + expf(l0 - l1)); }
        ((float*)(sm + SM_LBS))[i] = v;
    }
    for (int i = gt; i < 2 * DC; i += NGT) { const float lam = gp(a, I_LLAM)[i]; ((float*)(sm + SM_SP))[i] = -8.0f * log1pf(expf(-lam)); }
    for (int i = gt; i < 2 * 16 * 64; i += NGT) {
        const int lg = i >> 6, p = i & 63;
        const float dt = expf(gp(a, I_S5DT)[lg]); const float lr = fminf(gp(a, I_S5LR)[i], -1e-4f), li = gp(a, I_S5LI)[i];
        const float mag = expf(lr * dt); const float are = mag * cosf(li * dt), aim = mag * sinf(li * dt);
        ((f32x2v*)(sm + SM_S5A))[i] = (f32x2v){are, aim};
        float pr = are, pi = aim;
#pragma unroll
        for (int s = 0; s < 6; ++s) { const float nr_ = pr * pr - pi * pi, ni_ = 2.0f * pr * pi; pr = nr_; pi = ni_; }
        ((f32x2v*)(sm + SM_S5A64))[i] = (f32x2v){pr, pi};
        const float den = lr * lr + li * li, nr = are - 1.0f;
        const float gre = (nr * lr + aim * li) / den, gim = (aim * lr - nr * li) / den;
        bf16* BB = (bf16*)(sm + SM_BB) + ((size_t)lg * 128 + 2 * p) * 16;
#pragma unroll
        for (int n = 0; n < 16; ++n) { const float br = gp(a, I_S5BR)[(size_t)i * 16 + n], bi = gp(a, I_S5BI)[(size_t)i * 16 + n];
            BB[n] = f2bf(gre * br - gim * bi); BB[16 + n] = f2bf(gre * bi + gim * br); }
        bf16* CC = (bf16*)(sm + SM_CC) + (size_t)lg * 16 * 128;
#pragma unroll
        for (int n = 0; n < 16; ++n) { const float cr = gp(a, I_S5CR)[((size_t)lg * 16 + n) * 64 + p], ci = gp(a, I_S5CI)[((size_t)lg * 16 + n) * 64 + p];
            CC[n * 128 + 2 * p] = f2bf(cr); CC[n * 128 + 2 * p + 1] = f2bf(-ci); }
    }
    for (int i = gt; i < 2 * 256 * 256; i += NGT) { const int l = i >> 16, n = (i >> 8) & 255, k = i & 255; ((bf16*)(sm + SM_WGT))[i] = f2bf(gp(a, I_S5WG)[((size_t)l * 256 + k) * 256 + n]); }
    for (int i = gt; i < 2 * 6 * 64 * 64; i += NGT) { const int lh = i >> 12, j = (i >> 6) & 63, ii = i & 63;
        ((bf16*)(sm + SM_WAT))[i] = f2bf(gp(a, I_LWA)[((size_t)lh * 64 + ii) * 64 + j]); ((bf16*)(sm + SM_WXT))[i] = f2bf(gp(a, I_LWX)[((size_t)lh * 64 + ii) * 64 + j]); }
}

constexpr int HG_S = 72;
constexpr int HG_QG = 0, HG_KG = 2304, HG_QE = 4608, HG_KET = 6912, HG_VT = 8960, HG_EGL = 11008, HG_GT = 11264, HG_WAVE_BYTES = 13568;
template <int CTRL> __device__ __forceinline__ float dpp_f(float v) { return __int_as_float(__builtin_amdgcn_update_dpp(0, __float_as_int(v), CTRL, 0xF, 0xF, true)); }
__device__ __forceinline__ float bfe(const v4u (&w)[2], int e) { const unsigned x = w[e >> 3][(e >> 1) & 3]; return __uint_as_float((e & 1) ? (x & 0xffff0000u) : (x << 16)); }
__device__ __forceinline__ bf16 bfraw(const v4u (&w)[2], int e) { const unsigned x = w[e >> 3][(e >> 1) & 3]; return (bf16)((e & 1) ? (x >> 16) : (x & 0xffffu)); }
template <bool OUT>
__device__ __forceinline__ void hgrn_unit(const Args& a, int layer, int cid, int h, LAS unsigned char* wl, int lane) {
    const int fr = lane & 15, fq = lane >> 4;
    unsigned char* ws = gws(a);
    const bf16* proj = (const bf16*)(ws + WS_PROJ) + (size_t)cid * 64 * D_IN;
    const float* lbp = (const float*)(ws + WS_SMALL + SM_LBS) + layer * DA + h * 64 + 16 * fq;
    float* HST = (float*)(ws + WS_HST);
    f32x4 S[4][4];
    {
        const float* s0 = nullptr;
        if (cid >= NPCH) s0 = gp(a, I_SH) + (((size_t)layer * 32 + (cid - NPCH)) * 6 + h) * 4096;
        else if (OUT && (cid & 63) != 0) s0 = HST + ((size_t)(cid - 1) * 6 + h) * 4096;
        if (s0) {
            const float* sp = s0 + (4 * fq) * 64 + fr;
#pragma unroll
            for (int dt = 0; dt < 4; ++dt)
#pragma unroll
                for (int vt = 0; vt < 4; ++vt)
#pragma unroll
                    for (int j = 0; j < 4; ++j) S[dt][vt][j] = sp[(16 * dt + j) * 64 + 16 * vt];
        } else {
#pragma unroll
            for (int dt = 0; dt < 4; ++dt)
#pragma unroll
                for (int vt = 0; vt < 4; ++vt) S[dt][vt] = (f32x4){0.f, 0.f, 0.f, 0.f};
        }
    }
    float gtot[OUT ? 1 : 16];
#pragma unroll
    for (int e = 0; e < (OUT ? 1 : 16); ++e) gtot[e] = 0.f;
    LAS bf16* QG = (LAS bf16*)(wl + HG_QG); LAS bf16* KG = (LAS bf16*)(wl + HG_KG); LAS bf16* QE = (LAS bf16*)(wl + HG_QE);
    LAS bf16* KET = (LAS bf16*)(wl + HG_KET); LAS bf16* VT = (LAS bf16*)(wl + HG_VT); LAS float* EGL = (LAS float*)(wl + HG_EGL); LAS bf16* GT = (LAS bf16*)(wl + HG_GT);
    const bf16x8 zero8 = {0, 0, 0, 0, 0, 0, 0, 0};
    const int rb7 = (lane & 48) | 7, rb15 = (lane & 48) | 15;
#pragma unroll 1
    for (int sb = 0; sb < 4; ++sb) {
        const bf16* prow = proj + (size_t)(sb * 16 + fr) * D_IN + h * 64 + 16 * fq;
        {
            v4u fw[2], iw[2], qw[2], gw[2];
            fw[0] = ldg<OUT>((const v4u*)(prow + CF)); fw[1] = ldg<OUT>((const v4u*)(prow + CF + 8)); iw[0] = ldg<OUT>((const v4u*)(prow + CI)); iw[1] = ldg<OUT>((const v4u*)(prow + CI + 8));
            if (OUT) { qw[0] = ldg<true>((const v4u*)(prow + CQ)); qw[1] = ldg<true>((const v4u*)(prow + CQ + 8)); gw[0] = ldg<true>((const v4u*)(prow + CG)); gw[1] = ldg<true>((const v4u*)(prow + CG + 8)); }
            f32x4 lb4[4];
#pragma unroll
            for (int q = 0; q < 4; ++q) lb4[q] = *(const f32x4*)(lbp + 4 * q);
            float G[16], kv[16];
#pragma unroll
            for (int e = 0; e < 16; ++e) { const float lb = lb4[e >> 2][e & 3], oml = 1.0f - lb; const float sg = sigm(bfe(fw, e));
                kv[e] = oml * (1.0f - sg); G[e] = __logf(lb + oml * sg); }
#pragma unroll
            for (int e = 0; e < 16; ++e) { G[e] += dpp_f<0x111>(G[e]); G[e] += dpp_f<0x112>(G[e]); G[e] += dpp_f<0x114>(G[e]); G[e] += dpp_f<0x118>(G[e]); }
            unsigned qgp[8], kgp[8], qep[8]; float egl[16];
#pragma unroll
            for (int e = 0; e < 16; e += 2) {
                float qg2[2], kg2[2], qe2[2];
#pragma unroll
                for (int o = 0; o < 2; ++o) { const int ee = e + o;
                    const float Gr = __shfl(G[ee], rb7), Gl = __shfl(G[ee], rb15);
                    const float eGr = __expf(Gr), eGlr = __expf(Gl - Gr); egl[ee] = eGr * eGlr; if (!OUT) gtot[ee] += Gl;
                    const float e2 = __expf(Gr - G[ee]); const float kg = kv[ee] * e2;
                    KET[(16 * fq + ee) * 16 + fr] = f2bf(kg * eGlr);
                    VT[(16 * fq + ee) * 16 + fr] = bfraw(iw, ee);
                    if (OUT) { const float e1 = __expf(G[ee] - Gr); const float qg = bfe(qw, ee) * e1; qg2[o] = qg; kg2[o] = kg; qe2[o] = qg * eGr; } }
                if (OUT) { qgp[e >> 1] = pk2(qg2[0], qg2[1]); kgp[e >> 1] = pk2(kg2[0], kg2[1]); qep[e >> 1] = pk2(qe2[0], qe2[1]); }
            }
            if (fr == 15) {
#pragma unroll
                for (int q = 0; q < 4; ++q) *(LAS f32x4*)(EGL + 16 * fq + 4 * q) = (f32x4){egl[4 * q], egl[4 * q + 1], egl[4 * q + 2], egl[4 * q + 3]}; }
            if (OUT) {
                *(LAS v4u*)(QG + fr * HG_S + 16 * fq) = (v4u){qgp[0], qgp[1], qgp[2], qgp[3]}; *(LAS v4u*)(QG + fr * HG_S + 16 * fq + 8) = (v4u){qgp[4], qgp[5], qgp[6], qgp[7]};
                *(LAS v4u*)(KG + fr * HG_S + 16 * fq) = (v4u){kgp[0], kgp[1], kgp[2], kgp[3]}; *(LAS v4u*)(KG + fr * HG_S + 16 * fq + 8) = (v4u){kgp[4], kgp[5], kgp[6], kgp[7]};
                *(LAS v4u*)(QE + fr * HG_S + 16 * fq) = (v4u){qep[0], qep[1], qep[2], qep[3]}; *(LAS v4u*)(QE + fr * HG_S + 16 * fq + 8) = (v4u){qep[4], qep[5], qep[6], qep[7]};
                *(LAS v4u*)(GT + fr * HG_S + 16 * fq) = gw[0]; *(LAS v4u*)(GT + fr * HG_S + 16 * fq + 8) = gw[1];
            }
        }
        WAVE_SYNC();
        if (OUT) {
            f32x4 at = {0.f, 0.f, 0.f, 0.f};
#pragma unroll
            for (int kk = 0; kk < 2; ++kk) { const bf16x8 A = *(const LAS bf16x8*)(KG + fr * HG_S + kk * 32 + fq * 8), B = *(const LAS bf16x8*)(QG + fr * HG_S + kk * 32 + fq * 8); at = MFMA16(A, B, at); }
#pragma unroll
            for (int j = 0; j < 4; ++j) if (4 * fq + j > fr) at[j] = 0.f;
            union { bf16x8 v; unsigned u[4]; } Aatt; Aatt.u[0] = pk2(at[0], at[1]); Aatt.u[1] = pk2(at[2], at[3]); Aatt.u[2] = 0u; Aatt.u[3] = 0u;
            union { bf16x8 v; v2u h[2]; } Aq[2];
#pragma unroll
            for (int kk = 0; kk < 2; ++kk) { Aq[kk].h[0] = *(const LAS v2u*)(QE + fr * HG_S + kk * 32 + 4 * fq); Aq[kk].h[1] = *(const LAS v2u*)(QE + fr * HG_S + kk * 32 + 16 + 4 * fq); }
            f32x4 ov[4]; float ssq[4] = {0.f, 0.f, 0.f, 0.f};
#pragma unroll
            for (int vt = 0; vt < 4; ++vt) {
                union { bf16x8 v; v2u h[2]; } Bv; Bv.h[0] = *(const LAS v2u*)(VT + (16 * vt + fr) * 16 + 4 * fq); Bv.h[1] = (v2u){0u, 0u};
                f32x4 o = {0.f, 0.f, 0.f, 0.f};
                o = MFMA16(Aatt.v, Bv.v, o);
#pragma unroll
                for (int kk = 0; kk < 2; ++kk) { union { bf16x8 v; unsigned u[4]; } Bs;
                    Bs.u[0] = pk2(S[2 * kk][vt][0], S[2 * kk][vt][1]); Bs.u[1] = pk2(S[2 * kk][vt][2], S[2 * kk][vt][3]);
                    Bs.u[2] = pk2(S[2 * kk + 1][vt][0], S[2 * kk + 1][vt][1]); Bs.u[3] = pk2(S[2 * kk + 1][vt][2], S[2 * kk + 1][vt][3]);
                    o = MFMA16(Aq[kk].v, Bs.v, o); }
                ov[vt] = o;
#pragma unroll
                for (int j = 0; j < 4; ++j) ssq[j] += o[j] * o[j];
            }
#pragma unroll
            for (int j = 0; j < 4; ++j) { float s = ssq[j]; s += __shfl_xor(s, 1); s += __shfl_xor(s, 2); s += __shfl_xor(s, 4); s += __shfl_xor(s, 8); ssq[j] = __builtin_amdgcn_rsqf(s * (1.0f / 64.0f) + EPS); }
#pragma unroll
            for (int vt = 0; vt < 4; ++vt) { const float nw = gp(a, I_HNORM)[layer * DA + h * 64 + 16 * vt + fr];
#pragma unroll
                for (int j = 0; j < 4; ++j) { const int t = 4 * fq + j; const float g = bf2f(GT[t * HG_S + 16 * vt + fr]);
                    QG[t * HG_S + 16 * vt + fr] = f2bf(ov[vt][j] * ssq[j] * nw * g * sigm(g)); } }
            WAVE_SYNC();
            { const v4u o0 = *(const LAS v4u*)(QG + fr * HG_S + 8 * fq), o1 = *(const LAS v4u*)(QG + fr * HG_S + 32 + 8 * fq);
              bf16* dst = (bf16*)(ws + WS_MIX) + ((size_t)cid * 64 + sb * 16 + fr) * DM + h * 64 + 8 * fq; *(v4u*)dst = o0; *(v4u*)(dst + 32) = o1; }
        }
        {
            bf16x8 Bv[4];
#pragma unroll
            for (int vt = 0; vt < 4; ++vt) Bv[vt] = (fq < 2) ? *(const LAS bf16x8*)(VT + (16 * vt + fr) * 16 + fq * 8) : zero8;
#pragma unroll
            for (int dt = 0; dt < 4; ++dt) { const f32x4 eg = *(const LAS f32x4*)(EGL + 16 * dt + 4 * fq);
                const bf16x8 A = (fq < 2) ? *(const LAS bf16x8*)(KET + (16 * dt + fr) * 16 + fq * 8) : zero8;
#pragma unroll
                for (int vt = 0; vt < 4; ++vt) S[dt][vt] = MFMA16(A, Bv[vt], S[dt][vt] * eg); }
        }
        WAVE_SYNC();
    }
    {
        float* dst = nullptr;
        if (OUT) { if (cid >= NPCH) dst = gout(a) + O_HS + (((size_t)layer * 32 + (cid - NPCH)) * 6 + h) * 4096;
                   else if ((cid & 63) == 63) dst = gout(a) + O_HP + (((size_t)layer * 4 + (cid >> 6)) * 6 + h) * 4096; }
        else { dst = HST + ((size_t)cid * 6 + h) * 4096;
            if (fr == 0) { float* hd = (float*)(ws + WS_HD) + ((size_t)cid * 6 + h) * 64 + 16 * fq;
#pragma unroll
                for (int q = 0; q < 4; ++q) *(f32x4*)(hd + 4 * q) = (f32x4){__expf(gtot[(OUT ? 0 : 4 * q)]), __expf(gtot[(OUT ? 0 : 4 * q + 1)]), __expf(gtot[(OUT ? 0 : 4 * q + 2)]), __expf(gtot[(OUT ? 0 : 4 * q + 3)])}; } }
        if (dst) {
#pragma unroll
            for (int dt = 0; dt < 4; ++dt)
#pragma unroll
                for (int vt = 0; vt < 4; ++vt)
#pragma unroll
                    for (int j = 0; j < 4; ++j) dst[(4 * fq) * 64 + fr + (16 * dt + j) * 64 + 16 * vt] = S[dt][vt][j];
        }
    }
}

constexpr int S5_US = 264, S5_BS = 132, S5_HS = 136;
constexpr int S5_UT = 0, S5_BUT = 8448, S5_HT = 76032, S5_ZT = 110848, S5_ZF = 119296;
template <bool OUT>
__device__ __forceinline__ void s5_phase(const Args& a, int layer, LAS unsigned char* lds, int tid, int lane, int wave, int NU) {
    const int fr = lane & 15, fq = lane >> 4;
    unsigned char* ws = gws(a); const unsigned char* sm = ws + WS_SMALL;
    f32x2v* ST = (f32x2v*)(ws + WS_S5ST);
    LAS bf16* UT = (LAS bf16*)(lds + S5_UT); LAS float* BUT = (LAS float*)(lds + S5_BUT) + wave * (16 * S5_BS); LAS bf16* HT = (LAS bf16*)(lds + S5_HT) + wave * (16 * S5_HS);
    LAS bf16* ZT = (LAS bf16*)(lds + S5_ZT); LAS float* ZF = (LAS float*)(lds + S5_ZF);
    const bf16x8 zero8 = {0, 0, 0, 0, 0, 0, 0, 0};
    bf16x8 BBr[8], CCr[2][4], WGr[2][8]; float are[2], aim[2], dd[2], bgv[2];
    {
        const bf16* BB = (const bf16*)(sm + SM_BB) + ((size_t)(layer * 16 + (fq < 2 ? wave : 8 + wave)) * 128) * 16;
#pragma unroll
        for (int nt = 0; nt < 8; ++nt) BBr[nt] = *(const bf16x8*)(BB + (16 * nt + fr) * 16 + (fq & 1) * 8);
    }
    const int r_ut = tid >> 5, c8 = (tid & 31) * 8;
#pragma unroll
    for (int hf = 0; hf < 2; ++hf) { const int g = hf * 8 + wave;
        const f32x2v av = ((const f32x2v*)(sm + SM_S5A))[(layer * 16 + g) * 64 + lane]; are[hf] = av.x; aim[hf] = av.y;
        if (OUT) { const bf16* CC = (const bf16*)(sm + SM_CC) + (size_t)(layer * 16 + g) * 16 * 128;
#pragma unroll
            for (int kk = 0; kk < 4; ++kk) CCr[hf][kk] = *(const bf16x8*)(CC + fr * 128 + 32 * kk + 8 * fq);
            dd[hf] = gp(a, I_S5D)[layer * DB + g * 16 + fr]; } }
    if (OUT) { const bf16* WG = (const bf16*)(sm + SM_WGT) + (size_t)layer * 65536;
#pragma unroll
        for (int i = 0; i < 2; ++i) { const int nt = 2 * wave + i;
#pragma unroll
            for (int kk = 0; kk < 8; ++kk) WGr[i][kk] = *(const bf16x8*)(WG + (size_t)(16 * nt + fr) * 256 + 32 * kk + 8 * fq);
            bgv[i] = gp(a, I_S5BG)[layer * DB + 16 * nt + fr]; }
        }
#pragma unroll 1
    for (int u = blockIdx.x; u < NU; u += gridDim.x) {
        const int cid = OUT ? u : (u / 63) * 64 + (u % 63);
        const bf16* proj = (const bf16*)(ws + WS_PROJ) + (size_t)cid * 64 * D_IN;
        float hre[2], him[2];
#pragma unroll
        for (int hf = 0; hf < 2; ++hf) { const int g = hf * 8 + wave;
            if (cid >= NPCH) { const size_t o = (((size_t)layer * 32 + (cid - NPCH)) * 16 + g) * 64 + lane; hre[hf] = gp(a, I_SSR)[o]; him[hf] = gp(a, I_SSI)[o]; }
            else if (OUT && (cid & 63) != 0) { const f32x2v hv = ST[((size_t)(cid - 1) * 16 + g) * 64 + lane]; hre[hf] = hv.x; him[hf] = hv.y; }
            else { hre[hf] = 0.f; him[hf] = 0.f; } }
        v4u unext = ldg<OUT>((const v4u*)(proj + (size_t)r_ut * D_IN + CU + c8));
#pragma unroll 1
        for (int tt = 0; tt < 4; ++tt) {
            *(LAS v4u*)(UT + r_ut * S5_US + c8) = unext;
            if (tt < 3) unext = ldg<OUT>((const v4u*)(proj + (size_t)((tt + 1) * 16 + r_ut) * D_IN + CU + c8));
            BSYNC();
#pragma unroll
            for (int hf = 0; hf < 2; ++hf) {
                const int g = hf * 8 + wave;
                {
                    const bf16x8 A = ((fq < 2) == (hf == 0)) ? *(const LAS bf16x8*)(UT + fr * S5_US + g * 16 + (fq & 1) * 8) : zero8;
                    f32x4 cc[8];
#pragma unroll
                    for (int nt = 0; nt < 8; ++nt) { cc[nt] = (f32x4){0.f, 0.f, 0.f, 0.f}; cc[nt] = MFMA16(A, BBr[nt], cc[nt]); }
                    __builtin_amdgcn_sched_barrier(0); asm volatile("s_nop 7\n\ts_nop 7\n\ts_nop 7" ::: "memory"); __builtin_amdgcn_sched_barrier(0);
#pragma unroll
                    for (int nt = 0; nt < 8; ++nt)
#pragma unroll
                        for (int j = 0; j < 4; ++j) BUT[(4 * fq + j) * S5_BS + 16 * nt + fr] = cc[nt][j];
                }
                BSYNC();
                {
                    float hr = hre[hf], hi = him[hf]; const float ar = are[hf], ai = aim[hf];
#pragma unroll
                    for (int th = 0; th < 4; ++th) { f32x2v bv[4];
#pragma unroll
                        for (int t = 0; t < 4; ++t) bv[t] = *(const LAS f32x2v*)(BUT + (4 * th + t) * S5_BS + 2 * lane);
#pragma unroll
                        for (int t = 0; t < 4; ++t) { const float nr = ar * hr - ai * hi + bv[t].x, ni = ar * hi + ai * hr + bv[t].y; hr = nr; hi = ni;
                            if (OUT) *(LAS unsigned*)(HT + (4 * th + t) * S5_HS + 2 * lane) = pk2(hr, hi); } }
                    hre[hf] = hr; him[hf] = hi;
                }
                BSYNC();
                if (OUT) {
                    f32x4 y = {0.f, 0.f, 0.f, 0.f};
#pragma unroll
                    for (int kk = 0; kk < 4; ++kk) { const bf16x8 A = *(const LAS bf16x8*)(HT + fr * S5_HS + 32 * kk + 8 * fq); y = MFMA16(A, CCr[hf][kk], y); }
                    const int ch = g * 16 + fr;
#pragma unroll
                    for (int j = 0; j < 4; ++j) { const int tok = 4 * fq + j; const float uu = bf2f(UT[tok * S5_US + ch]); const float z = gelu_tanh(y[j] + dd[hf] * uu);
                        ZT[tok * S5_US + ch] = f2bf(z); ZF[tok * 256 + ch] = z; }
                }
            }
            if (OUT) {
                BSYNC();
#pragma unroll
                for (int i = 0; i < 2; ++i) { const int nt = 2 * wave + i; f32x4 p = {0.f, 0.f, 0.f, 0.f};
#pragma unroll
                    for (int kk = 0; kk < 8; ++kk) { const bf16x8 A = *(const LAS bf16x8*)(ZT + fr * S5_US + 32 * kk + 8 * fq); p = MFMA16(A, WGr[i][kk], p); }
                    const int n = 16 * nt + fr;
#pragma unroll
                    for (int j = 0; j < 4; ++j) { const int tok = 4 * fq + j; ZF[tok * 256 + n] = ZF[tok * 256 + n] * sigm(p[j] + bgv[i]); } }
                BSYNC();
                { const f32x4 v0 = *(const LAS f32x4*)(ZF + r_ut * 256 + c8), v1 = *(const LAS f32x4*)(ZF + r_ut * 256 + c8 + 4);
                  float s = (v0.x * v0.x + v0.y * v0.y) + (v0.z * v0.z + v0.w * v0.w) + (v1.x * v1.x + v1.y * v1.y) + (v1.z * v1.z + v1.w * v1.w);
                  s += __shfl_xor(s, 1); s += __shfl_xor(s, 2); s += __shfl_xor(s, 4); s += __shfl_xor(s, 8); s += __shfl_xor(s, 16);
                  const float rs = __builtin_amdgcn_rsqf(s * (1.0f / 256.0f) + EPS); const f32x4 nw0 = *(const f32x4*)(gp(a, I_S5N) + layer * DB + c8), nw1 = *(const f32x4*)(gp(a, I_S5N) + layer * DB + c8 + 4);
                  v4u o; o.x = pk2(v0.x * rs * nw0.x, v0.y * rs * nw0.y); o.y = pk2(v0.z * rs * nw0.z, v0.w * rs * nw0.w); o.z = pk2(v1.x * rs * nw1.x, v1.y * rs * nw1.y); o.w = pk2(v1.z * rs * nw1.z, v1.w * rs * nw1.w);
                  *(v4u*)((bf16*)(ws + WS_MIX) + ((size_t)cid * 64 + tt * 16 + r_ut) * DM + DA + c8) = o; }
            }
            BSYNC();
        }
#pragma unroll
        for (int hf = 0; hf < 2; ++hf) { const int g = hf * 8 + wave;
            if (OUT) { if (cid >= NPCH) { const size_t o = (((size_t)layer * 32 + (cid - NPCH)) * 16 + g) * 64 + lane; gout(a)[O_SRS + o] = hre[hf]; gout(a)[O_SIS + o] = him[hf]; }
                       else if ((cid & 63) == 63) { const size_t o = (((size_t)layer * 4 + (cid >> 6)) * 16 + g) * 64 + lane; gout(a)[O_SRP + o] = hre[hf]; gout(a)[O_SIP + o] = him[hf]; } }
            else ST[((size_t)cid * 16 + g) * 64 + lane] = (f32x2v){hre[hf], him[hf]}; }
    }
    __syncthreads();
}

constexpr int LR_XS = 392, LR_AS = 388;
constexpr int LR_XC = 0, LR_AL = 25088, LR_BL = 74752;
template <bool OUT>
__device__ __forceinline__ void lru_phase(const Args& a, int layer, LAS unsigned char* lds, int tid, int lane, int wave, int NU) {
    const int fr = lane & 15, fq = lane >> 4;
    unsigned char* ws = gws(a); const unsigned char* sm = ws + WS_SMALL;
    f32x2v* ST = (f32x2v*)(ws + WS_LRUST);
    LAS bf16* XC = (LAS bf16*)(lds + LR_XC); LAS float* AL = (LAS float*)(lds + LR_AL); LAS float* BL = (LAS float*)(lds + LR_BL);
    const bool act = tid < DC; const int c = act ? tid : 0;
    const float cw0 = gp(a, I_LCW)[(layer * 4 + 0) * DC + c], cw1 = gp(a, I_LCW)[(layer * 4 + 1) * DC + c], cw2 = gp(a, I_LCW)[(layer * 4 + 2) * DC + c], cw3 = gp(a, I_LCW)[(layer * 4 + 3) * DC + c];
    const float cb = gp(a, I_LCB)[layer * DC + c];
    bf16x8 BA0[3], BA1[3], BX0[3], BX1[3]; float bav[3], bxv[3], spv[3];
#pragma unroll
    for (int i = 0; i < 3; ++i) { const int ntg = 3 * wave + i, hd = ntg >> 2, jn = (ntg & 3) * 16; const int ch = 16 * ntg + fr;
        const bf16* WA = (const bf16*)(sm + SM_WAT) + ((size_t)(layer * 6 + hd) * 64 + jn + fr) * 64; const bf16* WX = (const bf16*)(sm + SM_WXT) + ((size_t)(layer * 6 + hd) * 64 + jn + fr) * 64;
        BA0[i] = *(const bf16x8*)(WA + 8 * fq); BA1[i] = *(const bf16x8*)(WA + 32 + 8 * fq); BX0[i] = *(const bf16x8*)(WX + 8 * fq); BX1[i] = *(const bf16x8*)(WX + 32 + 8 * fq);
        bav[i] = gp(a, I_LBA)[layer * DC + ch]; bxv[i] = gp(a, I_LBX)[layer * DC + ch]; spv[i] = ((const float*)(sm + SM_SP))[layer * DC + ch]; }
    const int ntok = tid >> 4, c0 = (tid & 15) * 24;
#pragma unroll 1
    for (int k = 0; k * (int)gridDim.x < NU; ++k) {
        const int G_ = (int)gridDim.x, u = k * G_ + (((int)blockIdx.x + G_ - (8 * k) % G_) % G_); if (u >= NU) continue;
        const int cid = OUT ? u : (u / 63) * 64 + (u % 63);
        const bf16* proj = (const bf16*)(ws + WS_PROJ) + (size_t)cid * 64 * D_IN;
        float xm3 = 0.f, xm2 = 0.f, xm1 = 0.f, h = 0.f, P = 1.f;
        if (cid >= NPCH) { const size_t sb = (size_t)layer * 32 + (cid - NPCH); xm3 = gp(a, I_SC)[(sb * 3 + 0) * DC + c]; xm2 = gp(a, I_SC)[(sb * 3 + 1) * DC + c]; xm1 = gp(a, I_SC)[(sb * 3 + 2) * DC + c]; h = gp(a, I_SL)[sb * DC + c]; }
        else if ((cid & 63) != 0) { xm3 = bf2f(proj[-3 * D_IN + CXR + c]); xm2 = bf2f(proj[-2 * D_IN + CXR + c]); xm1 = bf2f(proj[-1 * D_IN + CXR + c]); if (OUT) h = ST[(size_t)(cid - 1) * DC + c].y; }
#pragma unroll 1
        for (int tile = 0; tile < 2; ++tile) {
            const bf16* pr = proj + (size_t)tile * 32 * D_IN;
            bf16 gr[32];
            {   bf16 xr[32];
#pragma unroll
                for (int t = 0; t < 32; ++t) xr[t] = ldg<OUT>(pr + (size_t)t * D_IN + CXR + c);
                if (OUT) {
#pragma unroll
                    for (int t = 0; t < 32; ++t) gr[t] = ldg<true>(pr + (size_t)t * D_IN + CGR + c); }
                if (act) {
#pragma unroll
                    for (int t = 0; t < 32; ++t) { const float x = bf2f(xr[t]); const float xc = cb + cw0 * xm3 + cw1 * xm2 + cw2 * xm1 + cw3 * x; XC[t * LR_XS + c] = f2bf(xc); xm3 = xm2; xm2 = xm1; xm1 = x; } }
            }
            BSYNC();
#pragma unroll
            for (int i = 0; i < 3; ++i) { const int ntg = 3 * wave + i, hd = ntg >> 2; const int ch = 16 * ntg + fr;
#pragma unroll
                for (int mt = 0; mt < 2; ++mt) { const bf16x8 A0 = *(const LAS bf16x8*)(XC + (16 * mt + fr) * LR_XS + hd * 64 + 8 * fq), A1 = *(const LAS bf16x8*)(XC + (16 * mt + fr) * LR_XS + hd * 64 + 32 + 8 * fq);
                    f32x4 r = {0.f, 0.f, 0.f, 0.f}, ii = {0.f, 0.f, 0.f, 0.f};
                    r = MFMA16(A0, BA0[i], r); r = MFMA16(A1, BA1[i], r); ii = MFMA16(A0, BX0[i], ii); ii = MFMA16(A1, BX1[i], ii);
#pragma unroll
                    for (int j = 0; j < 4; ++j) { const int tok = 16 * mt + 4 * fq + j; const float rg = sigm(r[j] + bav[i]), ig = sigm(ii[j] + bxv[i]); const float la = spv[i] * rg; const float av = __expf(la);
                        const float xcv = bf2f(XC[tok * LR_XS + ch]); AL[tok * LR_AS + ch] = av; BL[tok * LR_AS + ch] = __builtin_amdgcn_sqrtf(fmaxf(1.0f - av * av, 0.f)) * ig * xcv; } } }
            BSYNC();
            if (act) {
#pragma unroll
                for (int t = 0; t < 32; ++t) { const float av = AL[t * LR_AS + c]; h = av * h + BL[t * LR_AS + c]; P *= av;
                    if (OUT) BL[t * LR_AS + c] = h * gelu_tanh(bf2f(gr[t])); }
            }
            if (OUT) {
                BSYNC();
                float v[24]; float s = 0.f; const int sub = tid & 15;
#pragma unroll
                for (int q = 0; q < 3; ++q) { const f32x4 x0 = *(const LAS f32x4*)(BL + ntok * LR_AS + 128 * q + 8 * sub), x1 = *(const LAS f32x4*)(BL + ntok * LR_AS + 128 * q + 8 * sub + 4);
                    v[8 * q] = x0.x; v[8 * q + 1] = x0.y; v[8 * q + 2] = x0.z; v[8 * q + 3] = x0.w; v[8 * q + 4] = x1.x; v[8 * q + 5] = x1.y; v[8 * q + 6] = x1.z; v[8 * q + 7] = x1.w;
                    s += ((x0.x * x0.x + x0.y * x0.y) + (x0.z * x0.z + x0.w * x0.w)) + ((x1.x * x1.x + x1.y * x1.y) + (x1.z * x1.z + x1.w * x1.w)); }
                s += __shfl_xor(s, 1); s += __shfl_xor(s, 2); s += __shfl_xor(s, 4); s += __shfl_xor(s, 8);
                const float rs = __builtin_amdgcn_rsqf(s * (1.0f / 384.0f) + EPS);
                bf16* dst = (bf16*)(ws + WS_MIX) + ((size_t)cid * 64 + tile * 32 + ntok) * DM + DA + DB + 8 * sub;
#pragma unroll
                for (int q = 0; q < 3; ++q) { const float* nw = gp(a, I_LNORM) + layer * DC + 128 * q + 8 * sub; const f32x4 n0 = *(const f32x4*)nw, n1 = *(const f32x4*)(nw + 4);
                    v4u o; o.x = pk2(v[8 * q] * rs * n0.x, v[8 * q + 1] * rs * n0.y); o.y = pk2(v[8 * q + 2] * rs * n0.z, v[8 * q + 3] * rs * n0.w);
                    o.z = pk2(v[8 * q + 4] * rs * n1.x, v[8 * q + 5] * rs * n1.y); o.w = pk2(v[8 * q + 6] * rs * n1.z, v[8 * q + 7] * rs * n1.w); *(v4u*)(dst + 128 * q) = o; }
            }
        }
        if (act) {
            if (OUT) {
                float* ho = nullptr; float* co = nullptr;
                if (cid >= NPCH) { const size_t sb = (size_t)layer * 32 + (cid - NPCH); ho = gout(a) + O_LS + sb * DC; co = gout(a) + O_CS + sb * 3 * DC; }
                else if ((cid & 63) == 63) { const size_t sb = (size_t)layer * 4 + (cid >> 6); ho = gout(a) + O_LP + sb * DC; co = gout(a) + O_CP + sb * 3 * DC; }
                if (ho) { ho[c] = h; co[c] = xm3; co[DC + c] = xm2; co[2 * DC + c] = xm1; }
            } else ST[(size_t)cid * DC + c] = (f32x2v){P, h};
        }
        __syncthreads();
    }
}

__device__ __forceinline__ void carry_phase(const Args& a, int layer, int tid) {
    unsigned char* ws = gws(a);
    const int gt = blockIdx.x * NTHREADS + tid, NGT = gridDim.x * NTHREADS;
    for (int i = gt; i < 4 * 6 * 4096; i += NGT) {
        const int b = i / 24576, rem = i % 24576, hh = rem >> 12, e = rem & 4095, d = e >> 6;
        float* HST = (float*)(ws + WS_HST) + ((size_t)(b * 64) * 6 + hh) * 4096 + e; const float* HD = (const float*)(ws + WS_HD) + ((size_t)(b * 64) * 6 + hh) * 64 + d;
        float S = 0.f;
#pragma unroll 21
        for (int cc = 0; cc < 63; ++cc) { S = HD[(size_t)cc * 6 * 64] * S + HST[(size_t)cc * 6 * 4096]; HST[(size_t)cc * 6 * 4096] = S; }
    }
    const int off5 = (NGT >= 4 * 6 * 4096 + 4 * 1024 + 4 * DC) ? 4 * 6 * 4096 : 0, offl = off5 ? off5 + 4 * 1024 : 0;
    for (int i = gt - off5; i < 4 * 1024; i += NGT) { if (i < 0) continue;
        const int b = i >> 10, gp = i & 1023; const f32x2v A = ((const f32x2v*)(ws + WS_SMALL + SM_S5A64))[layer * 1024 + gp];
        f32x2v* ST = (f32x2v*)(ws + WS_S5ST) + (size_t)(b * 64) * 1024 + gp; float hr = 0.f, hi = 0.f;
#pragma unroll 21
        for (int cc = 0; cc < 63; ++cc) { const f32x2v l = ST[(size_t)cc * 1024]; const float nr = A.x * hr - A.y * hi + l.x, ni = A.x * hi + A.y * hr + l.y; hr = nr; hi = ni; ST[(size_t)cc * 1024] = (f32x2v){hr, hi}; }
    }
    for (int i = gt - offl; i < 4 * DC; i += NGT) { if (i < 0) continue;
        const int b = i / DC, c = i % DC; f32x2v* ST = (f32x2v*)(ws + WS_LRUST) + (size_t)(b * 64) * DC + c; float h = 0.f;
#pragma unroll 21
        for (int cc = 0; cc < 63; ++cc) { const f32x2v l = ST[(size_t)cc * DC]; h = l.x * h + l.y; ST[(size_t)cc * DC] = (f32x2v){l.x, h}; }
    }
}

#ifndef MIXSLOW
#define MIXSLOW 0
#endif
#define MSLOW(bit) do { if (MIXSLOW) { asm volatile("s_waitcnt vmcnt(0) lgkmcnt(0)" ::: "memory"); __syncthreads(); const unsigned long long t1_ = __builtin_amdgcn_s_memrealtime(); if (MIXSLOW & (bit)) { const unsigned long long d_ = t1_ - t_m; while (__builtin_amdgcn_s_memrealtime() - t1_ < d_) __builtin_amdgcn_s_sleep(8); } t_m = __builtin_amdgcn_s_memrealtime(); } } while (0)
template <bool OUT>
__device__ __forceinline__ void mixer_phase(int layer, LAS unsigned char* lds, int tid0) {
#ifndef MIXSEL
#define MIXSEL 7
#endif
    unsigned long long t_m = MIXSLOW ? __builtin_amdgcn_s_memrealtime() : 0ull;
    if (MIXSEL & 1) {
        int tid = tid0; LAUNDER_V(tid); const int lane = tid & 63, wave = __builtin_amdgcn_readfirstlane(tid >> 6);
        const int gw = blockIdx.x * NWAVES + wave, NGW = gridDim.x * NWAVES;
        LAS unsigned char* wl = lds + wave * HG_WAVE_BYTES;
        const Args& a = kargs();
        if (OUT) {
            const int hb = ((int)gridDim.x * NWAVES > NCHUNK * 6) ? ((int)gridDim.x * NWAVES - NCHUNK * 6) / NWAVES : 0;
            if ((int)blockIdx.x >= hb) for (int u = ((int)blockIdx.x - hb) * NWAVES + wave; u < NCHUNK * 6; u += ((int)gridDim.x - hb) * NWAVES) hgrn_unit<true>(a, layer, u / 6, u % 6, wl, lane); }
        else     { for (int u = gw; u < 4 * 63 * 6; u += NGW) { const int b = u / 378, rem = u % 378; hgrn_unit<false>(a, layer, b * 64 + rem / 6, rem % 6, wl, lane); } }
    }
    __syncthreads();
    MSLOW(1);
    const int NU = OUT ? NCHUNK : 4 * 63;
    if (MIXSEL & 2) {
        int tid = tid0; LAUNDER_V(tid); const int lane = tid & 63, wave = __builtin_amdgcn_readfirstlane(tid >> 6);
        s5_phase<OUT>(kargs(), layer, lds, tid, lane, wave, NU);
    }
    MSLOW(2);
    if (MIXSEL & 4) {
        int tid = tid0; LAUNDER_V(tid); const int lane = tid & 63, wave = __builtin_amdgcn_readfirstlane(tid >> 6);
        lru_phase<OUT>(kargs(), layer, lds, tid, lane, wave, NU);
    }
    MSLOW(4);
}

__device__ __forceinline__ void final_norm(const Args& a, int lane, int wave) {
    const int gw = blockIdx.x * NWAVES + wave, NGW = gridDim.x * NWAVES;
    const float* SS = (const float*)(gws(a) + WS_SSP) + (size_t)4 * M_TOK * 16; const f32x4* nw = (const f32x4*)gp(a, I_NFIN) + lane;
    const bf16* XB = (const bf16*)(gws(a) + WS_XB);
    f32x4 w[4];
#pragma unroll
    for (int j = 0; j < 4; ++j) w[j] = nw[64 * j];
    for (int m = gw; m < M_TOK; m += NGW) { const float rs = pg8::row_rstd(SS, (size_t)m); f32x4* xr = (f32x4*)(gout(a) + (size_t)m * DM) + lane; const v2u* xb = (const v2u*)(XB + (size_t)m * DM) + lane;
#pragma unroll
        for (int j = 0; j < 4; ++j) { const v2u b = xb[64 * j]; f32x4 v; v[0] = __uint_as_float(b.x << 16); v[1] = __uint_as_float(b.x & 0xffff0000u); v[2] = __uint_as_float(b.y << 16); v[3] = __uint_as_float(b.y & 0xffff0000u);
            v = v * rs * w[j]; __builtin_nontemporal_store(v, xr + 64 * j); } }
}

#ifndef PHSEL
#define PHSEL 0xFF
#endif
#ifndef MK_MULTI
#define MK_MULTI 0
#endif
struct KArgs { Args a; int ph_lo, ph_hi; };
__global__ void __launch_bounds__(NTHREADS, 2) fwd_megakernel(KArgs ka) {
    extern __shared__ __attribute__((aligned(16))) unsigned char lds_raw[];
    LAS unsigned char* lds = (LAS unsigned char*)lds_raw;
    const int tid = threadIdx.x, lane = tid & 63, wave = __builtin_amdgcn_readfirstlane(tid >> 6);
    unsigned char* ws = ka.a.ws; float* const out = ka.a.out; unsigned char* const ws_early = ws;
    const Args& a = ka.a;
    float* SS = (float*)(ws + WS_SSP);
    bf16* XB = (bf16*)(ws + WS_XB); bf16* PROJ = (bf16*)(ws + WS_PROJ); bf16* MIX = (bf16*)(ws + WS_MIX); bf16* HID = (bf16*)(ws + WS_HID);
    int ph = 0;
#if MK_MULTI
#define SEAM() do { ++ph; } while (0)
#define RUN(b) (((PHSEL) >> (b)) & 1) && (ph >= ka.ph_lo && ph < ka.ph_hi)
#else
    cg::grid_group grid = cg::this_grid();
    volatile LAS unsigned* xb_st = (volatile LAS unsigned*)(lds + XB_LDS_OFF);
    if (threadIdx.x < 2) xb_st[threadIdx.x] = 0u;
    __syncthreads();
    const XcdBarrier xbar = xcd_barrier_post((unsigned*)(ws_early + WS_CTL + 16384), xb_st);
#define SEAM() do { if (ka.ph_hi < 0) grid.sync(); xcd_barrier(xbar); ++ph; } while (0)
#define RUN(b) ((((PHSEL) >> (b)) & 1) != 0)
#endif
#ifndef STOP_AFTER
#define STOP_AFTER 999
#endif
#ifndef DUMP_OFF
#define DUMP_OFF WS_MIX
#endif
#ifndef DUMP_F32
#define DUMP_F32 0
#endif
#define PROBE() do { if (ph == STOP_AFTER) { if (DUMP_F32 == 2) { const bf16* src = (const bf16*)(ws + WS_PROJ); for (size_t i = (size_t)blockIdx.x * NTHREADS + tid; i < (size_t)M_TOK * 256; i += (size_t)gridDim.x * NTHREADS) out[i] = bf2f(src[(i >> 8) * D_IN + CU + (i & 255)]); } else if (DUMP_F32) { const float* src = (const float*)(ws + DUMP_OFF); for (size_t i = (size_t)blockIdx.x * NTHREADS + tid; i < (size_t)7602176; i += (size_t)gridDim.x * NTHREADS) out[i] = src[i]; } \
    else { const bf16* src = (const bf16*)(ws + DUMP_OFF); for (size_t i = (size_t)blockIdx.x * NTHREADS + tid; i < (size_t)M_TOK * DM; i += (size_t)gridDim.x * NTHREADS) out[i] = bf2f(src[i]); } return; } } while (0)
#define IDLE_CONVERT(nwg_, lay_, part_) do { const int rem_ = (nwg_) % (int)gridDim.x; if ((int)blockIdx.x >= rem_) {     int t2 = tid; LAUNDER_V(t2); const int w2 = __builtin_amdgcn_readfirstlane(t2 >> 6); \
        convert_weights(kargs(), (lay_), lds, t2 & 63, w2, ((int)blockIdx.x - rem_) * NWAVES + w2, ((int)gridDim.x - rem_) * NWAVES, (part_)); } } while (0)
#ifndef SLOWMASK
#define SLOWMASK 0
#endif
    unsigned long long t_ph = SLOWMASK ? __builtin_amdgcn_s_memrealtime() : 0ull;
#define SLOW(bit) do { if (SLOWMASK) { const unsigned long long t1_ = __builtin_amdgcn_s_memrealtime(); if (SLOWMASK & (bit)) { const unsigned long long d_ = t1_ - t_ph; while (__builtin_amdgcn_s_memrealtime() - t1_ < d_) __builtin_amdgcn_s_sleep(8); } t_ph = __builtin_amdgcn_s_memrealtime(); } } while (0)
    if (RUN(0)) { int t3 = tid; LAUNDER_V(t3); p0_prologue(kargs(), lds, t3, t3 & 63, __builtin_amdgcn_readfirstlane(t3 >> 6)); if (blockIdx.x == 0 && tid < 38) ((unsigned long long*)(ws + WS_TAB))[tid] = (tid < 36) ? (unsigned long long)ka.a.in[tid] : (tid == 36 ? (unsigned long long)ka.a.out : (unsigned long long)ka.a.ws); }
    SEAM(); PROBE(); SLOW(1);
#pragma unroll 1
    for (int l = 0; l < 2; ++l) {
        if (RUN(1)) { pg8::Gemm g{XB, (const bf16*)(ws + WS_WIN) + (size_t)l * D_IN * DM, M_TOK, D_IN, DM}; pg8::StaticOrder S; S.init(M_TOK, D_IN, gridDim.x, blockIdx.x);
            pg8::EpiProj E{PROJ, D_IN, SS + (size_t)(2 * l) * M_TOK * 16};
            pg8::gemm_phase<pg8::EpiProj, pg8::StaticOrder, true, true>(lds, g, S, E);
            IDLE_CONVERT(72 * 10, l, 1); }
        SEAM(); PROBE(); SLOW(2);
        if (RUN(2)) mixer_phase<false>(l, lds, tid);
        SEAM(); PROBE(); SLOW(4);
        if (RUN(3)) { int t3 = tid; LAUNDER_V(t3); carry_phase(kargs(), l, t3); }
        SEAM(); PROBE(); SLOW(4);
        if (RUN(4)) mixer_phase<true>(l, lds, tid);
        SEAM(); PROBE(); SLOW(4);
        if (RUN(5)) { pg8::Gemm g{MIX, (const bf16*)(ws + WS_WOUT) + (size_t)l * DM * DM, M_TOK, DM, DM}; pg8::StaticOrder S; S.init(M_TOK, DM, gridDim.x, blockIdx.x);
            pg8::EpiRes E{XB, SS + (size_t)(2 * l + 1) * M_TOK * 16};
            pg8::gemm_phase<pg8::EpiRes, pg8::StaticOrder, true, true>(lds, g, S, E);
            IDLE_CONVERT(72 * 4, l, 2); IDLE_CONVERT(72 * 4, l, 3); if (l == 0) IDLE_CONVERT(72 * 4, 1, 0); }
        SEAM(); PROBE(); SLOW(8);
        {
            const int G_ = (int)gridDim.x, total = 72 * 22, full = (total / G_) * G_, c0 = total - full;
#define Wgu ((const bf16*)(ws + WS_WGU) + (size_t)l * 2 * D_FF * DM)
#define Wdn ((const bf16*)(ws + WS_WDN) + (size_t)l * DM * D_FF)
            const int nlow = (G_ == 256) ? 32 : 0, t_lo = G_ + 3 * nlow;
#pragma unroll 1
            for (int step = 0; step < 2; ++step) {
                if (step == 1 && RUN(6)) { pg8::Gemm g{HID, Wdn, M_TOK, DM, D_FF}; pg8::SampleOrder S; S.c0 = 0; S.c = (nlow ? (int)blockIdx.x : -1);
                    pg8::EpiRes E{XB, SS + (size_t)(2 * l + 2) * M_TOK * 16};
                    pg8::gemm_phase<pg8::EpiRes, pg8::SampleOrder, true, true>(lds, g, S, E); }
                if (RUN(6)) { pg8::Gemm g{XB, Wgu, M_TOK, 2 * D_FF, DM}; pg8::GuOrder S; S.init(M_PROMPT, 2 * D_FF, G_, blockIdx.x); S.npre = 8 * 22;
                    if (step == 0) { S.lo = 0; S.hi = G_; }
                    else if ((int)blockIdx.x < nlow) { S.G = nlow; S.lo = G_; S.hi = t_lo; }
                    else { S.G = G_ - nlow; S.c = (int)blockIdx.x - nlow; S.lo = t_lo; S.hi = total; }
                    pg8::EpiGateUp E{HID, D_FF, SS + (size_t)(2 * l + 1) * M_TOK * 16};
                    pg8::gemm_phase<pg8::EpiGateUp, pg8::GuOrder, true, true>(lds, g, S, E); }
                if (step == 0) xcd_barrier(xbar);
            }
            if (!nlow && RUN(6)) {
                xcd_barrier(xbar);
                pg8::Gemm g{HID, Wdn, M_TOK, DM, D_FF}; pg8::SampleOrder S; S.c0 = 0; S.c = blockIdx.x;
                pg8::EpiRes E{XB, SS + (size_t)(2 * l + 2) * M_TOK * 16};
                pg8::gemm_phase<pg8::EpiRes, pg8::SampleOrder, true, true>(lds, g, S, E); }
            SEAM(); PROBE(); SLOW(16);
            if (RUN(7)) { pg8::Gemm g{HID, Wdn, M_PROMPT, DM, D_FF}; pg8::StaticOrder S; S.init(M_PROMPT, DM, G_, blockIdx.x);
                pg8::EpiRes E{XB, SS + (size_t)(2 * l + 2) * M_TOK * 16};
                pg8::gemm_phase<pg8::EpiRes, pg8::StaticOrder, true, true>(lds, g, S, E); }
        }
        SEAM(); PROBE(); SLOW(32);
    }
    if (RUN(3)) { int t3 = tid; LAUNDER_V(t3); final_norm(kargs(), t3 & 63, __builtin_amdgcn_readfirstlane(t3 >> 6)); }
}
constexpr int N_PHASES = 1 + 2 * 7 + 1;

extern "C" void kernel_launch(void* const* d_in, const int* in_sizes, int n_in, void* d_out, int out_size, void* d_ws, size_t ws_size, hipStream_t stream) {
    static int grid = 0;
    if (grid == 0) {
        if (n_in != 36 || in_sizes[0] != M_PROMPT * DM || (size_t)out_size != O_END || ws_size < WS_END) {
            fprintf(stderr, "kernel_launch: unexpected shapes: n_in %d in0 %d out %d ws %zu\n", n_in, n_in > 0 ? in_sizes[0] : -1, out_size, ws_size); }
        int dev = 0, cus = 0, per_cu = 0;
        hipGetDevice(&dev); hipDeviceGetAttribute(&cus, hipDeviceAttributeMultiprocessorCount, dev);
        if (hipFuncSetAttribute((const void*)fwd_megakernel, hipFuncAttributeMaxDynamicSharedMemorySize, LDS_BYTES) != hipSuccess) { fprintf(stderr, "kernel_launch: hipFuncSetAttribute failed\n"); grid = -1; return; }
        if (hipOccupancyMaxActiveBlocksPerMultiprocessor(&per_cu, (const void*)fwd_megakernel, NTHREADS, LDS_BYTES) != hipSuccess || per_cu < 1) { fprintf(stderr, "kernel_launch: occupancy query failed (%d)\n", per_cu); (void)hipGetLastError(); per_cu = 1; }
        grid = cus * (per_cu > 1 ? 1 : per_cu);
        fprintf(stderr, "kernel_launch: grid %d (cus %d, per_cu %d)\n", grid, cus, per_cu);
    }
    if (grid < 0) return;
    (void)hipMemsetAsync((char*)d_ws + WS_CTL, 0, 65536, stream);
    KArgs ka{};
    for (int i = 0; i < 36; ++i) ka.a.in[i] = (const float*)d_in[i];
    ka.a.out = (float*)d_out; ka.a.ws = (unsigned char*)d_ws;
#if MK_MULTI
    for (int p = 0; p < N_PHASES; ++p) { ka.ph_lo = p; ka.ph_hi = p + 1; hipLaunchKernelGGL(fwd_megakernel, dim3(grid), dim3(NTHREADS), LDS_BYTES, stream, ka); }
#else
    ka.ph_lo = 0; ka.ph_hi = N_PHASES;
    void* args[] = {&ka};
    hipError_t e = hipLaunchCooperativeKernel((const void*)fwd_megakernel, dim3(grid), dim3(NTHREADS), args, LDS_BYTES, stream);
    if (e != hipSuccess) fprintf(stderr, "cooperative launch failed: %s (grid %d)\n", hipGetErrorString(e), grid);
#endif
}
```

```cpp
#include <hip/hip_runtime.h>
#include <hip/hip_cooperative_groups.h>
#include <cstdio>
#include <cstdint>
namespace pg8 {
#define PG8_LAS __attribute__((address_space(3)))
typedef unsigned short bf16_t;
typedef short bf16x8 __attribute__((ext_vector_type(8)));
typedef float f32x4 __attribute__((ext_vector_type(4)));
typedef unsigned u32x4 __attribute__((ext_vector_type(4)));
constexpr int BM = 256, BK = 64, HALF = 128, HTB = HALF * BK * 2  , STAGE_BYTES = 8 * HTB, NXCD = 8, WGM = 8;

__host__ __device__ __forceinline__ int lds_byte(int r, int c) { const int st = (r >> 4) * 2 + (c >> 5), rr = r & 15, cc = c & 31, ob = rr * 64 + cc * 2; return st * 1024 + (ob ^ (((ob >> 9) & 1) << 5)); }
__host__ __device__ __forceinline__ void stage_rc(int b, int& R, int& C) { const int st = b / 1024, sb = b % 1024, swz = sb ^ (((sb >> 9) & 1) << 5); R = (st >> 1) * 16 + swz / 64; C = (st & 1) * 32 + (swz % 64) / 2; }
__host__ __device__ __forceinline__ int perm32(int rho) { const int n = rho >> 4, i = rho & 15; return 8 * (i >> 2) + 4 * n + (i & 3); }

struct Unit { int pm, pn; };
struct Gemm { const bf16_t* A; const bf16_t* Bt; int M, N, K; };

struct StaticOrder {
    int nM, nN, nwg, G, c;
    __host__ __device__ void init(int M, int N, int G_, int c_) { nM = M / BM; nN = N / BM; nwg = nM * nN; G = G_; c = c_; }
    __host__ __device__ bool next(int i, Unit& u) const {
        const long L = (long)i * G + c; if (L >= nwg) return false;
        int wgid = (int)L; { const int q = nwg / NXCD, r = nwg % NXCD, xcd = wgid % NXCD, off = wgid / NXCD; wgid = (xcd < r ? xcd * (q + 1) : r * (q + 1) + (xcd - r) * q) + off; }
        const int nig = WGM * nN, gid = wgid / nig, fm = gid * WGM, gsz = (nM - fm) < WGM ? (nM - fm) : WGM;
        u.pm = fm + ((wgid % nig) % gsz); u.pn = (wgid % nig) / gsz; return true;
    }
    __device__ __forceinline__ void a_ready(const Unit&) const {}
    __device__ __forceinline__ void done(const Unit&) const {}
};

__device__ __forceinline__ unsigned cvt_pk_bf16(float lo, float hi) { unsigned r; asm volatile("v_cvt_pk_bf16_f32 %0, %1, %2" : "=v"(r) : "v"(lo), "v"(hi)); return r; }
typedef float f32x2 __attribute__((ext_vector_type(2)));
constexpr float RMS_EPS = 1e-6f;
__device__ __forceinline__ float row_rstd(const float* ssp, size_t row) {
    const f32x4* p = (const f32x4*)(ssp + row * 16); const f32x4 a = p[0], b = p[1], c = p[2], d = p[3];
    const float s = (((a[0] + a[1]) + (a[2] + a[3])) + ((b[0] + b[1]) + (b[2] + b[3]))) + (((c[0] + c[1]) + (c[2] + c[3])) + ((d[0] + d[1]) + (d[2] + d[3])));
    return __builtin_amdgcn_rsqf(s * (1.0f / 1024.0f) + RMS_EPS);
}
__device__ __forceinline__ float row_rstd_q(const float* ssp, size_t row, int fq) {
    const f32x4 a = *(const f32x4*)(ssp + row * 16 + 4 * fq);
    float s = (a[0] + a[1]) + (a[2] + a[3]);
    s += __shfl_xor(s, 16); s += __shfl_xor(s, 32);
    return __builtin_amdgcn_rsqf(s * (1.0f / 1024.0f) + RMS_EPS);
}
__device__ __forceinline__ float fast_sigmoid(float x) { return __builtin_amdgcn_rcpf(1.0f + __builtin_amdgcn_exp2f(-1.4426950408889634f * x)); }
struct EpiProj {
    static constexpr bool PERM = true, AFTER_DRAIN = false;
    bf16_t* O; int ldc; const float* ss;
    __device__ __forceinline__ void operator()(const f32x4 (&acc)[2][2][4][2], const Unit& u, int wr, int wc, int fr, int fq) const {
        const int row0 = u.pm * BM + wr * 64 + fr, col0 = u.pn * BM + wc * 32 + 8 * fq;
#pragma unroll
        for (int ai = 0; ai < 2; ++ai)
#pragma unroll
            for (int m = 0; m < 4; ++m) {
                const int row = row0 + ai * HALF + m * 16;
                const float rs = row_rstd_q(ss, (size_t)row, fq);
                bf16_t* rowp = O + (size_t)row * ldc + col0;
#pragma unroll
                for (int bj = 0; bj < 2; ++bj) { const f32x4 v0 = acc[ai][bj][m][0] * rs, v1 = acc[ai][bj][m][1] * rs;
                    u32x4 w; w.x = cvt_pk_bf16(v0[0], v0[1]); w.y = cvt_pk_bf16(v0[2], v0[3]); w.z = cvt_pk_bf16(v1[0], v1[1]); w.w = cvt_pk_bf16(v1[2], v1[3]);
                    *(u32x4*)(rowp + bj * HALF) = w; }
            }
    }
};
struct EpiGateUp {
    static constexpr bool PERM = true, AFTER_DRAIN = false;
    bf16_t* O; int ldc; const float* ss;
    __device__ __forceinline__ void operator()(const f32x4 (&acc)[2][2][4][2], const Unit& u, int wr, int wc, int fr, int fq) const {
        const int row0 = u.pm * BM + wr * 64 + fr, col0 = u.pn * HALF + wc * 32 + 8 * fq;
#pragma unroll
        for (int ai = 0; ai < 2; ++ai)
#pragma unroll
            for (int m = 0; m < 4; ++m) {
                const int row = row0 + ai * HALF + m * 16;
                const float rs = row_rstd_q(ss, (size_t)row, fq);
                float hv[8];
#pragma unroll
                for (int n = 0; n < 2; ++n)
#pragma unroll
                    for (int e = 0; e < 4; ++e) { const float g = acc[ai][0][m][n][e] * rs, up = acc[ai][1][m][n][e] * rs; hv[n * 4 + e] = g * fast_sigmoid(g) * up; }
                u32x4 w; w.x = cvt_pk_bf16(hv[0], hv[1]); w.y = cvt_pk_bf16(hv[2], hv[3]); w.z = cvt_pk_bf16(hv[4], hv[5]); w.w = cvt_pk_bf16(hv[6], hv[7]);
                *(u32x4*)(O + (size_t)row * ldc + col0) = w;
            }
    }
};
struct EpiRes {
    static constexpr bool PERM = true, AFTER_DRAIN = false;
    bf16_t* xb; float* ssn;
    __device__ __forceinline__ void operator()(const f32x4 (&acc)[2][2][4][2], const Unit& u, int wr, int wc, int fr, int fq) const {
        const int col0 = u.pn * BM + wc * 32 + 8 * fq;
#pragma unroll
        for (int ai = 0; ai < 2; ++ai)
#pragma unroll
            for (int m = 0; m < 4; ++m) {
                const size_t row = (size_t)u.pm * BM + ai * HALF + wr * 64 + m * 16 + fr;
                float ssq = 0.f;
#pragma unroll
                for (int bj = 0; bj < 2; ++bj) { bf16_t* p = xb + row * 1024 + col0 + bj * HALF;
                    const u32x4 b = *(const u32x4*)p; const f32x4 a0 = acc[ai][bj][m][0], a1 = acc[ai][bj][m][1];
                    float o[8];
                    o[0] = __uint_as_float(b.x << 16) + a0[0]; o[1] = __uint_as_float(b.x & 0xffff0000u) + a0[1]; o[2] = __uint_as_float(b.y << 16) + a0[2]; o[3] = __uint_as_float(b.y & 0xffff0000u) + a0[3];
                    o[4] = __uint_as_float(b.z << 16) + a1[0]; o[5] = __uint_as_float(b.z & 0xffff0000u) + a1[1]; o[6] = __uint_as_float(b.w << 16) + a1[2]; o[7] = __uint_as_float(b.w & 0xffff0000u) + a1[3];
                    ssq += ((o[0] * o[0] + o[1] * o[1]) + (o[2] * o[2] + o[3] * o[3])) + ((o[4] * o[4] + o[5] * o[5]) + (o[6] * o[6] + o[7] * o[7]));
                    u32x4 w; w.x = cvt_pk_bf16(o[0], o[1]); w.y = cvt_pk_bf16(o[2], o[3]); w.z = cvt_pk_bf16(o[4], o[5]); w.w = cvt_pk_bf16(o[6], o[7]); *(u32x4*)p = w; }
                ssq += __shfl_xor(ssq, 16); ssq += __shfl_xor(ssq, 32);
                if (fq == 0) ssn[row * 16 + u.pn * 4 + wc] = ssq;
            }
    }
};

struct GuOrder : StaticOrder {
    int npre, lo, hi;
    __device__ __forceinline__ bool next(int i, Unit& u) const {
        const long L = (long)lo + (long)i * G + c; if (L >= hi) return false;
        if (L < npre) { u.pm = 64 + (int)L / nN; u.pn = (int)L % nN; return true; }
        int wgid = (int)(L - npre); { const int q = nwg / NXCD, r = nwg % NXCD, xcd = wgid % NXCD, off = wgid / NXCD; wgid = (xcd < r ? xcd * (q + 1) : r * (q + 1) + (xcd - r) * q) + off; }
        const int nig = WGM * nN, gid = wgid / nig, fm = gid * WGM, gsz = (nM - fm) < WGM ? (nM - fm) : WGM;
        u.pm = fm + ((wgid % nig) % gsz); u.pn = (wgid % nig) / gsz; return true;
    }
    __device__ __forceinline__ void a_ready(const Unit&) const {}
    __device__ __forceinline__ void done(const Unit&) const {}
};
struct SampleOrder {
    int c0, c;
    __device__ __forceinline__ bool next(int i, Unit& u) const { if (i != 0 || c < c0 || c >= c0 + 32) return false; u.pm = 64 + (c - c0) / 4; u.pn = (c - c0) % 4; return true; }
    __device__ __forceinline__ void a_ready(const Unit&) const {}
    __device__ __forceinline__ void done(const Unit&) const {}
};
template <class Epi, class Sched, bool ALIGN_EPI = false, bool SP2 = false>
__device__ __forceinline__ void gemm_phase(PG8_LAS unsigned char* lds, const Gemm g, const Sched& S, const Epi& E) {
    int tid_ = threadIdx.x; asm volatile("" : "+v"(tid_));
    const int tid = tid_, wid = __builtin_amdgcn_readfirstlane(tid >> 6), lane = tid & 63, wr = wid >> 2, wc = wid & 3, fr = lane & 15, fq = lane >> 4;
    const int K = g.K, nt = K / BK;
    unsigned voffA[2], voffB[2];
#pragma unroll
    for (int i = 0; i < 2; ++i) { int R, C; stage_rc(tid * 16 + i * 8192, R, C); const int Rb = Epi::PERM ? ((R & ~31) + perm32(R & 31)) : R;
        voffA[i] = (unsigned)(R * K + C) * 2u; voffB[i] = (unsigned)(Rb * K + C) * 2u; }
    const size_t kstep = (size_t)(BK * 2);
    const size_t hstep = (size_t)HALF * K * 2;
    const size_t tstep = 2 * hstep;
    const unsigned ldsw = (unsigned)wid * 1024u;
    const int aoff = lds_byte(wr * 64 + fr, fq * 8), boff = lds_byte(wc * 32 + fr, fq * 8);
#define PG8_SA(b, h) (((b) * 2 + (h)) * HTB)
#define PG8_SB(b, h) ((4 + (b) * 2 + (h)) * HTB)
#define PG8_STAGE(bufoff, gbase, voff) do { _Pragma("unroll") for (int _i = 0; _i < 2; ++_i) \
        __builtin_amdgcn_global_load_lds((const unsigned*)((const char*)(gbase) + (voff)[_i]), (PG8_LAS unsigned*)(lds + (bufoff) + ldsw + _i * 8192), 16, 0, 0); } while (0)
#define PG8_LDA(dst, b, h) do { _Pragma("unroll") for (int m = 0; m < 4; ++m) _Pragma("unroll") for (int k = 0; k < 2; ++k) dst[m][k] = *(const PG8_LAS bf16x8*)(lds + PG8_SA(b, h) + aoff + m * 2048 + k * 1024); } while (0)
#define PG8_LDB(dst, b, h) do { _Pragma("unroll") for (int n = 0; n < 2; ++n) _Pragma("unroll") for (int k = 0; k < 2; ++k) dst[n][k] = *(const PG8_LAS bf16x8*)(lds + PG8_SB(b, h) + boff + n * 2048 + k * 1024); } while (0)
#define PG8_MMA(ai, bj, At, Bt) do { __builtin_amdgcn_s_setprio(1); _Pragma("unroll") for (int m = 0; m < 4; ++m) _Pragma("unroll") for (int n = 0; n < 2; ++n) _Pragma("unroll") for (int k = 0; k < 2; ++k) \
        acc[ai][bj][m][n] = __builtin_amdgcn_mfma_f32_16x16x32_bf16(Bt[n][k], At[m][k], acc[ai][bj][m][n], 0, 0, 0); __builtin_amdgcn_s_setprio(0); } while (0)
#define PG8_WAIT_V(n) asm volatile("s_waitcnt vmcnt(" #n ")" ::: "memory")
#define PG8_WAIT_L(n) asm volatile("s_waitcnt lgkmcnt(" #n ")" ::: "memory")
#define PG8_BAR __builtin_amdgcn_s_barrier()
#define PG8_SCHED __builtin_amdgcn_sched_barrier(0)
    Unit cur, nxt; int ui = 0;
    if (!S.next(0, cur)) return;
    f32x4 acc[2][2][4][2];
#pragma unroll
    for (int a = 0; a < 2; ++a)
#pragma unroll
        for (int b = 0; b < 2; ++b)
#pragma unroll
            for (int m = 0; m < 4; ++m)
#pragma unroll
                for (int n = 0; n < 2; ++n) acc[a][b][m][n] = (f32x4){0.f, 0.f, 0.f, 0.f};
    bf16x8 At[4][2], B0[2][2], B1[2][2];
    const char* cA = (const char*)g.A + (size_t)cur.pm * tstep; const char* cB = (const char*)g.Bt + (size_t)cur.pn * tstep;
    S.a_ready(cur);
    if constexpr (SP2) {
        PG8_STAGE(PG8_SB(0, 0), cB, voffB); PG8_STAGE(PG8_SB(0, 1), cB + hstep, voffB); PG8_STAGE(PG8_SA(0, 0), cA, voffA); PG8_STAGE(PG8_SA(0, 1), cA + hstep, voffA);
        if (wr == 1) PG8_BAR;
        PG8_WAIT_V(2); PG8_BAR;
        PG8_STAGE(PG8_SB(1, 0), cB + kstep, voffB); PG8_STAGE(PG8_SA(1, 0), cA + kstep, voffA); PG8_STAGE(PG8_SB(1, 1), cB + hstep + kstep, voffB);
        PG8_WAIT_V(6); PG8_BAR;
    } else {
        PG8_STAGE(PG8_SB(0, 0), cB, voffB); PG8_STAGE(PG8_SA(0, 0), cA, voffA); PG8_STAGE(PG8_SB(0, 1), cB + hstep, voffB); PG8_STAGE(PG8_SA(0, 1), cA + hstep, voffA);
        if (wr == 1) PG8_BAR;
        PG8_WAIT_V(4); PG8_BAR;
        PG8_STAGE(PG8_SB(1, 0), cB + kstep, voffB); PG8_STAGE(PG8_SA(1, 0), cA + kstep, voffA); PG8_STAGE(PG8_SB(1, 1), cB + hstep + kstep, voffB);
        PG8_WAIT_V(6); PG8_BAR;
    }
    for (;;) {
        const bool has_next = S.next(ui + 1, nxt);
        const char* nA = has_next ? (const char*)g.A + (size_t)nxt.pm * tstep : cA; const char* nB = has_next ? (const char*)g.Bt + (size_t)nxt.pn * tstep : cB;
        for (int t = 0; t < nt; t += 2) {
            const bool last = (t == nt - 2);
            const char* a1 = cA + (size_t)(t + 1) * kstep;
            const char* a2 = last ? nA : cA + (size_t)(t + 2) * kstep; const char* b2 = last ? nB : cB + (size_t)(t + 2) * kstep;
            const char* a3 = a2 + kstep; const char* b3 = b2 + kstep;
            if (last && has_next) S.a_ready(nxt);
            if constexpr (SP2) {
            PG8_LDB(B0, 0, 0); PG8_LDB(B1, 0, 1); PG8_SCHED; PG8_LDA(At, 0, 0); PG8_STAGE(PG8_SA(1, 1), a1 + hstep, voffA);
            PG8_WAIT_V(8); PG8_WAIT_L(0); PG8_BAR; PG8_MMA(0, 0, At, B0); PG8_MMA(0, 1, At, B1); PG8_BAR; PG8_SCHED;
            PG8_LDA(At, 0, 1); PG8_STAGE(PG8_SB(0, 0), b2, voffB); PG8_STAGE(PG8_SB(0, 1), b2 + hstep, voffB); PG8_STAGE(PG8_SA(0, 0), a2, voffA);
            PG8_WAIT_V(8); PG8_WAIT_L(0); PG8_BAR; PG8_MMA(1, 0, At, B0); PG8_MMA(1, 1, At, B1); PG8_BAR; PG8_SCHED;
            PG8_LDB(B0, 1, 0); PG8_LDB(B1, 1, 1); PG8_SCHED; PG8_LDA(At, 1, 0); PG8_STAGE(PG8_SA(0, 1), a2 + hstep, voffA);
            PG8_WAIT_V(8); PG8_WAIT_L(0); PG8_BAR; PG8_MMA(0, 0, At, B0); PG8_MMA(0, 1, At, B1); PG8_BAR; PG8_SCHED;
            PG8_LDA(At, 1, 1); PG8_STAGE(PG8_SB(1, 0), b3, voffB); PG8_STAGE(PG8_SB(1, 1), b3 + hstep, voffB); PG8_STAGE(PG8_SA(1, 0), a3, voffA);
            PG8_WAIT_V(8); PG8_WAIT_L(0); PG8_BAR; PG8_MMA(1, 0, At, B0); PG8_MMA(1, 1, At, B1); PG8_BAR; PG8_SCHED;
            } else {
            PG8_LDB(B0, 0, 0); PG8_SCHED; PG8_LDA(At, 0, 0); PG8_STAGE(PG8_SA(1, 1), a1 + hstep, voffA);
            PG8_WAIT_L(8); PG8_BAR; PG8_WAIT_L(0); PG8_MMA(0, 0, At, B0); PG8_BAR; PG8_SCHED;
            PG8_LDB(B1, 0, 1); PG8_STAGE(PG8_SB(0, 0), b2, voffB);
            PG8_BAR; PG8_WAIT_L(0); PG8_MMA(0, 1, At, B1); PG8_BAR;
            PG8_LDA(At, 0, 1); PG8_STAGE(PG8_SA(0, 0), a2, voffA);
            PG8_BAR; PG8_WAIT_L(0); PG8_MMA(1, 0, At, B0); PG8_BAR; PG8_SCHED;
            PG8_STAGE(PG8_SB(0, 1), b2 + hstep, voffB);
            PG8_WAIT_V(6); PG8_BAR; PG8_MMA(1, 1, At, B1); PG8_BAR;
            PG8_LDB(B0, 1, 0); PG8_SCHED; PG8_LDA(At, 1, 0); PG8_STAGE(PG8_SA(0, 1), a2 + hstep, voffA);
            PG8_WAIT_L(8); PG8_BAR; PG8_WAIT_L(0); PG8_MMA(0, 0, At, B0); PG8_BAR; PG8_SCHED;
            PG8_LDB(B1, 1, 1); PG8_STAGE(PG8_SB(1, 0), b3, voffB);
            PG8_BAR; PG8_WAIT_L(0); PG8_MMA(0, 1, At, B1); PG8_BAR;
            PG8_LDA(At, 1, 1); PG8_STAGE(PG8_SA(1, 0), a3, voffA);
            PG8_BAR; PG8_WAIT_L(0); PG8_MMA(1, 0, At, B0); PG8_BAR; PG8_SCHED;
            PG8_STAGE(PG8_SB(1, 1), b3 + hstep, voffB);
            PG8_WAIT_V(6); PG8_BAR; PG8_MMA(1, 1, At, B1); PG8_BAR;
            }
        }
        if constexpr (ALIGN_EPI) { if (wr == 0) PG8_BAR; }
        if constexpr (!Epi::AFTER_DRAIN) { E(acc, cur, wr, wc, fr, fq); S.done(cur); }
        if (!has_next) break;
#pragma unroll
        for (int a = 0; a < 2; ++a)
#pragma unroll
            for (int b = 0; b < 2; ++b)
#pragma unroll
                for (int m = 0; m < 4; ++m)
#pragma unroll
                    for (int n = 0; n < 2; ++n) acc[a][b][m][n] = (f32x4){0.f, 0.f, 0.f, 0.f};
        cur = nxt; cA = nA; cB = nB; ++ui;
        if constexpr (ALIGN_EPI) { if (wr == 1) PG8_BAR; }
    }
    PG8_WAIT_V(0);
    if constexpr (!ALIGN_EPI) { if (wr == 0) PG8_BAR; }
    PG8_BAR;
    if constexpr (Epi::AFTER_DRAIN) { E.fused(acc, cur, wr, wc, fr, fq, lds, wid, lane); S.done(cur); }
#undef PG8_SA
#undef PG8_SB
#undef PG8_STAGE
#undef PG8_LDA
#undef PG8_LDB
#undef PG8_MMA
#undef PG8_WAIT_V
#undef PG8_WAIT_L
#undef PG8_BAR
#undef PG8_SCHED
}
}
namespace cg = cooperative_groups;
#define LAS __attribute__((address_space(3)))
typedef unsigned short bf16;
typedef unsigned v4u __attribute__((ext_vector_type(4)));
typedef unsigned v2u __attribute__((ext_vector_type(2)));
typedef float f32x4 __attribute__((ext_vector_type(4)));
typedef float f32x2v __attribute__((ext_vector_type(2)));
typedef short bf16x8 __attribute__((ext_vector_type(8)));
typedef short bf16x4 __attribute__((ext_vector_type(4)));

constexpr int NWAVES = 8, NTHREADS = 512;
constexpr int DM = 1024, M_TOK = 18432, M_PROMPT = 16384, NCHUNK = 288, NPCH = 256;
constexpr int D_IN = 2560, D_FF = 2816, DA = 384, DB = 256, DC = 384;
constexpr int CQ = 0, CF = 384, CI = 768, CG = 1152, CU = 1536, CXR = 1792, CGR = 2176;
constexpr float EPS = 1e-6f;
constexpr size_t O_Y = 0, O_HP = 18874368, O_SRP = O_HP + 196608, O_SIP = O_SRP + 8192, O_LP = O_SIP + 8192, O_CP = O_LP + 3072,
                 O_HS = O_CP + 9216, O_SRS = O_HS + 1572864, O_SIS = O_SRS + 65536, O_LS = O_SIS + 65536, O_CS = O_LS + 24576, O_END = O_CS + 73728;
constexpr size_t MiB = 1u << 20;
constexpr size_t WS_CTL = 0, CTL_ZERO_BYTES = 1 * MiB, WS_SS = 64 * 1024, WS_TAB = 1 * MiB;
constexpr size_t WS_WIN = 2 * MiB, WS_WOUT = 12 * MiB, WS_WGU = 16 * MiB, WS_WDN = 38 * MiB, WS_SMALL = 49 * MiB;
constexpr size_t SM_LBS = 0, SM_S5A = 4096, SM_S5A64 = SM_S5A + 16384, SM_BB = SM_S5A64 + 16384, SM_CC = SM_BB + 131072, SM_WGT = SM_CC + 131072,
                 SM_WAT = SM_WGT + 262144, SM_WXT = SM_WAT + 98304, SM_SP = SM_WXT + 98304, SM_END = SM_SP + 4096;
static_assert(SM_END <= 3 * MiB, "small tables");
constexpr size_t WS_XB = 52 * MiB, WS_PROJ = 88 * MiB, WS_MIX = 178 * MiB, WS_HID = 88 * MiB;
constexpr size_t WS_HST = 214 * MiB, WS_HD = 238 * MiB, WS_S5ST = 239 * MiB, WS_LRUST = 241 * MiB, WS_SSP = 243 * MiB, WS_END = 249 * MiB;
constexpr int LDS_BYTES = 147456, XB_LDS_OFF = 147456 - 256;

struct Args { const float* in[36]; float* out; unsigned char* ws; };
enum { I_XP = 0, I_XS, I_SH, I_SSR, I_SSI, I_SL, I_SC, I_NMIX, I_WIN, I_HLB, I_HNORM, I_S5LR, I_S5LI, I_S5DT, I_S5BR, I_S5BI, I_S5CR, I_S5CI, I_S5D, I_S5WG, I_S5BG, I_S5N,
       I_LCW, I_LCB, I_LWA, I_LBA, I_LWX, I_LBX, I_LLAM, I_LNORM, I_WOUT, I_NFFN, I_WG, I_WU, I_WD, I_NFIN };


__device__ __forceinline__ unsigned long long rfl64(unsigned long long v) { return ((unsigned long long)(unsigned)__builtin_amdgcn_readfirstlane((int)(unsigned)(v >> 32)) << 32) | (unsigned long long)(unsigned)__builtin_amdgcn_readfirstlane((int)(unsigned)v); }
#define GAS __attribute__((address_space(1)))
typedef __attribute__((address_space(4))) const unsigned char KSEG;
__device__ __forceinline__ const Args& kargs() { KSEG* p = (KSEG*)__builtin_amdgcn_kernarg_segment_ptr(); asm volatile("" : "+s"(p)); return *(const Args*)(const void*)p; }
__device__ __forceinline__ const float* gp(const Args& a, int k) { return (const float*)(const GAS float*)a.in[k]; }
__device__ __forceinline__ unsigned char* gws(const Args& a) { return (unsigned char*)(GAS unsigned char*)a.ws; }
__device__ __forceinline__ float* gout(const Args& a) { return (float*)(GAS float*)a.out; }
__device__ __forceinline__ float bf2f(bf16 b) { return __uint_as_float((unsigned)b << 16); }
__device__ __forceinline__ unsigned pk2(float lo, float hi) { return pg8::cvt_pk_bf16(lo, hi); }
__device__ __forceinline__ bf16 f2bf(float f) { return (bf16)(pk2(f, 0.f) & 0xffffu); }
__device__ __forceinline__ float sigm(float x) { return __builtin_amdgcn_rcpf(1.0f + __builtin_amdgcn_exp2f(-1.4426950408889634f * x)); }
__device__ __forceinline__ float gelu_tanh(float x) { const float u = 0.7978845608028654f * (x + 0.044715f * x * x * x); return x * sigm(2.0f * u); }
#define LAUNDER_V(x) asm volatile("" : "+v"(x))
#define BSYNC() asm volatile("s_waitcnt lgkmcnt(0)\n\ts_barrier" ::: "memory")
template <bool NT, class T> __device__ __forceinline__ T ldg(const T* p) { return NT ? __builtin_nontemporal_load(p) : *p; }
#define LDS_WAIT() asm volatile("s_waitcnt lgkmcnt(0)" ::: "memory")
#define WAVE_SYNC() do { asm volatile("s_waitcnt lgkmcnt(0)" ::: "memory"); __builtin_amdgcn_wave_barrier(); } while (0)
#define MFMA16(a, b, c) __builtin_amdgcn_mfma_f32_16x16x32_bf16((a), (b), (c), 0, 0, 0)
__device__ __forceinline__ float wave_sum(float v) {
#pragma unroll
    for (int o = 1; o < 64; o <<= 1) v += __shfl_xor(v, o);
    return v;
}

#define XB_TMO      128
#define XB_XCNT(j)  (256  + 64 * (j))
#define XB_XSUB(j)  (1280 + 64 * (j))
#define XB_XGEN(j)  (2304 + 64 * (j))
#define XB_TOP      3328
#define XB_TOPGEN   3392
#define XCD_BAR_WORDS 3456
#define XB_SPIN_CAP (1u << 18)

__device__ __forceinline__ unsigned xb_ld(unsigned* p)              { return __hip_atomic_load(p, __ATOMIC_RELAXED, __HIP_MEMORY_SCOPE_AGENT); }
__device__ __forceinline__ unsigned xb_add(unsigned* p, unsigned v) { return __hip_atomic_fetch_add(p, v, __ATOMIC_RELAXED, __HIP_MEMORY_SCOPE_AGENT); }
__device__ __forceinline__ unsigned xb_xcc_id() { return (unsigned)__builtin_amdgcn_s_getreg((3 << 11) | 20) & 0xFu; }
#define XB_SPIN(cond, bar) do { unsigned _sp = 0; while (cond) { __builtin_amdgcn_s_sleep(1); \
    if ((++_sp & 255u) == 0u) { if (xb_ld(&(bar)[XB_TMO])) break; if (_sp > XB_SPIN_CAP) { atomicAdd(&(bar)[XB_TMO], 1u); break; } } } } while (0)

struct XcdBarrier {
    unsigned* bar; unsigned x;
    volatile LAS unsigned* st;
};

__device__ __forceinline__ XcdBarrier xcd_barrier_post(unsigned* bar, volatile LAS unsigned* st) {
    XcdBarrier b; b.bar = bar; b.x = xb_xcc_id(); b.st = st;
    if (threadIdx.x == 0) (void)xb_add(&bar[XB_XCNT(b.x)], 1u);
    return b;
}
__device__ __forceinline__ void xcd_barrier_complete(unsigned* bar, unsigned x, unsigned& nloc, unsigned& nx) {
    const unsigned G = gridDim.x * gridDim.y * gridDim.z;
    unsigned sum, cnt, mine, sp = 0u;
    for (;;) {
        sum = 0u; cnt = 0u; mine = 0u;
#pragma unroll
        for (unsigned j = 0; j < 16; ++j) { const unsigned c = xb_ld(&bar[XB_XCNT(j)]); sum += c; cnt += (c > 0u) ? 1u : 0u; mine = (j == x) ? c : mine; }
        if (sum == G) break;
        __builtin_amdgcn_s_sleep(1);
        if ((++sp & 255u) == 0u) { if (xb_ld(&bar[XB_TMO])) break; if (sp > XB_SPIN_CAP) { atomicAdd(&bar[XB_TMO], 1u); break; } }
    }
    nloc = mine > 0u ? mine : 1u; nx = cnt > 0u ? cnt : 1u;
}

__device__ __forceinline__ void xcd_barrier(const XcdBarrier& b) {
    asm volatile("s_waitcnt vmcnt(0)" ::: "memory");
    __syncthreads();
    if (threadIdx.x == 0) {
        unsigned* bar = b.bar;
        __builtin_amdgcn_s_waitcnt(0);
        unsigned nloc = b.st[0], nx = b.st[1];
        if (nloc == 0u) { xcd_barrier_complete(bar, b.x, nloc, nx); b.st[0] = nloc; b.st[1] = nx; }
        const unsigned old = xb_add(&bar[XB_XSUB(b.x)], 1u);
        const unsigned gen = old / nloc;
        if (old + 1u == (gen + 1u) * nloc) {
            __builtin_amdgcn_fence(__ATOMIC_RELEASE, "agent");
            asm volatile("s_waitcnt vmcnt(0)" ::: "memory");
            const unsigned og = xb_add(&bar[XB_TOP], 1u);
            const unsigned tg = og / nx;
            if (og + 1u == (tg + 1u) * nx) xb_add(&bar[XB_TOPGEN], 1u);
            else XB_SPIN(xb_ld(&bar[XB_TOPGEN]) == tg, bar);
            __builtin_amdgcn_fence(__ATOMIC_ACQUIRE, "agent");
            xb_add(&bar[XB_XGEN(b.x)], 1u);
            asm volatile("s_waitcnt vmcnt(0)" ::: "memory");
        } else {
            XB_SPIN(xb_ld(&bar[XB_XGEN(b.x)]) == gen, bar);
            __builtin_amdgcn_fence(__ATOMIC_ACQUIRE, "agent");
            asm volatile("s_waitcnt vmcnt(0)" ::: "memory");
        }
    }
    __syncthreads();
}

__device__ __forceinline__ void p0_transpose_item(const float* W, int K, int N, bf16* WT, int k0, int n0, int drow0, const float* kscale, LAS float* scr, int lane) {
    const int c = lane & 7;
    f32x4 ks0 = {1.f, 1.f, 1.f, 1.f}, ks1 = {1.f, 1.f, 1.f, 1.f};
    if (kscale) { ks0 = *(const f32x4*)(kscale + k0 + 8 * c); ks1 = *(const f32x4*)(kscale + k0 + 8 * c + 4); }
    const float* wp = W + (size_t)(k0 + (lane >> 5)) * N + n0 + (lane & 31);
#pragma unroll
    for (int i = 0; i < 32; ++i) scr[(2 * i + (lane >> 5)) * 33 + (lane & 31)] = __builtin_nontemporal_load(wp + (size_t)(2 * i) * N);
    LDS_WAIT(); asm volatile("" ::: "memory");
#pragma unroll
    for (int j = 0; j < 4; ++j) { const int n = (lane >> 3) + 8 * j; const LAS float* s = scr + (8 * c) * 33 + n;
        v4u o; o.x = pk2(s[0 * 33] * ks0.x, s[1 * 33] * ks0.y); o.y = pk2(s[2 * 33] * ks0.z, s[3 * 33] * ks0.w); o.z = pk2(s[4 * 33] * ks1.x, s[5 * 33] * ks1.y); o.w = pk2(s[6 * 33] * ks1.z, s[7 * 33] * ks1.w);
        *(v4u*)(WT + (size_t)(drow0 + n) * K + k0 + 8 * c) = o; }
    LDS_WAIT(); asm volatile("" ::: "memory");
}

__device__ __forceinline__ void convert_weights(const Args& a, int l, LAS unsigned char* lds, int lane, int wave, int w, int nw, int part = 4  ) {
    unsigned char* ws = gws(a);
    LAS float* scr = (LAS float*)(lds + wave * 16384);
    constexpr int IT_IN = 16 * 80, IT_OUT = 16 * 32, IT_G = 16 * 88, IT_D = 44 * 32;
    constexpr int NITEMS = IT_IN + IT_OUT + 2 * IT_G + IT_D;
    const int it_lo = part == 4 ? 0 : (part == 0 ? 0 : part == 1 ? IT_IN : part == 2 ? IT_IN + IT_OUT : IT_IN + IT_OUT + 2 * IT_G);
    const int it_hi = part == 4 ? NITEMS : (part == 0 ? IT_IN : part == 1 ? IT_IN + IT_OUT : part == 2 ? IT_IN + IT_OUT + 2 * IT_G : NITEMS);
    for (int it = it_lo + w; it < it_hi; it += nw) {
        int r = it;
        if (r < IT_IN) { const int kb = r / 80, nb = r % 80;
            p0_transpose_item(gp(a, I_WIN) + (size_t)l * DM * D_IN, DM, D_IN, (bf16*)(ws + WS_WIN) + (size_t)l * D_IN * DM, 64 * kb, 32 * nb, 32 * nb, gp(a, I_NMIX) + l * DM, scr, lane); continue; }
        r -= IT_IN;
        if (r < IT_OUT) { const int kb = r / 32, nb = r % 32;
            p0_transpose_item(gp(a, I_WOUT) + (size_t)l * DM * DM, DM, DM, (bf16*)(ws + WS_WOUT) + (size_t)l * DM * DM, 64 * kb, 32 * nb, 32 * nb, nullptr, scr, lane); continue; }
        r -= IT_OUT;
        if (r < 2 * IT_G) { const int sel = r / IT_G; r -= sel * IT_G; const int kb = r / 88, nb = r % 88; const int n0 = 32 * nb;
            const int drow0 = 256 * (n0 >> 7) + 128 * sel + (n0 & 127);
            p0_transpose_item(gp(a, sel ? I_WU : I_WG) + (size_t)l * DM * D_FF, DM, D_FF, (bf16*)(ws + WS_WGU) + (size_t)l * 2 * D_FF * DM, 64 * kb, n0, drow0, gp(a, I_NFFN) + l * DM, scr, lane); continue; }
        r -= 2 * IT_G;
        { const int kb = r / 32, nb = r % 32;
            p0_transpose_item(gp(a, I_WD) + (size_t)l * D_FF * DM, D_FF, DM, (bf16*)(ws + WS_WDN) + (size_t)l * DM * D_FF, 64 * kb, 32 * nb, 32 * nb, nullptr, scr, lane); }
    }
}

__device__ __forceinline__ void p0_prologue(const Args& a, LAS unsigned char* lds, int tid, int lane, int wave) {
    unsigned char* ws = gws(a);
    LAS float* scr = (LAS float*)(lds + wave * 16384);
    const int gw = blockIdx.x * NWAVES + wave, NGW = gridDim.x * NWAVES;
    convert_weights(a, 0, lds, lane, wave, gw, NGW, 0);
    {
        bf16* XB = (bf16*)(ws + WS_XB); float* SS0 = (float*)(ws + WS_SSP);
        for (int m0 = gw; m0 < M_TOK; m0 += 3 * NGW) {
            f32x4 v[3][4];
#pragma unroll
            for (int r = 0; r < 3; ++r) { const int m = m0 + r * NGW; if (m < M_TOK) { const float* xrow = (m < M_PROMPT) ? gp(a, I_XP) + (size_t)m * DM : gp(a, I_XS) + (size_t)(m - M_PROMPT) * DM; const f32x4* xr = (const f32x4*)xrow + lane;
#pragma unroll
                for (int j = 0; j < 4; ++j) v[r][j] = __builtin_nontemporal_load(xr + 64 * j); } }
#pragma unroll
            for (int r = 0; r < 3; ++r) { const int m = m0 + r * NGW; if (m < M_TOK) { float s = 0.f; unsigned long long* o8 = (unsigned long long*)(XB + (size_t)m * DM) + lane;
#pragma unroll
                for (int j = 0; j < 4; ++j) { const f32x4 x = v[r][j]; s += (x.x * x.x + x.y * x.y) + (x.z * x.z + x.w * x.w); o8[64 * j] = (unsigned long long)pk2(x.x, x.y) | ((unsigned long long)pk2(x.z, x.w) << 32); }
                s = wave_sum(s); if (lane < 16) SS0[(size_t)m * 16 + lane] = (lane == 0) ? s : 0.f; } }
        }
    }
    unsigned char* sm = ws + WS_SMALL;
    const int NGT = gridDim.x * NTHREADS, gt = NGT - 1 - (blockIdx.x * NTHREADS + tid);
    for (int i = gt; i < 2 * DA; i += NGT) {
        const int l = i / DA, j = i % DA; float v = 0.f;
        if (l == 1) { const float l0 = gp(a, I_HLB)[j], l1 = gp(a, I_HLB)[DA + j]; v = 1.0f / (1.0f + expf(l0 - l1)); }
        ((float*)(sm + SM_LBS))[i] = v;
    }
    for (int i = gt; i < 2 * DC; i += NGT) { const float lam = gp(a, I_LLAM)[i]; ((float*)(sm + SM_SP))[i] = -8.0f * log1pf(expf(-lam)); }
    for (int i = gt; i < 2 * 16 * 64; i += NGT) {
        const int lg = i >> 6, p = i & 63;
        const float dt = expf(gp(a, I_S5DT)[lg]); const float lr = fminf(gp(a, I_S5LR)[i], -1e-4f), li = gp(a, I_S5LI)[i];
        const float mag = expf(lr * dt); const float are = mag * cosf(li * dt), aim = mag * sinf(li * dt);
        ((f32x2v*)(sm + SM_S5A))[i] = (f32x2v){are, aim};
        float pr = are, pi = aim;
#pragma unroll
        for (int s = 0; s < 6; ++s) { const float nr_ = pr * pr - pi * pi, ni_ = 2.0f * pr * pi; pr = nr_; pi = ni_; }
        ((f32x2v*)(sm + SM_S5A64))[i] = (f32x2v){pr, pi};
        const float den = lr * lr + li * li, nr = are - 1.0f;
        const float gre = (nr * lr + aim * li) / den, gim = (aim * lr - nr * li) / den;
        bf16* BB = (bf16*)(sm + SM_BB) + ((size_t)lg * 128 + 2 * p) * 16;
#pragma unroll
        for (int n = 0; n < 16; ++n) { const float br = gp(a, I_S5BR)[(size_t)i * 16 + n], bi = gp(a, I_S5BI)[(size_t)i * 16 + n];
            BB[n] = f2bf(gre * br - gim * bi); BB[16 + n] = f2bf(gre * bi + gim * br); }
        bf16* CC = (bf16*)(sm + SM_CC) + (size_t)lg * 16 * 128;
#pragma unroll
        for (int n = 0; n < 16; ++n) { const float cr = gp(a, I_S5CR)[((size_t)lg * 16 + n) * 64 + p], ci = gp(a, I_S5CI)[((size_t)lg * 16 + n) * 64 + p];
            CC[n * 128 + 2 * p] = f2bf(cr); CC[n * 128 + 2 * p + 1] = f2bf(-ci); }
    }
    for (int i = gt; i < 2 * 256 * 256; i += NGT) { const int l = i >> 16, n = (i >> 8) & 255, k = i & 255; ((bf16*)(sm + SM_WGT))[i] = f2bf(gp(a, I_S5WG)[((size_t)l * 256 + k) * 256 + n]); }
    for (int i = gt; i < 2 * 6 * 64 * 64; i += NGT) { const int lh = i >> 12, j = (i >> 6) & 63, ii = i & 63;
        ((bf16*)(sm + SM_WAT))[i] = f2bf(gp(a, I_LWA)[((size_t)lh * 64 + ii) * 64 + j]); ((bf16*)(sm + SM_WXT))[i] = f2bf(gp(a, I_LWX)[((size_t)lh * 64 + ii) * 64 + j]); }
}

constexpr int HG_S = 72;
constexpr int HG_QG = 0, HG_KG = 2304, HG_QE = 4608, HG_KET = 6912, HG_VT = 8960, HG_EGL = 11008, HG_GT = 11264, HG_WAVE_BYTES = 13568;
template <int CTRL> __device__ __forceinline__ float dpp_f(float v) { return __int_as_float(__builtin_amdgcn_update_dpp(0, __float_as_int(v), CTRL, 0xF, 0xF, true)); }
__device__ __forceinline__ float bfe(const v4u (&w)[2], int e) { const unsigned x = w[e >> 3][(e >> 1) & 3]; return __uint_as_float((e & 1) ? (x & 0xffff0000u) : (x << 16)); }
__device__ __forceinline__ bf16 bfraw(const v4u (&w)[2], int e) { const unsigned x = w[e >> 3][(e >> 1) & 3]; return (bf16)((e & 1) ? (x >> 16) : (x & 0xffffu)); }
template <bool OUT>
__device__ __forceinline__ void hgrn_unit(const Args& a, int layer, int cid, int h, LAS unsigned char* wl, int lane) {
    const int fr = lane & 15, fq = lane >> 4;
    unsigned char* ws = gws(a);
    const bf16* proj = (const bf16*)(ws + WS_PROJ) + (size_t)cid * 64 * D_IN;
    const float* lbp = (const float*)(ws + WS_SMALL + SM_LBS) + layer * DA + h * 64 + 16 * fq;
    float* HST = (float*)(ws + WS_HST);
    f32x4 S[4][4];
    {
        const float* s0 = nullptr;
        if (cid >= NPCH) s0 = gp(a, I_SH) + (((size_t)layer * 32 + (cid - NPCH)) * 6 + h) * 4096;
        else if (OUT && (cid & 63) != 0) s0 = HST + ((size_t)(cid - 1) * 6 + h) * 4096;
        if (s0) {
            const float* sp = s0 + (4 * fq) * 64 + fr;
#pragma unroll
            for (int dt = 0; dt < 4; ++dt)
#pragma unroll
                for (int vt = 0; vt < 4; ++vt)
#pragma unroll
                    for (int j = 0; j < 4; ++j) S[dt][vt][j] = ldg<true>(sp + (16 * dt + j) * 64 + 16 * vt);
        } else {
#pragma unroll
            for (int dt = 0; dt < 4; ++dt)
#pragma unroll
                for (int vt = 0; vt < 4; ++vt) S[dt][vt] = (f32x4){0.f, 0.f, 0.f, 0.f};
        }
    }
    float gtot[OUT ? 1 : 16];
#pragma unroll
    for (int e = 0; e < (OUT ? 1 : 16); ++e) gtot[e] = 0.f;
    LAS bf16* QG = (LAS bf16*)(wl + HG_QG); LAS bf16* KG = (LAS bf16*)(wl + HG_KG); LAS bf16* QE = (LAS bf16*)(wl + HG_QE);
    LAS bf16* KET = (LAS bf16*)(wl + HG_KET); LAS bf16* VT = (LAS bf16*)(wl + HG_VT); LAS float* EGL = (LAS float*)(wl + HG_EGL); LAS bf16* GT = (LAS bf16*)(wl + HG_GT);
    const bf16x8 zero8 = {0, 0, 0, 0, 0, 0, 0, 0};
    const int rb7 = (lane & 48) | 7, rb15 = (lane & 48) | 15;
#pragma unroll 1
    for (int sb = 0; sb < 4; ++sb) {
        const bf16* prow = proj + (size_t)(sb * 16 + fr) * D_IN + h * 64 + 16 * fq;
        {
            v4u fw[2], iw[2], qw[2], gw[2];
            fw[0] = ldg<OUT>((const v4u*)(prow + CF)); fw[1] = ldg<OUT>((const v4u*)(prow + CF + 8)); iw[0] = ldg<OUT>((const v4u*)(prow + CI)); iw[1] = ldg<OUT>((const v4u*)(prow + CI + 8));
            if (OUT) { qw[0] = ldg<true>((const v4u*)(prow + CQ)); qw[1] = ldg<true>((const v4u*)(prow + CQ + 8)); gw[0] = ldg<true>((const v4u*)(prow + CG)); gw[1] = ldg<true>((const v4u*)(prow + CG + 8)); }
            f32x4 lb4[4];
#pragma unroll
            for (int q = 0; q < 4; ++q) lb4[q] = *(const f32x4*)(lbp + 4 * q);
            float G[16], kv[16];
#pragma unroll
            for (int e = 0; e < 16; ++e) { const float lb = lb4[e >> 2][e & 3], oml = 1.0f - lb; const float sg = sigm(bfe(fw, e));
                kv[e] = oml * (1.0f - sg); G[e] = __logf(lb + oml * sg); }
#pragma unroll
            for (int e = 0; e < 16; ++e) { G[e] += dpp_f<0x111>(G[e]); G[e] += dpp_f<0x112>(G[e]); G[e] += dpp_f<0x114>(G[e]); G[e] += dpp_f<0x118>(G[e]); }
            unsigned qgp[8], kgp[8], qep[8]; float egl[16];
#pragma unroll
            for (int e = 0; e < 16; e += 2) {
                float qg2[2], kg2[2], qe2[2];
#pragma unroll
                for (int o = 0; o < 2; ++o) { const int ee = e + o;
                    const float Gr = __shfl(G[ee], rb7), Gl = __shfl(G[ee], rb15);
                    const float eGr = __expf(Gr), eGlr = __expf(Gl - Gr); egl[ee] = eGr * eGlr; if (!OUT) gtot[ee] += Gl;
                    const float e2 = __expf(Gr - G[ee]); const float kg = kv[ee] * e2;
                    KET[(16 * fq + ee) * 16 + fr] = f2bf(kg * eGlr);
                    VT[(16 * fq + ee) * 16 + fr] = bfraw(iw, ee);
                    if (OUT) { const float e1 = __expf(G[ee] - Gr); const float qg = bfe(qw, ee) * e1; qg2[o] = qg; kg2[o] = kg; qe2[o] = qg * eGr; } }
                if (OUT) { qgp[e >> 1] = pk2(qg2[0], qg2[1]); kgp[e >> 1] = pk2(kg2[0], kg2[1]); qep[e >> 1] = pk2(qe2[0], qe2[1]); }
            }
            if (fr == 15) {
#pragma unroll
                for (int q = 0; q < 4; ++q) *(LAS f32x4*)(EGL + 16 * fq + 4 * q) = (f32x4){egl[4 * q], egl[4 * q + 1], egl[4 * q + 2], egl[4 * q + 3]}; }
            if (OUT) {
                *(LAS v4u*)(QG + fr * HG_S + 16 * fq) = (v4u){qgp[0], qgp[1], qgp[2], qgp[3]}; *(LAS v4u*)(QG + fr * HG_S + 16 * fq + 8) = (v4u){qgp[4], qgp[5], qgp[6], qgp[7]};
                *(LAS v4u*)(KG + fr * HG_S + 16 * fq) = (v4u){kgp[0], kgp[1], kgp[2], kgp[3]}; *(LAS v4u*)(KG + fr * HG_S + 16 * fq + 8) = (v4u){kgp[4], kgp[5], kgp[6], kgp[7]};
                *(LAS v4u*)(QE + fr * HG_S + 16 * fq) = (v4u){qep[0], qep[1], qep[2], qep[3]}; *(LAS v4u*)(QE + fr * HG_S + 16 * fq + 8) = (v4u){qep[4], qep[5], qep[6], qep[7]};
                *(LAS v4u*)(GT + fr * HG_S + 16 * fq) = gw[0]; *(LAS v4u*)(GT + fr * HG_S + 16 * fq + 8) = gw[1];
            }
        }
        WAVE_SYNC();
        if (OUT) {
            f32x4 at = {0.f, 0.f, 0.f, 0.f};
#pragma unroll
            for (int kk = 0; kk < 2; ++kk) { const bf16x8 A = *(const LAS bf16x8*)(KG + fr * HG_S + kk * 32 + fq * 8), B = *(const LAS bf16x8*)(QG + fr * HG_S + kk * 32 + fq * 8); at = MFMA16(A, B, at); }
#pragma unroll
            for (int j = 0; j < 4; ++j) if (4 * fq + j > fr) at[j] = 0.f;
            union { bf16x8 v; unsigned u[4]; } Aatt; Aatt.u[0] = pk2(at[0], at[1]); Aatt.u[1] = pk2(at[2], at[3]); Aatt.u[2] = 0u; Aatt.u[3] = 0u;
            union { bf16x8 v; v2u h[2]; } Aq[2];
#pragma unroll
            for (int kk = 0; kk < 2; ++kk) { Aq[kk].h[0] = *(const LAS v2u*)(QE + fr * HG_S + kk * 32 + 4 * fq); Aq[kk].h[1] = *(const LAS v2u*)(QE + fr * HG_S + kk * 32 + 16 + 4 * fq); }
            f32x4 ov[4]; float ssq[4] = {0.f, 0.f, 0.f, 0.f};
#pragma unroll
            for (int vt = 0; vt < 4; ++vt) {
                union { bf16x8 v; v2u h[2]; } Bv; Bv.h[0] = *(const LAS v2u*)(VT + (16 * vt + fr) * 16 + 4 * fq); Bv.h[1] = (v2u){0u, 0u};
                f32x4 o = {0.f, 0.f, 0.f, 0.f};
                o = MFMA16(Aatt.v, Bv.v, o);
#pragma unroll
                for (int kk = 0; kk < 2; ++kk) { union { bf16x8 v; unsigned u[4]; } Bs;
                    Bs.u[0] = pk2(S[2 * kk][vt][0], S[2 * kk][vt][1]); Bs.u[1] = pk2(S[2 * kk][vt][2], S[2 * kk][vt][3]);
                    Bs.u[2] = pk2(S[2 * kk + 1][vt][0], S[2 * kk + 1][vt][1]); Bs.u[3] = pk2(S[2 * kk + 1][vt][2], S[2 * kk + 1][vt][3]);
                    o = MFMA16(Aq[kk].v, Bs.v, o); }
                ov[vt] = o;
#pragma unroll
                for (int j = 0; j < 4; ++j) ssq[j] += o[j] * o[j];
            }
#pragma unroll
            for (int j = 0; j < 4; ++j) { float s = ssq[j]; s += __shfl_xor(s, 1); s += __shfl_xor(s, 2); s += __shfl_xor(s, 4); s += __shfl_xor(s, 8); ssq[j] = __builtin_amdgcn_rsqf(s * (1.0f / 64.0f) + EPS); }
#pragma unroll
            for (int vt = 0; vt < 4; ++vt) { const float nw = gp(a, I_HNORM)[layer * DA + h * 64 + 16 * vt + fr];
#pragma unroll
                for (int j = 0; j < 4; ++j) { const int t = 4 * fq + j; const float g = bf2f(GT[t * HG_S + 16 * vt + fr]);
                    QG[t * HG_S + 16 * vt + fr] = f2bf(ov[vt][j] * ssq[j] * nw * g * sigm(g)); } }
            WAVE_SYNC();
            { const v4u o0 = *(const LAS v4u*)(QG + fr * HG_S + 8 * fq), o1 = *(const LAS v4u*)(QG + fr * HG_S + 32 + 8 * fq);
              bf16* dst = (bf16*)(ws + WS_MIX) + ((size_t)cid * 64 + sb * 16 + fr) * DM + h * 64 + 8 * fq; *(v4u*)dst = o0; *(v4u*)(dst + 32) = o1; }
        }
        {
            bf16x8 Bv[4];
#pragma unroll
            for (int vt = 0; vt < 4; ++vt) Bv[vt] = (fq < 2) ? *(const LAS bf16x8*)(VT + (16 * vt + fr) * 16 + fq * 8) : zero8;
#pragma unroll
            for (int dt = 0; dt < 4; ++dt) { const f32x4 eg = *(const LAS f32x4*)(EGL + 16 * dt + 4 * fq);
                const bf16x8 A = (fq < 2) ? *(const LAS bf16x8*)(KET + (16 * dt + fr) * 16 + fq * 8) : zero8;
#pragma unroll
                for (int vt = 0; vt < 4; ++vt) S[dt][vt] = MFMA16(A, Bv[vt], S[dt][vt] * eg); }
        }
        WAVE_SYNC();
    }
    {
        float* dst = nullptr;
        if (OUT) { if (cid >= NPCH) dst = gout(a) + O_HS + (((size_t)layer * 32 + (cid - NPCH)) * 6 + h) * 4096;
                   else if ((cid & 63) == 63) dst = gout(a) + O_HP + (((size_t)layer * 4 + (cid >> 6)) * 6 + h) * 4096; }
        else { dst = HST + ((size_t)cid * 6 + h) * 4096;
            if (fr == 0) { float* hd = (float*)(ws + WS_HD) + ((size_t)cid * 6 + h) * 64 + 16 * fq;
#pragma unroll
                for (int q = 0; q < 4; ++q) *(f32x4*)(hd + 4 * q) = (f32x4){__expf(gtot[(OUT ? 0 : 4 * q)]), __expf(gtot[(OUT ? 0 : 4 * q + 1)]), __expf(gtot[(OUT ? 0 : 4 * q + 2)]), __expf(gtot[(OUT ? 0 : 4 * q + 3)])}; } }
        if (dst) {
#pragma unroll
            for (int dt = 0; dt < 4; ++dt)
#pragma unroll
                for (int vt = 0; vt < 4; ++vt)
#pragma unroll
                    for (int j = 0; j < 4; ++j) { float* q_ = dst + (4 * fq) * 64 + fr + (16 * dt + j) * 64 + 16 * vt; if (OUT) __builtin_nontemporal_store(S[dt][vt][j], q_); else *q_ = S[dt][vt][j]; }
        }
    }
}

constexpr int S5_US = 264, S5_BS = 132, S5_HS = 136;
constexpr int S5_UT = 0, S5_BUT = 8448, S5_HT = 76032, S5_ZT = 110848, S5_ZF = 119296;
template <bool OUT>
__device__ __forceinline__ void s5_phase(const Args& a, int layer, LAS unsigned char* lds, int tid, int lane, int wave, int NU) {
    const int fr = lane & 15, fq = lane >> 4;
    unsigned char* ws = gws(a); const unsigned char* sm = ws + WS_SMALL;
    f32x2v* ST = (f32x2v*)(ws + WS_S5ST);
    LAS bf16* UT = (LAS bf16*)(lds + S5_UT); LAS float* BUT = (LAS float*)(lds + S5_BUT) + wave * (16 * S5_BS); LAS bf16* HT = (LAS bf16*)(lds + S5_HT) + wave * (16 * S5_HS);
    LAS bf16* ZT = (LAS bf16*)(lds + S5_ZT); LAS float* ZF = (LAS float*)(lds + S5_ZF);
    const bf16x8 zero8 = {0, 0, 0, 0, 0, 0, 0, 0};
    bf16x8 BBr[8], CCr[2][4], WGr[2][8]; float are[2], aim[2], dd[2], bgv[2];
    {
        const bf16* BB = (const bf16*)(sm + SM_BB) + ((size_t)(layer * 16 + (fq < 2 ? wave : 8 + wave)) * 128) * 16;
#pragma unroll
        for (int nt = 0; nt < 8; ++nt) BBr[nt] = *(const bf16x8*)(BB + (16 * nt + fr) * 16 + (fq & 1) * 8);
    }
    const int r_ut = tid >> 5, c8 = (tid & 31) * 8;
#pragma unroll
    for (int hf = 0; hf < 2; ++hf) { const int g = hf * 8 + wave;
        const f32x2v av = ((const f32x2v*)(sm + SM_S5A))[(layer * 16 + g) * 64 + lane]; are[hf] = av.x; aim[hf] = av.y;
        if (OUT) { const bf16* CC = (const bf16*)(sm + SM_CC) + (size_t)(layer * 16 + g) * 16 * 128;
#pragma unroll
            for (int kk = 0; kk < 4; ++kk) CCr[hf][kk] = *(const bf16x8*)(CC + fr * 128 + 32 * kk + 8 * fq);
            dd[hf] = gp(a, I_S5D)[layer * DB + g * 16 + fr]; } }
    if (OUT) { const bf16* WG = (const bf16*)(sm + SM_WGT) + (size_t)layer * 65536;
#pragma unroll
        for (int i = 0; i < 2; ++i) { const int nt = 2 * wave + i;
#pragma unroll
            for (int kk = 0; kk < 8; ++kk) WGr[i][kk] = *(const bf16x8*)(WG + (size_t)(16 * nt + fr) * 256 + 32 * kk + 8 * fq);
            bgv[i] = gp(a, I_S5BG)[layer * DB + 16 * nt + fr]; }
        }
#pragma unroll 1
    for (int u = blockIdx.x; u < NU; u += gridDim.x) {
        const int cid = OUT ? u : (u / 63) * 64 + (u % 63);
        const bf16* proj = (const bf16*)(ws + WS_PROJ) + (size_t)cid * 64 * D_IN;
        float hre[2], him[2];
#pragma unroll
        for (int hf = 0; hf < 2; ++hf) { const int g = hf * 8 + wave;
            if (cid >= NPCH) { const size_t o = (((size_t)layer * 32 + (cid - NPCH)) * 16 + g) * 64 + lane; hre[hf] = gp(a, I_SSR)[o]; him[hf] = gp(a, I_SSI)[o]; }
            else if (OUT && (cid & 63) != 0) { const f32x2v hv = ST[((size_t)(cid - 1) * 16 + g) * 64 + lane]; hre[hf] = hv.x; him[hf] = hv.y; }
            else { hre[hf] = 0.f; him[hf] = 0.f; } }
        v4u unext = ldg<OUT>((const v4u*)(proj + (size_t)r_ut * D_IN + CU + c8));
#pragma unroll 1
        for (int tt = 0; tt < 4; ++tt) {
            *(LAS v4u*)(UT + r_ut * S5_US + c8) = unext;
            if (tt < 3) unext = ldg<OUT>((const v4u*)(proj + (size_t)((tt + 1) * 16 + r_ut) * D_IN + CU + c8));
            BSYNC();
#pragma unroll
            for (int hf = 0; hf < 2; ++hf) {
                const int g = hf * 8 + wave;
                {
                    const bf16x8 A = ((fq < 2) == (hf == 0)) ? *(const LAS bf16x8*)(UT + fr * S5_US + g * 16 + (fq & 1) * 8) : zero8;
                    f32x4 cc[8];
#pragma unroll
                    for (int nt = 0; nt < 8; ++nt) { cc[nt] = (f32x4){0.f, 0.f, 0.f, 0.f}; cc[nt] = MFMA16(A, BBr[nt], cc[nt]); }
                    __builtin_amdgcn_sched_barrier(0); asm volatile("s_nop 7\n\ts_nop 7\n\ts_nop 7" ::: "memory"); __builtin_amdgcn_sched_barrier(0);
#pragma unroll
                    for (int nt = 0; nt < 8; ++nt)
#pragma unroll
                        for (int j = 0; j < 4; ++j) BUT[(4 * fq + j) * S5_BS + 16 * nt + fr] = cc[nt][j];
                }
                BSYNC();
                {
                    float hr = hre[hf], hi = him[hf]; const float ar = are[hf], ai = aim[hf];
#pragma unroll
                    for (int th = 0; th < 4; ++th) { f32x2v bv[4];
#pragma unroll
                        for (int t = 0; t < 4; ++t) bv[t] = *(const LAS f32x2v*)(BUT + (4 * th + t) * S5_BS + 2 * lane);
#pragma unroll
                        for (int t = 0; t < 4; ++t) { const float nr = ar * hr - ai * hi + bv[t].x, ni = ar * hi + ai * hr + bv[t].y; hr = nr; hi = ni;
                            if (OUT) *(LAS unsigned*)(HT + (4 * th + t) * S5_HS + 2 * lane) = pk2(hr, hi); } }
                    hre[hf] = hr; him[hf] = hi;
                }
                BSYNC();
                if (OUT) {
                    f32x4 y = {0.f, 0.f, 0.f, 0.f};
#pragma unroll
                    for (int kk = 0; kk < 4; ++kk) { const bf16x8 A = *(const LAS bf16x8*)(HT + fr * S5_HS + 32 * kk + 8 * fq); y = MFMA16(A, CCr[hf][kk], y); }
                    const int ch = g * 16 + fr;
#pragma unroll
                    for (int j = 0; j < 4; ++j) { const int tok = 4 * fq + j; const float uu = bf2f(UT[tok * S5_US + ch]); const float z = gelu_tanh(y[j] + dd[hf] * uu);
                        ZT[tok * S5_US + ch] = f2bf(z); ZF[tok * 256 + ch] = z; }
                }
            }
            if (OUT) {
                BSYNC();
#pragma unroll
                for (int i = 0; i < 2; ++i) { const int nt = 2 * wave + i; f32x4 p = {0.f, 0.f, 0.f, 0.f};
#pragma unroll
                    for (int kk = 0; kk < 8; ++kk) { const bf16x8 A = *(const LAS bf16x8*)(ZT + fr * S5_US + 32 * kk + 8 * fq); p = MFMA16(A, WGr[i][kk], p); }
                    const int n = 16 * nt + fr;
#pragma unroll
                    for (int j = 0; j < 4; ++j) { const int tok = 4 * fq + j; ZF[tok * 256 + n] = ZF[tok * 256 + n] * sigm(p[j] + bgv[i]); } }
                BSYNC();
                { const f32x4 v0 = *(const LAS f32x4*)(ZF + r_ut * 256 + c8), v1 = *(const LAS f32x4*)(ZF + r_ut * 256 + c8 + 4);
                  float s = (v0.x * v0.x + v0.y * v0.y) + (v0.z * v0.z + v0.w * v0.w) + (v1.x * v1.x + v1.y * v1.y) + (v1.z * v1.z + v1.w * v1.w);
                  s += __shfl_xor(s, 1); s += __shfl_xor(s, 2); s += __shfl_xor(s, 4); s += __shfl_xor(s, 8); s += __shfl_xor(s, 16);
                  const float rs = __builtin_amdgcn_rsqf(s * (1.0f / 256.0f) + EPS); const f32x4 nw0 = *(const f32x4*)(gp(a, I_S5N) + layer * DB + c8), nw1 = *(const f32x4*)(gp(a, I_S5N) + layer * DB + c8 + 4);
                  v4u o; o.x = pk2(v0.x * rs * nw0.x, v0.y * rs * nw0.y); o.y = pk2(v0.z * rs * nw0.z, v0.w * rs * nw0.w); o.z = pk2(v1.x * rs * nw1.x, v1.y * rs * nw1.y); o.w = pk2(v1.z * rs * nw1.z, v1.w * rs * nw1.w);
                  *(v4u*)((bf16*)(ws + WS_MIX) + ((size_t)cid * 64 + tt * 16 + r_ut) * DM + DA + c8) = o; }
            }
            BSYNC();
        }
#pragma unroll
        for (int hf = 0; hf < 2; ++hf) { const int g = hf * 8 + wave;
            if (OUT) { if (cid >= NPCH) { const size_t o = (((size_t)layer * 32 + (cid - NPCH)) * 16 + g) * 64 + lane; gout(a)[O_SRS + o] = hre[hf]; gout(a)[O_SIS + o] = him[hf]; }
                       else if ((cid & 63) == 63) { const size_t o = (((size_t)layer * 4 + (cid >> 6)) * 16 + g) * 64 + lane; gout(a)[O_SRP + o] = hre[hf]; gout(a)[O_SIP + o] = him[hf]; } }
            else ST[((size_t)cid * 16 + g) * 64 + lane] = (f32x2v){hre[hf], him[hf]}; }
    }
    __syncthreads();
}

constexpr int LR_XS = 392, LR_AS = 388;
constexpr int LR_XC = 0, LR_AL = 25088, LR_BL = 74752;
template <bool OUT>
__device__ __forceinline__ void lru_phase(const Args& a, int layer, LAS unsigned char* lds, int tid, int lane, int wave, int NU) {
    const int fr = lane & 15, fq = lane >> 4;
    unsigned char* ws = gws(a); const unsigned char* sm = ws + WS_SMALL;
    f32x2v* ST = (f32x2v*)(ws + WS_LRUST);
    LAS bf16* XC = (LAS bf16*)(lds + LR_XC); LAS float* AL = (LAS float*)(lds + LR_AL); LAS float* BL = (LAS float*)(lds + LR_BL);
    const bool act = tid < DC; const int c = act ? tid : 0;
    const float cw0 = gp(a, I_LCW)[(layer * 4 + 0) * DC + c], cw1 = gp(a, I_LCW)[(layer * 4 + 1) * DC + c], cw2 = gp(a, I_LCW)[(layer * 4 + 2) * DC + c], cw3 = gp(a, I_LCW)[(layer * 4 + 3) * DC + c];
    const float cb = gp(a, I_LCB)[layer * DC + c];
    bf16x8 BA0[3], BA1[3], BX0[3], BX1[3]; float bav[3], bxv[3], spv[3];
#pragma unroll
    for (int i = 0; i < 3; ++i) { const int ntg = 3 * wave + i, hd = ntg >> 2, jn = (ntg & 3) * 16; const int ch = 16 * ntg + fr;
        const bf16* WA = (const bf16*)(sm + SM_WAT) + ((size_t)(layer * 6 + hd) * 64 + jn + fr) * 64; const bf16* WX = (const bf16*)(sm + SM_WXT) + ((size_t)(layer * 6 + hd) * 64 + jn + fr) * 64;
        BA0[i] = *(const bf16x8*)(WA + 8 * fq); BA1[i] = *(const bf16x8*)(WA + 32 + 8 * fq); BX0[i] = *(const bf16x8*)(WX + 8 * fq); BX1[i] = *(const bf16x8*)(WX + 32 + 8 * fq);
        bav[i] = gp(a, I_LBA)[layer * DC + ch]; bxv[i] = gp(a, I_LBX)[layer * DC + ch]; spv[i] = ((const float*)(sm + SM_SP))[layer * DC + ch]; }
    const int ntok = tid >> 4, c0 = (tid & 15) * 24;
#pragma unroll 1
    for (int k = 0; k * (int)gridDim.x < NU; ++k) {
        const int G_ = (int)gridDim.x, u = k * G_ + (((int)blockIdx.x + G_ - (8 * k) % G_) % G_); if (u >= NU) continue;
        const int cid = OUT ? u : (u / 63) * 64 + (u % 63);
        const bf16* proj = (const bf16*)(ws + WS_PROJ) + (size_t)cid * 64 * D_IN;
        float xm3 = 0.f, xm2 = 0.f, xm1 = 0.f, h = 0.f, P = 1.f;
        if (cid >= NPCH) { const size_t sb = (size_t)layer * 32 + (cid - NPCH); xm3 = gp(a, I_SC)[(sb * 3 + 0) * DC + c]; xm2 = gp(a, I_SC)[(sb * 3 + 1) * DC + c]; xm1 = gp(a, I_SC)[(sb * 3 + 2) * DC + c]; h = gp(a, I_SL)[sb * DC + c]; }
        else if ((cid & 63) != 0) { xm3 = bf2f(proj[-3 * D_IN + CXR + c]); xm2 = bf2f(proj[-2 * D_IN + CXR + c]); xm1 = bf2f(proj[-1 * D_IN + CXR + c]); if (OUT) h = ST[(size_t)(cid - 1) * DC + c].y; }
#pragma unroll 1
        for (int tile = 0; tile < 2; ++tile) {
            const bf16* pr = proj + (size_t)tile * 32 * D_IN;
            bf16 gr[32];
            {   bf16 xr[32];
#pragma unroll
                for (int t = 0; t < 32; ++t) xr[t] = ldg<OUT>(pr + (size_t)t * D_IN + CXR + c);
                if (OUT) {
#pragma unroll
                    for (int t = 0; t < 32; ++t) gr[t] = ldg<true>(pr + (size_t)t * D_IN + CGR + c); }
                if (act) {
#pragma unroll
                    for (int t = 0; t < 32; ++t) { const float x = bf2f(xr[t]); const float xc = cb + cw0 * xm3 + cw1 * xm2 + cw2 * xm1 + cw3 * x; XC[t * LR_XS + c] = f2bf(xc); xm3 = xm2; xm2 = xm1; xm1 = x; } }
            }
            BSYNC();
#pragma unroll
            for (int i = 0; i < 3; ++i) { const int ntg = 3 * wave + i, hd = ntg >> 2; const int ch = 16 * ntg + fr;
#pragma unroll
                for (int mt = 0; mt < 2; ++mt) { const bf16x8 A0 = *(const LAS bf16x8*)(XC + (16 * mt + fr) * LR_XS + hd * 64 + 8 * fq), A1 = *(const LAS bf16x8*)(XC + (16 * mt + fr) * LR_XS + hd * 64 + 32 + 8 * fq);
                    f32x4 r = {0.f, 0.f, 0.f, 0.f}, ii = {0.f, 0.f, 0.f, 0.f};
                    r = MFMA16(A0, BA0[i], r); r = MFMA16(A1, BA1[i], r); ii = MFMA16(A0, BX0[i], ii); ii = MFMA16(A1, BX1[i], ii);
#pragma unroll
                    for (int j = 0; j < 4; ++j) { const int tok = 16 * mt + 4 * fq + j; const float rg = sigm(r[j] + bav[i]), ig = sigm(ii[j] + bxv[i]); const float la = spv[i] * rg; const float av = __expf(la);
                        const float xcv = bf2f(XC[tok * LR_XS + ch]); AL[tok * LR_AS + ch] = av; BL[tok * LR_AS + ch] = __builtin_amdgcn_sqrtf(fmaxf(1.0f - av * av, 0.f)) * ig * xcv; } } }
            BSYNC();
            if (act) {
#pragma unroll
                for (int t = 0; t < 32; ++t) { const float av = AL[t * LR_AS + c]; h = av * h + BL[t * LR_AS + c]; P *= av;
                    if (OUT) BL[t * LR_AS + c] = h * gelu_tanh(bf2f(gr[t])); }
            }
            if (OUT) {
                BSYNC();
                float v[24]; float s = 0.f; const int sub = tid & 15;
#pragma unroll
                for (int q = 0; q < 3; ++q) { const f32x4 x0 = *(const LAS f32x4*)(BL + ntok * LR_AS + 128 * q + 8 * sub), x1 = *(const LAS f32x4*)(BL + ntok * LR_AS + 128 * q + 8 * sub + 4);
                    v[8 * q] = x0.x; v[8 * q + 1] = x0.y; v[8 * q + 2] = x0.z; v[8 * q + 3] = x0.w; v[8 * q + 4] = x1.x; v[8 * q + 5] = x1.y; v[8 * q + 6] = x1.z; v[8 * q + 7] = x1.w;
                    s += ((x0.x * x0.x + x0.y * x0.y) + (x0.z * x0.z + x0.w * x0.w)) + ((x1.x * x1.x + x1.y * x1.y) + (x1.z * x1.z + x1.w * x1.w)); }
                s += __shfl_xor(s, 1); s += __shfl_xor(s, 2); s += __shfl_xor(s, 4); s += __shfl_xor(s, 8);
                const float rs = __builtin_amdgcn_rsqf(s * (1.0f / 384.0f) + EPS);
                bf16* dst = (bf16*)(ws + WS_MIX) + ((size_t)cid * 64 + tile * 32 + ntok) * DM + DA + DB + 8 * sub;
#pragma unroll
                for (int q = 0; q < 3; ++q) { const float* nw = gp(a, I_LNORM) + layer * DC + 128 * q + 8 * sub; const f32x4 n0 = *(const f32x4*)nw, n1 = *(const f32x4*)(nw + 4);
                    v4u o; o.x = pk2(v[8 * q] * rs * n0.x, v[8 * q + 1] * rs * n0.y); o.y = pk2(v[8 * q + 2] * rs * n0.z, v[8 * q + 3] * rs * n0.w);
                    o.z = pk2(v[8 * q + 4] * rs * n1.x, v[8 * q + 5] * rs * n1.y); o.w = pk2(v[8 * q + 6] * rs * n1.z, v[8 * q + 7] * rs * n1.w); *(v4u*)(dst + 128 * q) = o; }
            }
        }
        if (act) {
            if (OUT) {
                float* ho = nullptr; float* co = nullptr;
                if (cid >= NPCH) { const size_t sb = (size_t)layer * 32 + (cid - NPCH); ho = gout(a) + O_LS + sb * DC; co = gout(a) + O_CS + sb * 3 * DC; }
                else if ((cid & 63) == 63) { const size_t sb = (size_t)layer * 4 + (cid >> 6); ho = gout(a) + O_LP + sb * DC; co = gout(a) + O_CP + sb * 3 * DC; }
                if (ho) { ho[c] = h; co[c] = xm3; co[DC + c] = xm2; co[2 * DC + c] = xm1; }
            } else ST[(size_t)cid * DC + c] = (f32x2v){P, h};
        }
        __syncthreads();
    }
}

__device__ __forceinline__ void carry_phase(const Args& a, int layer, int tid) {
    unsigned char* ws = gws(a);
    const int gt = blockIdx.x * NTHREADS + tid, NGT = gridDim.x * NTHREADS;
    for (int i = gt; i < 4 * 6 * 4096; i += NGT) {
        const int b = i / 24576, rem = i % 24576, hh = rem >> 12, e = rem & 4095, d = e >> 6;
        float* HST = (float*)(ws + WS_HST) + ((size_t)(b * 64) * 6 + hh) * 4096 + e; const float* HD = (const float*)(ws + WS_HD) + ((size_t)(b * 64) * 6 + hh) * 64 + d;
        float S = 0.f;
#pragma unroll 21
        for (int cc = 0; cc < 63; ++cc) { S = HD[(size_t)cc * 6 * 64] * S + HST[(size_t)cc * 6 * 4096]; HST[(size_t)cc * 6 * 4096] = S; }
    }
    const int off5 = (NGT >= 4 * 6 * 4096 + 4 * 1024 + 4 * DC) ? 4 * 6 * 4096 : 0, offl = off5 ? off5 + 4 * 1024 : 0;
    for (int i = gt - off5; i < 4 * 1024; i += NGT) { if (i < 0) continue;
        const int b = i >> 10, gp = i & 1023; const f32x2v A = ((const f32x2v*)(ws + WS_SMALL + SM_S5A64))[layer * 1024 + gp];
        f32x2v* ST = (f32x2v*)(ws + WS_S5ST) + (size_t)(b * 64) * 1024 + gp; float hr = 0.f, hi = 0.f;
#pragma unroll 21
        for (int cc = 0; cc < 63; ++cc) { const f32x2v l = ST[(size_t)cc * 1024]; const float nr = A.x * hr - A.y * hi + l.x, ni = A.x * hi + A.y * hr + l.y; hr = nr; hi = ni; ST[(size_t)cc * 1024] = (f32x2v){hr, hi}; }
    }
    for (int i = gt - offl; i < 4 * DC; i += NGT) { if (i < 0) continue;
        const int b = i / DC, c = i % DC; f32x2v* ST = (f32x2v*)(ws + WS_LRUST) + (size_t)(b * 64) * DC + c; float h = 0.f;
#pragma unroll 21
        for (int cc = 0; cc < 63; ++cc) { const f32x2v l = ST[(size_t)cc * DC]; h = l.x * h + l.y; ST[(size_t)cc * DC] = (f32x2v){l.x, h}; }
    }
}

#ifndef MIXSLOW
#define MIXSLOW 0
#endif
#define MSLOW(bit) do { if (MIXSLOW) { asm volatile("s_waitcnt vmcnt(0) lgkmcnt(0)" ::: "memory"); __syncthreads(); const unsigned long long t1_ = __builtin_amdgcn_s_memrealtime(); if (MIXSLOW & (bit)) { const unsigned long long d_ = t1_ - t_m; while (__builtin_amdgcn_s_memrealtime() - t1_ < d_) __builtin_amdgcn_s_sleep(8); } t_m = __builtin_amdgcn_s_memrealtime(); } } while (0)
template <bool OUT>
__device__ __forceinline__ void mixer_phase(int layer, LAS unsigned char* lds, int tid0) {
#ifndef MIXSEL
#define MIXSEL 7
#endif
    unsigned long long t_m = MIXSLOW ? __builtin_amdgcn_s_memrealtime() : 0ull;
    if (MIXSEL & 1) {
        int tid = tid0; LAUNDER_V(tid); const int lane = tid & 63, wave = __builtin_amdgcn_readfirstlane(tid >> 6);
        const int gw = blockIdx.x * NWAVES + wave, NGW = gridDim.x * NWAVES;
        LAS unsigned char* wl = lds + wave * HG_WAVE_BYTES;
        const Args& a = kargs();
        if (OUT) {
            const int hb = ((int)gridDim.x * NWAVES > NCHUNK * 6) ? ((int)gridDim.x * NWAVES - NCHUNK * 6) / NWAVES : 0;
            if ((int)blockIdx.x >= hb) for (int u = ((int)blockIdx.x - hb) * NWAVES + wave; u < NCHUNK * 6; u += ((int)gridDim.x - hb) * NWAVES) hgrn_unit<true>(a, layer, u / 6, u % 6, wl, lane); }
        else     { for (int u = gw; u < 4 * 63 * 6; u += NGW) { const int b = u / 378, rem = u % 378; hgrn_unit<false>(a, layer, b * 64 + rem / 6, rem % 6, wl, lane); } }
    }
    __syncthreads();
    MSLOW(1);
    const int NU = OUT ? NCHUNK : 4 * 63;
    if (MIXSEL & 2) {
        int tid = tid0; LAUNDER_V(tid); const int lane = tid & 63, wave = __builtin_amdgcn_readfirstlane(tid >> 6);
        s5_phase<OUT>(kargs(), layer, lds, tid, lane, wave, NU);
    }
    MSLOW(2);
    if (MIXSEL & 4) {
        int tid = tid0; LAUNDER_V(tid); const int lane = tid & 63, wave = __builtin_amdgcn_readfirstlane(tid >> 6);
        lru_phase<OUT>(kargs(), layer, lds, tid, lane, wave, NU);
    }
    MSLOW(4);
}

__device__ __forceinline__ void final_norm(const Args& a, int lane, int wave) {
    const int gw = blockIdx.x * NWAVES + wave, NGW = gridDim.x * NWAVES;
    const float* SS = (const float*)(gws(a) + WS_SSP) + (size_t)4 * M_TOK * 16; const f32x4* nw = (const f32x4*)gp(a, I_NFIN) + lane;
    const bf16* XB = (const bf16*)(gws(a) + WS_XB);
    f32x4 w[4];
#pragma unroll
    for (int j = 0; j < 4; ++j) w[j] = nw[64 * j];
    for (int m = gw; m < M_TOK; m += NGW) { const float rs = pg8::row_rstd(SS, (size_t)m); f32x4* xr = (f32x4*)(gout(a) + (size_t)m * DM) + lane; const v2u* xb = (const v2u*)(XB + (size_t)m * DM) + lane;
#pragma unroll
        for (int j = 0; j < 4; ++j) { const v2u b = xb[64 * j]; f32x4 v; v[0] = __uint_as_float(b.x << 16); v[1] = __uint_as_float(b.x & 0xffff0000u); v[2] = __uint_as_float(b.y << 16); v[3] = __uint_as_float(b.y & 0xffff0000u);
            v = v * rs * w[j]; __builtin_nontemporal_store(v, xr + 64 * j); } }
}

#ifndef PHSEL
#define PHSEL 0xFF
#endif
#ifndef MK_MULTI
#define MK_MULTI 0
#endif
struct KArgs { Args a; int ph_lo, ph_hi; };
__global__ void __launch_bounds__(NTHREADS, 2) fwd_megakernel(KArgs ka) {
    extern __shared__ __attribute__((aligned(16))) unsigned char lds_raw[];
    LAS unsigned char* lds = (LAS unsigned char*)lds_raw;
    const int tid = threadIdx.x, lane = tid & 63, wave = __builtin_amdgcn_readfirstlane(tid >> 6);
    unsigned char* ws = ka.a.ws; float* const out = ka.a.out; unsigned char* const ws_early = ws;
    const Args& a = ka.a;
    float* SS = (float*)(ws + WS_SSP);
    bf16* XB = (bf16*)(ws + WS_XB); bf16* PROJ = (bf16*)(ws + WS_PROJ); bf16* MIX = (bf16*)(ws + WS_MIX); bf16* HID = (bf16*)(ws + WS_HID);
    int ph = 0;
#if MK_MULTI
#define SEAM() do { ++ph; } while (0)
#define RUN(b) (((PHSEL) >> (b)) & 1) && (ph >= ka.ph_lo && ph < ka.ph_hi)
#else
    cg::grid_group grid = cg::this_grid();
    volatile LAS unsigned* xb_st = (volatile LAS unsigned*)(lds + XB_LDS_OFF);
    if (threadIdx.x < 2) xb_st[threadIdx.x] = 0u;
    __syncthreads();
    const XcdBarrier xbar = xcd_barrier_post((unsigned*)(ws_early + WS_CTL + 16384), xb_st);
#define SEAM() do { if (ka.ph_hi < 0) grid.sync(); xcd_barrier(xbar); ++ph; } while (0)
#define RUN(b) ((((PHSEL) >> (b)) & 1) != 0)
#endif
#ifndef STOP_AFTER
#define STOP_AFTER 999
#endif
#ifndef DUMP_OFF
#define DUMP_OFF WS_MIX
#endif
#ifndef DUMP_F32
#define DUMP_F32 0
#endif
#define PROBE() do { if (ph == STOP_AFTER) { if (DUMP_F32 == 2) { const bf16* src = (const bf16*)(ws + WS_PROJ); for (size_t i = (size_t)blockIdx.x * NTHREADS + tid; i < (size_t)M_TOK * 256; i += (size_t)gridDim.x * NTHREADS) out[i] = bf2f(src[(i >> 8) * D_IN + CU + (i & 255)]); } else if (DUMP_F32) { const float* src = (const float*)(ws + DUMP_OFF); for (size_t i = (size_t)blockIdx.x * NTHREADS + tid; i < (size_t)7602176; i += (size_t)gridDim.x * NTHREADS) out[i] = src[i]; } \
    else { const bf16* src = (const bf16*)(ws + DUMP_OFF); for (size_t i = (size_t)blockIdx.x * NTHREADS + tid; i < (size_t)M_TOK * DM; i += (size_t)gridDim.x * NTHREADS) out[i] = bf2f(src[i]); } return; } } while (0)
#define IDLE_CONVERT(nwg_, lay_, part_) do { const int rem_ = (nwg_) % (int)gridDim.x; if ((int)blockIdx.x >= rem_) {     int t2 = tid; LAUNDER_V(t2); const int w2 = __builtin_amdgcn_readfirstlane(t2 >> 6); \
        convert_weights(kargs(), (lay_), lds, t2 & 63, w2, ((int)blockIdx.x - rem_) * NWAVES + w2, ((int)gridDim.x - rem_) * NWAVES, (part_)); } } while (0)
#ifndef SLOWMASK
#define SLOWMASK 0
#endif
    unsigned long long t_ph = SLOWMASK ? __builtin_amdgcn_s_memrealtime() : 0ull;
#define SLOW(bit) do { if (SLOWMASK) { const unsigned long long t1_ = __builtin_amdgcn_s_memrealtime(); if (SLOWMASK & (bit)) { const unsigned long long d_ = t1_ - t_ph; while (__builtin_amdgcn_s_memrealtime() - t1_ < d_) __builtin_amdgcn_s_sleep(8); } t_ph = __builtin_amdgcn_s_memrealtime(); } } while (0)
    if (RUN(0)) { int t3 = tid; LAUNDER_V(t3); p0_prologue(kargs(), lds, t3, t3 & 63, __builtin_amdgcn_readfirstlane(t3 >> 6)); if (blockIdx.x == 0 && tid < 38) ((unsigned long long*)(ws + WS_TAB))[tid] = (tid < 36) ? (unsigned long long)ka.a.in[tid] : (tid == 36 ? (unsigned long long)ka.a.out : (unsigned long long)ka.a.ws); }
    SEAM(); PROBE(); SLOW(1);
#pragma unroll 1
    for (int l = 0; l < 2; ++l) {
        if (RUN(1)) { pg8::Gemm g{XB, (const bf16*)(ws + WS_WIN) + (size_t)l * D_IN * DM, M_TOK, D_IN, DM}; pg8::StaticOrder S; S.init(M_TOK, D_IN, gridDim.x, blockIdx.x);
            pg8::EpiProj E{PROJ, D_IN, SS + (size_t)(2 * l) * M_TOK * 16};
            pg8::gemm_phase<pg8::EpiProj, pg8::StaticOrder, true, true>(lds, g, S, E);
            IDLE_CONVERT(72 * 10, l, 1); }
        SEAM(); PROBE(); SLOW(2);
        if (RUN(2)) mixer_phase<false>(l, lds, tid);
        SEAM(); PROBE(); SLOW(4);
        if (RUN(3)) { int t3 = tid; LAUNDER_V(t3); carry_phase(kargs(), l, t3); }
        SEAM(); PROBE(); SLOW(4);
        if (RUN(4)) mixer_phase<true>(l, lds, tid);
        SEAM(); PROBE(); SLOW(4);
        if (RUN(5)) { pg8::Gemm g{MIX, (const bf16*)(ws + WS_WOUT) + (size_t)l * DM * DM, M_TOK, DM, DM}; pg8::StaticOrder S; S.init(M_TOK, DM, gridDim.x, blockIdx.x);
            pg8::EpiRes E{XB, SS + (size_t)(2 * l + 1) * M_TOK * 16};
            pg8::gemm_phase<pg8::EpiRes, pg8::StaticOrder, true, true>(lds, g, S, E);
            IDLE_CONVERT(72 * 4, l, 2); IDLE_CONVERT(72 * 4, l, 3); if (l == 0) IDLE_CONVERT(72 * 4, 1, 0); }
        SEAM(); PROBE(); SLOW(8);
        {
            const int G_ = (int)gridDim.x, total = 72 * 22, full = (total / G_) * G_, c0 = total - full;
#define Wgu ((const bf16*)(ws + WS_WGU) + (size_t)l * 2 * D_FF * DM)
#define Wdn ((const bf16*)(ws + WS_WDN) + (size_t)l * DM * D_FF)
            const int nlow = (G_ == 256) ? 32 : 0, t_lo = G_ + 3 * nlow;
#pragma unroll 1
            for (int step = 0; step < 2; ++step) {
                if (step == 1 && RUN(6)) { pg8::Gemm g{HID, Wdn, M_TOK, DM, D_FF}; pg8::SampleOrder S; S.c0 = 0; S.c = (nlow ? (int)blockIdx.x : -1);
                    pg8::EpiRes E{XB, SS + (size_t)(2 * l + 2) * M_TOK * 16};
                    pg8::gemm_phase<pg8::EpiRes, pg8::SampleOrder, true, true>(lds, g, S, E); }
                if (RUN(6)) { pg8::Gemm g{XB, Wgu, M_TOK, 2 * D_FF, DM}; pg8::GuOrder S; S.init(M_PROMPT, 2 * D_FF, G_, blockIdx.x); S.npre = 8 * 22;
                    if (step == 0) { S.lo = 0; S.hi = G_; }
                    else if ((int)blockIdx.x < nlow) { S.G = nlow; S.lo = G_; S.hi = t_lo; }
                    else { S.G = G_ - nlow; S.c = (int)blockIdx.x - nlow; S.lo = t_lo; S.hi = total; }
                    pg8::EpiGateUp E{HID, D_FF, SS + (size_t)(2 * l + 1) * M_TOK * 16};
                    pg8::gemm_phase<pg8::EpiGateUp, pg8::GuOrder, true, true>(lds, g, S, E); }
                if (step == 0) xcd_barrier(xbar);
            }
            if (!nlow && RUN(6)) {
                xcd_barrier(xbar);
                pg8::Gemm g{HID, Wdn, M_TOK, DM, D_FF}; pg8::SampleOrder S; S.c0 = 0; S.c = blockIdx.x;
                pg8::EpiRes E{XB, SS + (size_t)(2 * l + 2) * M_TOK * 16};
                pg8::gemm_phase<pg8::EpiRes, pg8::SampleOrder, true, true>(lds, g, S, E); }
            SEAM(); PROBE(); SLOW(16);
            if (RUN(7)) { pg8::Gemm g{HID, Wdn, M_PROMPT, DM, D_FF}; pg8::StaticOrder S; S.init(M_PROMPT, DM, G_, blockIdx.x);
                pg8::EpiRes E{XB, SS + (size_t)(2 * l + 2) * M_TOK * 16};
                pg8::gemm_phase<pg8::EpiRes, pg8::StaticOrder, true, true>(lds, g, S, E); }
        }
        SEAM(); PROBE(); SLOW(32);
    }
    if (RUN(3)) { int t3 = tid; LAUNDER_V(t3); final_norm(kargs(), t3 & 63, __builtin_amdgcn_readfirstlane(t3 >> 6)); }
}
constexpr int N_PHASES = 1 + 2 * 7 + 1;

extern "C" void kernel_launch(void* const* d_in, const int* in_sizes, int n_in, void* d_out, int out_size, void* d_ws, size_t ws_size, hipStream_t stream) {
    static int grid = 0;
    if (grid == 0) {
        if (n_in != 36 || in_sizes[0] != M_PROMPT * DM || (size_t)out_size != O_END || ws_size < WS_END) {
            fprintf(stderr, "kernel_launch: unexpected shapes: n_in %d in0 %d out %d ws %zu\n", n_in, n_in > 0 ? in_sizes[0] : -1, out_size, ws_size); }
        int dev = 0, cus = 0, per_cu = 0;
        hipGetDevice(&dev); hipDeviceGetAttribute(&cus, hipDeviceAttributeMultiprocessorCount, dev);
        if (hipFuncSetAttribute((const void*)fwd_megakernel, hipFuncAttributeMaxDynamicSharedMemorySize, LDS_BYTES) != hipSuccess) { fprintf(stderr, "kernel_launch: hipFuncSetAttribute failed\n"); grid = -1; return; }
        if (hipOccupancyMaxActiveBlocksPerMultiprocessor(&per_cu, (const void*)fwd_megakernel, NTHREADS, LDS_BYTES) != hipSuccess || per_cu < 1) { fprintf(stderr, "kernel_launch: occupancy query failed (%d)\n", per_cu); (void)hipGetLastError(); per_cu = 1; }
        grid = cus * (per_cu > 1 ? 1 : per_cu);
        fprintf(stderr, "kernel_launch: grid %d (cus %d, per_cu %d)\n", grid, cus, per_cu);
    }
    if (grid < 0) return;
    (void)hipMemsetAsync((char*)d_ws + WS_CTL, 0, 65536, stream);
    KArgs ka{};
    for (int i = 0; i < 36; ++i) ka.a.in[i] = (const float*)d_in[i];
    ka.a.out = (float*)d_out; ka.a.ws = (unsigned char*)d_ws;
#if MK_MULTI
    for (int p = 0; p < N_PHASES; ++p) { ka.ph_lo = p; ka.ph_hi = p + 1; hipLaunchKernelGGL(fwd_megakernel, dim3(grid), dim3(NTHREADS), LDS_BYTES, stream, ka); }
#else
    ka.ph_lo = 0; ka.ph_hi = N_PHASES;
    void* args[] = {&ka};
    hipError_t e = hipLaunchCooperativeKernel((const void*)fwd_megakernel, dim3(grid), dim3(NTHREADS), args, LDS_BYTES, stream);
    if (e != hipSuccess) fprintf(stderr, "cooperative launch failed: %s (grid %d)\n", hipGetErrorString(e), grid);
#endif
}
```
